# Optimizing an MI355X kernel written in HIP

```python
import jax, jax.numpy as jnp
from jax import lax
import numpy as np

D_MODEL = 1024
BATCH = 16
SEQ = 4096
DEPTH = 2

CHUNK = 64
EPS = 1e-6
HA_HEADS = 4
HA_DK = 128
HA_DV = 128
HA_K = HA_HEADS * HA_DK
HA_V = HA_HEADS * HA_DV
RB_HEADS = 4
RB_DK = 128
RB_DV = 256
RB_K = RB_HEADS * RB_DK
RB_V = RB_HEADS * RB_DV
ROPE_BASE = 10000.0
IN_COLS = (HA_K, HA_K, HA_V, HA_V, RB_K, RB_K, RB_V, RB_V, D_MODEL, D_MODEL)
IN_TOTAL = sum(IN_COLS)
N_EXPERTS = 16
N_GROUPS = 4
EXP_PER_GROUP = N_EXPERTS // N_GROUPS
TOP_K = 2
D_EXPERT = 512

kernel_name = 'hybrid_hgrn2_retention_groupmoe_adaln'


def rms_norm(x, g):
    xf = x.astype(jnp.float32)
    y = xf * lax.rsqrt(jnp.mean(xf * xf, axis=-1, keepdims=True) + EPS)
    return (y * g.astype(jnp.float32)).astype(x.dtype)


def head_layer_norm(o, g):
    mu = jnp.mean(o, axis=-1, keepdims=True)
    oc = o - mu
    var = jnp.mean(oc * oc, axis=-1, keepdims=True)
    return oc * lax.rsqrt(var + EPS) * g.astype(jnp.float32)


def to_chunks(t, heads):
    b, s, w = t.shape
    return t.reshape(b, s // CHUNK, CHUNK, heads, w // heads).transpose(1, 0, 3, 2, 4)


def from_chunks(t):
    n, b, h, c, d = t.shape
    return t.transpose(1, 0, 3, 2, 4).reshape(b, n * c, h, d)


def rotary(t, heads):
    b, s, w = t.shape
    d = w // heads
    half = d // 2
    t = t.reshape(b, s, heads, d)
    inv = ROPE_BASE ** (-jnp.arange(half, dtype=jnp.float32) / half)
    ang = jnp.arange(s, dtype=jnp.float32)[:, None] * inv[None, :]
    cos = jnp.cos(ang)[None, :, None, :]
    sin = jnp.sin(ang)[None, :, None, :]
    t1, t2 = t[..., :half], t[..., half:]
    out = jnp.concatenate([t1 * cos - t2 * sin, t1 * sin + t2 * cos], axis=-1)
    return out.reshape(b, s, w)


def hgrn2_scan(q, k, v, log_f):
    n, b, h, c, dk = q.shape
    dv = v.shape[-1]
    causal = jnp.tril(jnp.ones((c, c), dtype=bool))[:, :, None]

    def step(state, xs):
        qn, kn, vn, gn = xs
        cum = jnp.cumsum(gn, axis=2)
        diff = cum[:, :, :, None, :] - cum[:, :, None, :, :]
        decay = jnp.exp(jnp.where(causal, diff, -jnp.inf))
        scores = jnp.einsum('bhjd,bhld,bhjld->bhjl', qn, kn, decay)
        out = (jnp.einsum('bhjl,bhlv->bhjv', scores, vn)
               + jnp.einsum('bhjd,bhdv->bhjv', qn * jnp.exp(cum), state))
        last = cum[:, :, -1:, :]
        state = (jnp.exp(last[:, :, 0, :, None]) * state
                 + jnp.einsum('bhld,bhlv->bhdv', kn * jnp.exp(last - cum), vn))
        return state, out

    init = jnp.zeros((b, h, dk, dv), jnp.float32)
    _, out = lax.scan(step, init, (q, k, v, log_f))
    return out


def retention_scan(q, k, v):
    n, b, h, c, dk = q.shape
    dv = v.shape[-1]
    log_gamma = jnp.log(1.0 - 2.0 ** (-5.0 - jnp.arange(h, dtype=jnp.float32)))
    pos = jnp.arange(c, dtype=jnp.float32)
    intra = jnp.exp(log_gamma[:, None, None] * jnp.abs(pos[:, None] - pos[None, :]))
    q_dec = jnp.exp(log_gamma[:, None] * (pos + 1.0))[:, :, None]
    k_dec = jnp.exp(log_gamma[:, None] * (c - 1.0 - pos))[:, :, None]
    chunk_dec = jnp.exp(log_gamma * c)[:, None, None]

    def step(state, xs):
        qn, kn, vn = xs
        scores = jnp.einsum('bhjd,bhld->bhjl', qn, kn) * intra
        out = (jnp.einsum('bhjl,bhlv->bhjv', scores, vn)
               + jnp.einsum('bhjd,bhdv->bhjv', qn, state) * q_dec)
        state = chunk_dec * state + jnp.einsum('bhld,bhlv->bhdv', kn * k_dec, vn)
        return state, out

    init = jnp.zeros((b, h, dk, dv), jnp.float32)
    _, out = lax.scan(step, init, (q, k, v))
    return out


def hybrid_mixer(h, w_in, lb, g_hgrn, g_ret, w_branch_a, w_branch_b, w_out):
    bsz, s, _ = h.shape
    f32 = jnp.float32
    z = h @ w_in
    bounds = np.cumsum(IN_COLS)[:-1].tolist()
    q_a, f_a, i_a, og_a, q_b, k_b, v_b, og_b, m_a, m_b = jnp.split(z, bounds, axis=-1)

    f = lb + (1.0 - lb) * jax.nn.sigmoid(f_a.astype(f32))
    o_a = hgrn2_scan(to_chunks(jax.nn.silu(q_a.astype(f32)), HA_HEADS),
                     to_chunks(1.0 - f, HA_HEADS),
                     to_chunks(i_a.astype(f32), HA_HEADS),
                     to_chunks(jnp.log(f), HA_HEADS))
    o_a = rms_norm(from_chunks(o_a), g_hgrn).reshape(bsz, s, HA_V)
    y_a = (o_a * jax.nn.silu(og_a.astype(f32))).astype(h.dtype) @ w_branch_a

    qr = rotary(q_b.astype(f32), RB_HEADS) * (RB_DK ** -0.5)
    kr = rotary(k_b.astype(f32), RB_HEADS)
    o_b = retention_scan(to_chunks(qr, RB_HEADS), to_chunks(kr, RB_HEADS),
                         to_chunks(v_b.astype(f32), RB_HEADS))
    o_b = head_layer_norm(from_chunks(o_b), g_ret).reshape(bsz, s, RB_V)
    y_b = (o_b * jax.nn.silu(og_b.astype(f32))).astype(h.dtype) @ w_branch_b

    y = jax.nn.sigmoid(m_a) * y_a + jax.nn.sigmoid(m_b) * y_b
    return y @ w_out


def grouped_moe(h, w_router, b_router, w_gate, w_up, w_down):
    bsz, s, d = h.shape
    t = h.reshape(-1, d)
    n_tok = t.shape[0]
    scores = jax.nn.sigmoid((t @ w_router).astype(jnp.float32))
    biased = scores + b_router.astype(jnp.float32)
    grp = biased.reshape(n_tok, N_GROUPS, EXP_PER_GROUP)
    grp_score = lax.top_k(grp, TOP_K)[0].sum(axis=-1)
    g_sel = jnp.argmax(grp_score, axis=-1)
    in_grp = grp[jnp.arange(n_tok), g_sel]
    _, local = lax.top_k(in_grp, TOP_K)
    expert_idx = g_sel[:, None] * EXP_PER_GROUP + local
    w_sel = jnp.take_along_axis(scores, expert_idx, axis=1)
    w_sel = w_sel / jnp.sum(w_sel, axis=-1, keepdims=True)
    combine = jnp.sum(jax.nn.one_hot(expert_idx, N_EXPERTS, dtype=jnp.float32) * w_sel[..., None], axis=1)
    out = jnp.zeros((n_tok, d), jnp.float32)
    for e in range(N_EXPERTS):
        he = jax.nn.silu(t @ w_gate[e]) * (t @ w_up[e])
        out = out + combine[:, e:e + 1] * (he @ w_down[e]).astype(jnp.float32)
    return out.astype(h.dtype).reshape(bsz, s, d)


def setup_inputs(seed: int = 0) -> dict:
    key = jax.random.key(seed)
    ks = jax.random.split(key, 20)
    f32 = jnp.float32
    D = D_MODEL

    def nrm(k, shape, scale):
        return jax.random.normal(k, shape, f32) * scale

    return {
        'x': nrm(ks[0], (BATCH, SEQ, D), 1.0),
        'c': nrm(ks[1], (BATCH, D), 1.0),
        'w_ada': nrm(ks[2], (DEPTH, D, 6 * D), 0.5 * D ** -0.5),
        'b_ada': nrm(ks[3], (DEPTH, 6 * D), 0.02),
        'g_norm1': 1.0 + nrm(ks[4], (DEPTH, D), 0.02),
        'g_norm2': 1.0 + nrm(ks[5], (DEPTH, D), 0.02),
        'w_in': nrm(ks[6], (DEPTH, D, IN_TOTAL), D ** -0.5),
        'lb_logits': nrm(ks[7], (DEPTH, HA_K), 0.1),
        'g_hgrn': 1.0 + nrm(ks[8], (DEPTH, HA_HEADS, HA_DV), 0.02),
        'g_ret': 1.0 + nrm(ks[9], (DEPTH, RB_HEADS, RB_DV), 0.02),
        'w_branch_a': nrm(ks[10], (DEPTH, HA_V, D), HA_V ** -0.5),
        'w_branch_b': nrm(ks[11], (DEPTH, RB_V, D), RB_V ** -0.5),
        'w_out': nrm(ks[12], (DEPTH, D, D), D ** -0.5),
        'w_router': nrm(ks[13], (D, N_EXPERTS), D ** -0.5),
        'b_router': nrm(ks[14], (N_EXPERTS,), 0.01),
        'w_exp_gate': nrm(ks[15], (DEPTH, N_EXPERTS, D, D_EXPERT), D ** -0.5),
        'w_exp_up': nrm(ks[16], (DEPTH, N_EXPERTS, D, D_EXPERT), D ** -0.5),
        'w_exp_down': nrm(ks[17], (DEPTH, N_EXPERTS, D_EXPERT, D), D_EXPERT ** -0.5),
        'g_final': 1.0 + nrm(ks[18], (D,), 0.02),
    }


def reference(x, c, w_ada, b_ada, g_norm1, g_norm2, w_in, lb_logits, g_hgrn, g_ret,
              w_branch_a, w_branch_b, w_out, w_router, b_router, w_exp_gate, w_exp_up,
              w_exp_down, g_final):
    p = jax.nn.softmax(lb_logits.astype(jnp.float32), axis=0)
    lower_bounds = jnp.cumsum(p, axis=0) - p[0:1]
    c_act = jax.nn.silu(c)
    for l in range(DEPTH):
        mod = c_act @ w_ada[l] + b_ada[l]
        sh1, sc1, gt1, sh2, sc2, gt2 = jnp.split(mod[:, None, :], 6, axis=-1)
        h = rms_norm(x, g_norm1[l]) * (1.0 + sc1) + sh1
        x = x + gt1 * hybrid_mixer(h, w_in[l], lower_bounds[l], g_hgrn[l], g_ret[l],
                                   w_branch_a[l], w_branch_b[l], w_out[l])
        h = rms_norm(x, g_norm2[l]) * (1.0 + sc2) + sh2
        x = x + gt2 * grouped_moe(h, w_router, b_router, w_exp_gate[l], w_exp_up[l], w_exp_down[l])
    return rms_norm(x, g_final)
```

```cpp
#include <hip/hip_runtime.h>
#include <hip/hip_cooperative_groups.h>
#include <cstdio>
#include <cstdint>
namespace cg = cooperative_groups;
#ifndef SCAN_V0
#define SCAN_V0 0
#endif

#define LAS __attribute__((address_space(3)))
typedef unsigned short bf16_t;
typedef short bf16x8 __attribute__((ext_vector_type(8)));
typedef float f32x4 __attribute__((ext_vector_type(4)));
typedef float f32x2 __attribute__((ext_vector_type(2)));
typedef unsigned u32x4 __attribute__((ext_vector_type(4)));
typedef unsigned u32x2 __attribute__((ext_vector_type(2)));
#define DI __device__ __forceinline__

constexpr int D = 1024, NB = 16, SEQ = 4096, M = NB * SEQ, DEPTH = 2;
constexpr int NZA = 3584, NZC = 3584, NIN = 7168;
constexpr int KAB = 1536;
constexpr int NE = 16, DE = 512, NCLS = 24;
constexpr float EPS = 1e-6f;
constexpr int ZQ = 0, ZG2 = 512, ZI = 1024, ZQR = 1536, ZKR = 2048, ZV = 2560;
constexpr size_t HZ_OFF = 256u << 20;

constexpr size_t MiB = 1u << 20;
constexpr size_t WS_CTL = 0, CTL_BYTES = 1 * MiB;
constexpr size_t WS_ROT = 1 * MiB;
constexpr size_t WS_MOD = 3 * MiB;
constexpr size_t WS_LBT = 3 * MiB + 768 * 1024;
constexpr size_t WS_WIN = 4 * MiB;
constexpr size_t WS_WAB = 32 * MiB;
constexpr size_t WS_WOUT = 38 * MiB;
constexpr size_t WS_WG = 42 * MiB;
constexpr size_t WS_WU = 58 * MiB;
constexpr size_t WS_WD = 74 * MiB;
constexpr size_t WS_LIST = 90 * MiB;
constexpr size_t WS_WL = 96 * MiB;
constexpr size_t WS_TOKI = 108 * MiB;
constexpr size_t WS_X16 = 110 * MiB;
constexpr size_t WS_H = 238 * MiB;
constexpr size_t WS_AB = 366 * MiB;
constexpr size_t WS_Z = 558 * MiB;
constexpr size_t WS_END = 1006 * MiB;
constexpr int CW_BAR = 16384;
constexpr int CW_CNT = 1024;

constexpr int LDS_BYTES = 163840;
constexpr int LDS_IDT = 147456;
constexpr int LDS_AUX = 131072;

typedef __bf16 bf16x2_t __attribute__((ext_vector_type(2)));
DI unsigned cvt_pk_bf16(float lo, float hi) { const bf16x2_t r = __builtin_convertvector((f32x2){lo, hi}, bf16x2_t); return __builtin_bit_cast(unsigned, r); }
typedef int i32x4 __attribute__((ext_vector_type(4)));
typedef int i32x8 __attribute__((ext_vector_type(8)));
DI unsigned pk_fp8x4(float a, float b, float c, float d, float S) {
    a = __builtin_amdgcn_fmed3f(a * S, -448.f, 448.f); b = __builtin_amdgcn_fmed3f(b * S, -448.f, 448.f); c = __builtin_amdgcn_fmed3f(c * S, -448.f, 448.f); d = __builtin_amdgcn_fmed3f(d * S, -448.f, 448.f);
    int pk = __builtin_amdgcn_cvt_pk_fp8_f32(a, b, 0, false); pk = __builtin_amdgcn_cvt_pk_fp8_f32(c, d, pk, true); return (unsigned)pk; }
constexpr float S8_ACT = 4.f, S8_W = 64.f, S8_ACT2 = 8.f;
#ifndef FP8_DE
#define FP8_DE 1
#endif
constexpr size_t AB8_BX = (size_t)6 << 20;
constexpr size_t H2_BX = (size_t)8 << 20;
constexpr int CW_MOE = 3072;
constexpr int CW_LAB = 2048;
constexpr size_t AB8_OFF = (size_t)256 << 20;
DI float bf_lo(unsigned u) { return __uint_as_float(u << 16); }
DI float bf_hi(unsigned u) { return __uint_as_float(u & 0xffff0000u); }
DI float bf2f(bf16_t b) { return __uint_as_float(((unsigned)b) << 16); }
DI float sigm(float x) { return __builtin_amdgcn_rcpf(1.f + __expf(-x)); }
DI float silu(float x) { return x * sigm(x); }
DI unsigned pk_f16(float a, float b) { _Float16 ha = (_Float16)a, hb = (_Float16)b; return (unsigned)__builtin_bit_cast(unsigned short, ha) | ((unsigned)__builtin_bit_cast(unsigned short, hb) << 16); }
DI float h2f(unsigned short u) { return (float)__builtin_bit_cast(_Float16, u); }
template <int X> DI float swz_xor(float v) { return __int_as_float(__builtin_amdgcn_ds_swizzle(__float_as_int(v), (X << 10) | 0x1f)); }
DI float sum16(float v) { v += swz_xor<1>(v); v += swz_xor<2>(v); v += swz_xor<4>(v); v += swz_xor<8>(v); return v; }
DI float wave_sum(float v) {
    v = sum16(v); v += swz_xor<16>(v);
    const auto r = __builtin_amdgcn_permlane32_swap(__float_as_uint(v), __float_as_uint(v), false, false);
    return __uint_as_float(r[0]) + __uint_as_float(r[1]);
}
template <int CTRL> DI float dppf(float x) { return __int_as_float(__builtin_amdgcn_update_dpp(0, __float_as_int(x), CTRL, 0xf, 0xf, false)); }
DI float reduce16(const float (&p)[16], int lane) {
    float q[8], r4[4], t[2];
#pragma unroll
    for (int e = 0; e < 8; ++e) { const auto r = __builtin_amdgcn_permlane32_swap(__float_as_uint(p[e]), __float_as_uint(p[e + 8]), false, false); q[e] = __uint_as_float(r[0]) + __uint_as_float(r[1]); }
#pragma unroll
    for (int e = 0; e < 4; ++e) { const auto r = __builtin_amdgcn_permlane16_swap(__float_as_uint(q[e]), __float_as_uint(q[e + 4]), false, false); r4[e] = __uint_as_float(r[0]) + __uint_as_float(r[1]); }
    const bool b3 = (lane & 8) != 0, b2 = (lane & 4) != 0;
#pragma unroll
    for (int e = 0; e < 2; ++e) { const float sel = b3 ? r4[e + 2] : r4[e], oth = b3 ? r4[e] : r4[e + 2]; t[e] = sel + dppf<0x140>(oth); }
    const float sel = b2 ? t[1] : t[0], oth = b2 ? t[0] : t[1];
    float u = sel + dppf<0x141>(oth);
    u += dppf<0xB1>(u); u += dppf<0x4E>(u);
    return u;
}
#define LDS_WAIT() asm volatile("s_waitcnt lgkmcnt(0)" ::: "memory")
DI int ltid(int W) { int t; asm volatile("v_mbcnt_lo_u32_b32 %0, -1, 0\n\tv_mbcnt_hi_u32_b32 %0, -1, %0\n\tv_lshl_add_u32 %0, %1, 6, %0" : "=&v"(t) : "s"(W)); return t; }
DI int lbid() { int b = blockIdx.x; asm volatile("" : "+s"(b)); return b; }
DI int lgrid() { int g = gridDim.x; asm volatile("" : "+s"(g)); return g; }

DI int src_col_in(int r) {
    if (r < NZA) {
        if (r < 1536) return r;
        if (r < 2560) { const int seg = (r - 1536) >> 9, w = (r - 1536) & 511, head = w >> 7, p = w & 127, i = p >> 1, half = p & 1;
            return 2048 + seg * 512 + head * 128 + half * 64 + i; }
        return 3072 + (r - 2560);
    }
    const int q = r - NZA;
    if (q < 512) return 1536 + q;
    if (q < 1536) return 4096 + (q - 512);
    { const int qq = q - 1536, k = qq >> 8, w = qq & 255; return 5120 + (w >> 7) * 1024 + k * 128 + (w & 127); }
}

namespace pg {
constexpr int BM = 256, BK = 64, HALF = 128, HTB = HALF * BK * 2, STAGE_BYTES = 8 * HTB;
DI int lds_byte(int r, int c) { const int st = (r >> 4) * 2 + (c >> 5), rr = r & 15, cc = c & 31, ob = rr * 64 + cc * 2; return st * 1024 + (ob ^ (((ob >> 9) & 1) << 5)); }
DI void stage_rc(int b, int& R, int& C) { const int st = b / 1024, sb = b % 1024, swz = sb ^ (((sb >> 9) & 1) << 5); R = (st >> 1) * 16 + swz / 64; C = (st & 1) * 32 + (swz % 64) / 2; }
DI int perm32(int rho) { const int n = rho >> 4, i = rho & 15; return 8 * (i >> 2) + 4 * n + (i & 3); }

struct Unit { int pm, pn, cls, cnt, rowpos, seq; };
typedef f32x4 Acc[2][2][4][2];

template <int NM, int NN> struct StaticOrder {
    int G, c;
    DI void init(int G_, int c_) { G = G_; c = c_; }
    DI bool next(int i, Unit& u) const {
        constexpr int nwg = NM * NN; static_assert(nwg % 8 == 0 && NM % 8 == 0, "shape");
        const int L = i * G + c; if (L >= nwg) return false;
        const int wgid = (L % 8) * (nwg / 8) + L / 8;
        constexpr int nig = 8 * NN; const int gid = wgid / nig, fm = gid * 8;
        u.pm = fm + ((wgid % nig) % 8); u.pn = (wgid % nig) / 8; u.cls = 0; u.cnt = 0; u.rowpos = 0; u.seq = i; return true;
    }
};

template <class P, class = void> struct HasDone { static constexpr bool v = false; };
template <class P> struct HasDone<P, decltype((void)P::HAS_DONE)> { static constexpr bool v = P::HAS_DONE; };
template <class P, class = void> struct HasDmaAddr { static constexpr bool v = false; };
template <class P> struct HasDmaAddr<P, decltype((void)P::DMA_ADDR)> { static constexpr bool v = P::DMA_ADDR; };
template <class P>
DI void gemm_phase(LAS unsigned char* lds, const P& p, int W) {
    constexpr int NT = P::NT;
    typedef typename P::Adr Adr;
    const int tid = ltid(W), wid = __builtin_amdgcn_readfirstlane(tid >> 6), lane = tid & 63, wr = wid >> 2, wc = wid & 3, fr = lane & 15, fq = lane >> 4;
    unsigned voffA;
    { int R, C; stage_rc(tid * 16, R, C); voffA = (unsigned)(R * P::LDA + C * 2); }
#define voffB (P::LDA == P::LDB ? voffA : ((voffA / (unsigned)P::LDA) * (unsigned)P::LDB + (voffA & 127u)))
    const unsigned ldsw = (unsigned)wid * 1024u;
    int lfrag = lds_byte(fr, fq * 8); const int aU = wr * 8192, bU = wc * 4096;
#define aoff (aU + lfrag)
#define boff (bU + lfrag)
#define PG_SA(b, h) (((b) * 2 + (h)) * HTB)
#define PG_SB(b, h) ((4 + (b) * 2 + (h)) * HTB)
#define PG_GLDS(src, dstoff) __builtin_amdgcn_global_load_lds((const unsigned*)(src), (LAS unsigned*)(lds + (dstoff)), 16, 0, 0)
#define PG_STAGE_A(bufoff, adr, h, t) do { const unsigned _ab = p.abase(adr, h, t), _pre = p.apre(adr, h); _Pragma("unroll") for (int _i = 0; _i < 2; ++_i) PG_GLDS(p.wsb + (size_t)(unsigned)(_ab + p.avoff(adr, h, _i, voffA, _pre) + (unsigned)(_i * P::AIOFF)), (bufoff) + ldsw + _i * 8192); } while (0)
#define PG_STAGE_B(bufoff, adr, h, t) do { const unsigned _bb = p.bbase(adr, h, t); _Pragma("unroll") for (int _i = 0; _i < 2; ++_i) PG_GLDS(p.wsb + (size_t)(unsigned)(_bb + voffB + (unsigned)(_i * 64 * P::LDB)), (bufoff) + ldsw + _i * 8192); } while (0)
#define PG_LDA(dst, b, h) do { _Pragma("unroll") for (int m = 0; m < 4; ++m) _Pragma("unroll") for (int k = 0; k < 2; ++k) dst[m][k] = *(const LAS bf16x8*)(lds + PG_SA(b, h) + aoff + m * 2048 + k * 1024); } while (0)
#define PG_LDB(dst, b, h) do { _Pragma("unroll") for (int n = 0; n < 2; ++n) _Pragma("unroll") for (int k = 0; k < 2; ++k) dst[n][k] = *(const LAS bf16x8*)(lds + PG_SB(b, h) + boff + n * 2048 + k * 1024); } while (0)
#define PG_CAT8(x) __builtin_shufflevector(__builtin_bit_cast(i32x4, x[0]), __builtin_bit_cast(i32x4, x[1]), 0, 1, 2, 3, 4, 5, 6, 7)
#define PG_MMA(ai, bj, At, Bt) do { __builtin_amdgcn_s_setprio(1); \
        if constexpr (P::FP8) { _Pragma("unroll") for (int m = 0; m < 4; ++m) _Pragma("unroll") for (int n = 0; n < 2; ++n) \
            acc[ai][bj][m][n] = __builtin_amdgcn_mfma_scale_f32_16x16x128_f8f6f4(PG_CAT8(Bt[n]), PG_CAT8(At[m]), acc[ai][bj][m][n], 0, 0, 0, 0, 0, 0); } \
        else { _Pragma("unroll") for (int m = 0; m < 4; ++m) _Pragma("unroll") for (int n = 0; n < 2; ++n) _Pragma("unroll") for (int k = 0; k < 2; ++k) \
            acc[ai][bj][m][n] = __builtin_amdgcn_mfma_f32_16x16x32_bf16(Bt[n][k], At[m][k], acc[ai][bj][m][n], 0, 0, 0); } \
        __builtin_amdgcn_s_setprio(0); } while (0)
#define PG_WAIT_V(n) asm volatile("s_waitcnt vmcnt(" #n ")" ::: "memory")
#define PG_WAIT_L(n) asm volatile("s_waitcnt lgkmcnt(" #n ")" ::: "memory")
#define PG_BAR __builtin_amdgcn_s_barrier()
#define PG_SCHED __builtin_amdgcn_sched_barrier(0)
    Unit cur, nxt; int ui = 0;
    if (!p.next(0, cur)) return;
    Adr ca, na;
    p.addr(cur, ca);
    if constexpr (HasDmaAddr<P>::v) asm volatile("s_waitcnt vmcnt(0)" ::: "memory");
    Acc acc;
#pragma unroll
    for (int a = 0; a < 2; ++a)
#pragma unroll
        for (int b = 0; b < 2; ++b)
#pragma unroll
            for (int m = 0; m < 4; ++m)
#pragma unroll
                for (int n = 0; n < 2; ++n) acc[a][b][m][n] = (f32x4){0.f, 0.f, 0.f, 0.f};
    bf16x8 At[4][2], B0[2][2], B1[2][2];
    PG_STAGE_B(PG_SB(0, 0), ca, 0, 0); PG_STAGE_B(PG_SB(0, 1), ca, 1, 0); PG_STAGE_A(PG_SA(0, 0), ca, 0, 0); PG_STAGE_A(PG_SA(0, 1), ca, 1, 0);
    if (wr == 1) PG_BAR;
    PG_WAIT_V(2); PG_BAR;
    PG_STAGE_B(PG_SB(1, 0), ca, 0, 1); PG_STAGE_A(PG_SA(1, 0), ca, 0, 1); PG_STAGE_B(PG_SB(1, 1), ca, 1, 1);
    PG_WAIT_V(6); PG_BAR;
    for (;;) {
        const bool has_next = p.next(ui + 1, nxt);
        if (has_next) p.addr(nxt, na); else na = ca;
        for (int t = 0; t < NT; t += 2) {
            asm volatile("" : "+v"(voffA), "+v"(lfrag));
            const bool last = (t == NT - 2);
            if constexpr (P::HAS_MID) { if (t == P::TMID) { const int l2 = ltid(W) & 63; p.mid(acc, cur, wr, wc, l2 & 15, l2 >> 4); } }
            const Adr xa = last ? na : ca;
            const int t1 = t + 1, t2 = last ? 0 : t + 2, t3 = t2 + 1;
            PG_LDB(B0, 0, 0); PG_LDB(B1, 0, 1); PG_SCHED; PG_LDA(At, 0, 0); PG_STAGE_A(PG_SA(1, 1), ca, 1, t1);
            PG_WAIT_V(8); PG_WAIT_L(0); PG_BAR; PG_MMA(0, 0, At, B0); PG_MMA(0, 1, At, B1); PG_BAR; PG_SCHED;
            PG_LDA(At, 0, 1); PG_STAGE_B(PG_SB(0, 0), xa, 0, t2); PG_STAGE_B(PG_SB(0, 1), xa, 1, t2); PG_STAGE_A(PG_SA(0, 0), xa, 0, t2);
            PG_WAIT_V(8); PG_WAIT_L(0); PG_BAR; PG_MMA(1, 0, At, B0); PG_MMA(1, 1, At, B1); PG_BAR; PG_SCHED;
            PG_LDB(B0, 1, 0); PG_LDB(B1, 1, 1); PG_SCHED; PG_LDA(At, 1, 0); PG_STAGE_A(PG_SA(0, 1), xa, 1, t2);
            PG_WAIT_V(8); PG_WAIT_L(0); PG_BAR; PG_MMA(0, 0, At, B0); PG_MMA(0, 1, At, B1); PG_BAR; PG_SCHED;
            PG_LDA(At, 1, 1); PG_STAGE_B(PG_SB(1, 0), xa, 0, t3); PG_STAGE_B(PG_SB(1, 1), xa, 1, t3); PG_STAGE_A(PG_SA(1, 0), xa, 0, t3);
            PG_WAIT_V(8); PG_WAIT_L(0); PG_BAR; PG_MMA(1, 0, At, B0); PG_MMA(1, 1, At, B1); PG_BAR; PG_SCHED;
        }
        if (wr == 0) PG_BAR;
        { const int l2 = ltid(W) & 63; p.epi(acc, cur, wr, wc, l2 & 15, l2 >> 4); }
        if constexpr (HasDone<P>::v) p.done(cur);
        if (!has_next) break;
#pragma unroll
        for (int a = 0; a < 2; ++a)
#pragma unroll
            for (int b = 0; b < 2; ++b)
#pragma unroll
                for (int m = 0; m < 4; ++m)
#pragma unroll
                    for (int n = 0; n < 2; ++n) acc[a][b][m][n] = (f32x4){0.f, 0.f, 0.f, 0.f};
        cur = nxt; ca = na; ++ui;
        if (wr == 1) PG_BAR;
    }
    PG_WAIT_V(0);
    PG_BAR;
#undef PG_SA
#undef PG_SB
#undef PG_GLDS
#undef PG_STAGE_A
#undef PG_STAGE_B
#undef PG_LDA
#undef PG_LDB
#undef PG_MMA
#undef aoff
#undef boff
#undef voffB
#undef PG_CAT8
#undef PG_WAIT_V
#undef PG_WAIT_L
#undef PG_BAR
#undef PG_SCHED
}
}

using pg::Unit; using pg::Acc;

struct AdrReg { unsigned a, b; };
#define REGULAR_ADDR(LDA_, LDB_) REGULAR_ADDR3(LDA_, LDB_, 0)
#define REGULAR_ADDR3(LDA_, LDB_, ABX_) \
    typedef AdrReg Adr; static constexpr int LDA = LDA_, LDB = LDB_, AIOFF = 64 * LDA_; \
    DI void addr(const Unit& u, Adr& r) const { r.a = aoff0 + (unsigned)u.pm * (256u * LDA_) + (unsigned)(u.pm >> 4) * (unsigned)(ABX_); r.b = boff0 + (unsigned)u.pn * (256u * LDB_); } \
    DI unsigned abase(const Adr& r, int h, int t) const { return r.a + (unsigned)(h * 128 * LDA_) + (unsigned)t * 128u; } \
    DI unsigned apre(const Adr&, int) const { return 0u; } \
    DI unsigned avoff(const Adr&, int, int, unsigned v, unsigned) const { return v; } \
    DI unsigned bbase(const Adr& r, int h, int t) const { return r.b + (unsigned)(h * 128 * LDB_) + (unsigned)t * 128u; }

struct PInA {
    static constexpr int NT = 8, TMID = -1; static constexpr bool PERM = true, HAS_MID = false, FP8 = true;
    const char* wsb; unsigned aoff0, boff0; int l; pg::StaticOrder<M / 256, NZA / 256> so;
    DI bool next(int i, Unit& u) const { return so.next(i, u); }
    REGULAR_ADDR(1024, 1024)
    DI void epi(const Acc& acc, const Unit& u, int wr, int wc, int fr, int fq) const {
        bf16_t* Z = (bf16_t*)(wsb + WS_Z); const float* lbt = (const float*)(wsb + WS_LBT) + l * 512; const f32x2* rot = (const f32x2*)(wsb + WS_ROT);
        asm volatile("" : "+v"(fr), "+v"(fq));
        const int seg = u.pn >> 1;
        const int row0 = u.pm * 256 + wr * 64 + fr, colw = wc * 32 + 8 * fq;
        f32x4 lbv[2][2];
        if (seg == 1) {
#pragma unroll
            for (int bj = 0; bj < 2; ++bj) { const int c = u.pn * 256 - 512 + bj * 128 + colw; lbv[bj][0] = *(const f32x4*)(lbt + c); lbv[bj][1] = *(const f32x4*)(lbt + c + 4); }
        }
        f32x4 csb[2][4][2];
        if (seg == 3 || seg == 4) {
#pragma unroll
            for (int ai = 0; ai < 2; ++ai)
#pragma unroll
                for (int m = 0; m < 4; ++m) { const f32x2* rp = rot + (size_t)((row0 + ai * 128 + m * 16) & (SEQ - 1)) * 64 + (colw >> 1); csb[ai][m][0] = *(const f32x4*)rp; csb[ai][m][1] = *(const f32x4*)(rp + 2); }
        }
#pragma unroll
        for (int ai = 0; ai < 2; ++ai)
#pragma unroll
            for (int m = 0; m < 4; ++m) {
                const int row = row0 + ai * 128 + m * 16;
#if SCAN_V0
                bf16_t* rowp = Z + (size_t)row * NZA + u.pn * 256 + colw; const size_t bjstep = 128;
#else
                const size_t tok = (size_t)(row & (SEQ - 1)), bh0 = (size_t)(row >> 12) * 4;
                bf16_t* rowp; size_t bjstep;
                if (seg < 3)      { rowp = Z + (HZ_OFF >> 1) + ((bh0 + 2 * (u.pn & 1)) * SEQ + tok) * 384 + seg * 128 + colw; bjstep = (size_t)SEQ * 384; }
                else if (seg < 5) { rowp = Z + ((bh0 + 2 * (u.pn & 1)) * SEQ + tok) * 512 + (seg - 3) * 128 + colw; bjstep = (size_t)SEQ * 512; }
                else              { rowp = Z + ((bh0 + (u.pn - 10)) * SEQ + tok) * 512 + 256 + colw; bjstep = 128; }
#endif
                const f32x4 cs0 = csb[ai][m][0], cs1 = csb[ai][m][1];
#pragma unroll
                for (int bj = 0; bj < 2; ++bj) {
                    f32x4 v0 = acc[ai][bj][m][0] * (1.f / (S8_ACT * S8_W)), v1 = acc[ai][bj][m][1] * (1.f / (S8_ACT * S8_W));
                    u32x4 w;
                    if (seg == 1) {
#pragma unroll
                        for (int j = 0; j < 4; ++j) { const float l0 = lbv[bj][0][j], l1 = lbv[bj][1][j];
                            v0[j] = __log2f(l0 + (1.f - l0) * sigm(v0[j])); v1[j] = __log2f(l1 + (1.f - l1) * sigm(v1[j])); }
                        w.x = pk_f16(v0[0], v0[1]); w.y = pk_f16(v0[2], v0[3]); w.z = pk_f16(v1[0], v1[1]); w.w = pk_f16(v1[2], v1[3]);
                    } else {
                        if (seg == 0) {
#pragma unroll
                            for (int j = 0; j < 4; ++j) { v0[j] = silu(v0[j]); v1[j] = silu(v1[j]); }
                        } else if (seg == 3 || seg == 4) {
                            const float sc = (seg == 3) ? 0.08838834764831845f : 1.f;
                            f32x4 o0, o1;
                            o0[0] = (v0[0] * cs0[0] - v0[1] * cs0[1]) * sc; o0[1] = (v0[0] * cs0[1] + v0[1] * cs0[0]) * sc;
                            o0[2] = (v0[2] * cs0[2] - v0[3] * cs0[3]) * sc; o0[3] = (v0[2] * cs0[3] + v0[3] * cs0[2]) * sc;
                            o1[0] = (v1[0] * cs1[0] - v1[1] * cs1[1]) * sc; o1[1] = (v1[0] * cs1[1] + v1[1] * cs1[0]) * sc;
                            o1[2] = (v1[2] * cs1[2] - v1[3] * cs1[3]) * sc; o1[3] = (v1[2] * cs1[3] + v1[3] * cs1[2]) * sc;
                            v0 = o0; v1 = o1;
                        }
                        w.x = cvt_pk_bf16(v0[0], v0[1]); w.y = cvt_pk_bf16(v0[2], v0[3]); w.z = cvt_pk_bf16(v1[0], v1[1]); w.w = cvt_pk_bf16(v1[2], v1[3]);
                    }
                    *(u32x4*)(rowp + bj * bjstep) = w;
                }
            }
    }
};

struct PInA_bare {
    static constexpr int NT = 8, TMID = -1; static constexpr bool PERM = true, HAS_MID = false, FP8 = true;
    const char* wsb; unsigned aoff0, boff0; int l; pg::StaticOrder<M / 256, NZA / 256> so;
    DI bool next(int i, Unit& u) const { return so.next(i, u); }
    REGULAR_ADDR(1024, 1024)
    DI void epi(const Acc& acc, const Unit& u, int wr, int wc, int fr, int fq) const {
        bf16_t* Z = (bf16_t*)(wsb + WS_Z); const int row0 = u.pm * 256 + wr * 64 + fr, colw = wc * 32 + 8 * fq;
#pragma unroll
        for (int ai = 0; ai < 2; ++ai)
#pragma unroll
            for (int m = 0; m < 4; ++m) { bf16_t* rowp = Z + (size_t)(row0 + ai * 128 + m * 16) * NZA + u.pn * 256 + colw;
#pragma unroll
                for (int bj = 0; bj < 2; ++bj) { const f32x4 v0 = acc[ai][bj][m][0], v1 = acc[ai][bj][m][1]; u32x4 w;
                    w.x = cvt_pk_bf16(v0[0], v0[1]); w.y = cvt_pk_bf16(v0[2], v0[3]); w.z = cvt_pk_bf16(v1[0], v1[1]); w.w = cvt_pk_bf16(v1[2], v1[3]); *(u32x4*)(rowp + bj * 128) = w; } }
    }
};

struct PInC {
    static constexpr int NT = 8, TMID = -1; static constexpr bool PERM = true, HAS_MID = false, FP8 = true;
    const char* wsb; unsigned aoff0, boff0; pg::StaticOrder<M / 256, NZC / 256> so;
    DI bool next(int i, Unit& u) const { return so.next(i, u); }
    REGULAR_ADDR(1024, 1024)
    DI void epi(const Acc& acc, const Unit& u, int wr, int wc, int fr, int fq) const {
        bf16_t* AB = (bf16_t*)(wsb + WS_AB); bf16_t* ZG = (bf16_t*)(wsb + WS_Z);
        asm volatile("" : "+v"(fr), "+v"(fq));
        const int row0 = u.pm * 256 + wr * 64 + fr, col0 = u.pn * 256 + wc * 32 + 8 * fq;
        const bool gate = u.pn < 6;
        u32x4 ob[2][4][2];
        if (gate) {
#pragma unroll
            for (int ai = 0; ai < 2; ++ai)
#pragma unroll
                for (int m = 0; m < 4; ++m)
#pragma unroll
                    for (int bj = 0; bj < 2; ++bj) ob[ai][m][bj] = *(const u32x4*)(AB + (size_t)(row0 + ai * 128 + m * 16) * KAB + col0 + bj * 128);
        }
#pragma unroll
        for (int ai = 0; ai < 2; ++ai)
#pragma unroll
            for (int m = 0; m < 4; ++m) {
                const int row = row0 + ai * 128 + m * 16;
#pragma unroll
                for (int bj = 0; bj < 2; ++bj) {
                    f32x4 v0 = acc[ai][bj][m][0] * (1.f / (S8_ACT * S8_W)), v1 = acc[ai][bj][m][1] * (1.f / (S8_ACT * S8_W));
                    u32x4 w;
                    if (gate) {
                        bf16_t* pab = AB + (size_t)row * KAB + col0 + bj * 128;
                        const u32x4 o = ob[ai][m][bj];
#if FP8_DE
                        u32x2 w8; (void)pab;
                        w8.x = pk_fp8x4(bf_lo(o.x) * silu(v0[0]), bf_hi(o.x) * silu(v0[1]), bf_lo(o.y) * silu(v0[2]), bf_hi(o.y) * silu(v0[3]), S8_ACT);
                        w8.y = pk_fp8x4(bf_lo(o.z) * silu(v1[0]), bf_hi(o.z) * silu(v1[1]), bf_lo(o.w) * silu(v1[2]), bf_hi(o.w) * silu(v1[3]), S8_ACT);
                        *(u32x2*)((unsigned char*)ZG + AB8_OFF + (size_t)row * KAB + (size_t)(row >> 12) * AB8_BX + col0 + bj * 128) = w8;
#else
                        w.x = cvt_pk_bf16(bf_lo(o.x) * silu(v0[0]), bf_hi(o.x) * silu(v0[1])); w.y = cvt_pk_bf16(bf_lo(o.y) * silu(v0[2]), bf_hi(o.y) * silu(v0[3]));
                        w.z = cvt_pk_bf16(bf_lo(o.z) * silu(v1[0]), bf_hi(o.z) * silu(v1[1])); w.w = cvt_pk_bf16(bf_lo(o.w) * silu(v1[2]), bf_hi(o.w) * silu(v1[3]));
                        *(u32x4*)pab = w;
#endif
                    } else if (bj == 0) {
                        const f32x4 b0 = acc[ai][1][m][0] * (1.f / (S8_ACT * S8_W)), b1 = acc[ai][1][m][1] * (1.f / (S8_ACT * S8_W));
                        float sa[8], sb[8];
#pragma unroll
                        for (int e = 0; e < 4; ++e) { sa[e] = sigm(v0[e]); sa[4 + e] = sigm(v1[e]); sb[e] = sigm(b0[e]); sb[4 + e] = sigm(b1[e]); }
                        u32x4 wr_, ws_;
                        wr_.x = cvt_pk_bf16(sa[0] * __builtin_amdgcn_rcpf(sb[0]), sa[1] * __builtin_amdgcn_rcpf(sb[1])); wr_.y = cvt_pk_bf16(sa[2] * __builtin_amdgcn_rcpf(sb[2]), sa[3] * __builtin_amdgcn_rcpf(sb[3]));
                        wr_.z = cvt_pk_bf16(sa[4] * __builtin_amdgcn_rcpf(sb[4]), sa[5] * __builtin_amdgcn_rcpf(sb[5])); wr_.w = cvt_pk_bf16(sa[6] * __builtin_amdgcn_rcpf(sb[6]), sa[7] * __builtin_amdgcn_rcpf(sb[7]));
                        ws_.x = cvt_pk_bf16(sb[0], sb[1]); ws_.y = cvt_pk_bf16(sb[2], sb[3]); ws_.z = cvt_pk_bf16(sb[4], sb[5]); ws_.w = cvt_pk_bf16(sb[6], sb[7]);
                        bf16_t* zp = ZG + (size_t)row * 2048 + (u.pn - 6) * 128 + wc * 32 + 8 * fq;
                        *(u32x4*)zp = wr_; *(u32x4*)(zp + 1024) = ws_;
                    }
                }
            }
    }
};

struct PMerge {
    static constexpr int NT = FP8_DE ? 12 : 24, TMID = FP8_DE ? 4 : 8; static constexpr bool PERM = true, HAS_MID = true, FP8 = FP8_DE != 0;
    const char* wsb; unsigned aoff0, boff0; pg::StaticOrder<M / 256, D / 256> so;
    DI bool next(int i, Unit& u) const { return so.next(i, u); }
    REGULAR_ADDR3((FP8_DE ? 1536 : 3072), (FP8_DE ? 1536 : 3072), (FP8_DE ? AB8_BX : 0))
    DI void mid(Acc& acc, const Unit& u, int wr, int wc, int fr, int fq) const {
        const bf16_t* ZG = (const bf16_t*)(wsb + WS_Z);
        asm volatile("" : "+v"(fr), "+v"(fq));
        const int row0 = u.pm * 256 + wr * 64 + fr, col0 = u.pn * 256 + wc * 32 + 8 * fq;
        u32x4 ga[2][4][2];
#pragma unroll
        for (int ai = 0; ai < 2; ++ai)
#pragma unroll
            for (int m = 0; m < 4; ++m) { const bf16_t* zp = ZG + (size_t)(row0 + ai * 128 + m * 16) * 2048 + col0;
#pragma unroll
                for (int bj = 0; bj < 2; ++bj) ga[ai][m][bj] = *(const u32x4*)(zp + bj * 128); }
#pragma unroll
        for (int ai = 0; ai < 2; ++ai)
#pragma unroll
            for (int m = 0; m < 4; ++m)
#pragma unroll
                for (int bj = 0; bj < 2; ++bj) { const u32x4 a = ga[ai][m][bj];
                    f32x4& v0 = acc[ai][bj][m][0]; f32x4& v1 = acc[ai][bj][m][1];
                    v0[0] *= bf_lo(a.x); v0[1] *= bf_hi(a.x); v0[2] *= bf_lo(a.y); v0[3] *= bf_hi(a.y);
                    v1[0] *= bf_lo(a.z); v1[1] *= bf_hi(a.z); v1[2] *= bf_lo(a.w); v1[3] *= bf_hi(a.w); }
        asm volatile("" ::: "memory");
    }
    DI void epi(const Acc& acc, const Unit& u, int wr, int wc, int fr, int fq) const {
        const bf16_t* ZG = (const bf16_t*)(wsb + WS_Z); bf16_t* Y = (bf16_t*)(wsb + WS_H);
        const int row0 = u.pm * 256 + wr * 64 + fr, col0 = u.pn * 256 + wc * 32 + 8 * fq;
        u32x4 gbb[2][4][2];
#pragma unroll
        for (int ai = 0; ai < 2; ++ai)
#pragma unroll
            for (int m = 0; m < 4; ++m)
#pragma unroll
                for (int bj = 0; bj < 2; ++bj) gbb[ai][m][bj] = *(const u32x4*)(ZG + (size_t)(row0 + ai * 128 + m * 16) * 2048 + 1024 + col0 + bj * 128);
#pragma unroll
        for (int ai = 0; ai < 2; ++ai)
#pragma unroll
            for (int m = 0; m < 4; ++m) {
                const int row = row0 + ai * 128 + m * 16;
#pragma unroll
                for (int bj = 0; bj < 2; ++bj) {
                    const u32x4 gb = gbb[ai][m][bj];
                    const f32x4 v0 = acc[ai][bj][m][0], v1 = acc[ai][bj][m][1];
                    u32x4 w;
#if FP8_DE
                    constexpr float qs = 1.f / S8_W;
                    u32x2 w8; (void)w;
                    w8.x = pk_fp8x4(v0[0] * bf_lo(gb.x), v0[1] * bf_hi(gb.x), v0[2] * bf_lo(gb.y), v0[3] * bf_hi(gb.y), qs);
                    w8.y = pk_fp8x4(v1[0] * bf_lo(gb.z), v1[1] * bf_hi(gb.z), v1[2] * bf_lo(gb.w), v1[3] * bf_hi(gb.w), qs);
                    *(u32x2*)((unsigned char*)Y + (size_t)row * D + col0 + bj * 128) = w8;
#else
                    w.x = cvt_pk_bf16(v0[0] * bf_lo(gb.x), v0[1] * bf_hi(gb.x)); w.y = cvt_pk_bf16(v0[2] * bf_lo(gb.y), v0[3] * bf_hi(gb.y));
                    w.z = cvt_pk_bf16(v1[0] * bf_lo(gb.z), v1[1] * bf_hi(gb.z)); w.w = cvt_pk_bf16(v1[2] * bf_lo(gb.w), v1[3] * bf_hi(gb.w));
                    *(u32x4*)(Y + (size_t)row * D + col0 + bj * 128) = w;
#endif
                }
            }
    }
};

struct PWout {
    static constexpr int NT = FP8_DE ? 8 : 16, TMID = -1; static constexpr bool PERM = true, HAS_MID = false, FP8 = FP8_DE != 0;
    const char* wsb; unsigned aoff0, boff0; const float* xin32; int l; pg::StaticOrder<M / 256, D / 256> so;
    DI bool next(int i, Unit& u) const { return so.next(i, u); }
    REGULAR_ADDR((FP8_DE ? 1024 : 2048), (FP8_DE ? 1024 : 2048))
    DI void epi(const Acc& acc, const Unit& u, int wr, int wc, int fr, int fq) const {
        bf16_t* X = (bf16_t*)(wsb + WS_X16);
        const int row0 = u.pm * 256 + wr * 64 + fr, col0 = u.pn * 256 + wc * 32 + 8 * fq;
        const float* gtb = (const float*)(wsb + WS_MOD) + (size_t)(l * 16 + (u.pm >> 4)) * 6144 + 2048 + col0;
        f32x4 g[2][2];
#pragma unroll
        for (int bj = 0; bj < 2; ++bj)
#pragma unroll
            for (int n = 0; n < 2; ++n) g[bj][n] = *(const f32x4*)(gtb + bj * 128 + n * 4) * (FP8_DE ? 1.f / (S8_ACT * S8_W) : 1.f);
#pragma unroll
        for (int bt = 0; bt < 8; bt += 2) {
            if (l == 0) {
#pragma unroll
                for (int h2 = 0; h2 < 2; ++h2) { const int rg = bt + h2, ai = rg >> 2, m = rg & 3; const size_t off = (size_t)(row0 + ai * 128 + m * 16) * D + col0;
                    f32x4 xa[2][2];
#pragma unroll
                    for (int bj = 0; bj < 2; ++bj) { xa[bj][0] = *(const f32x4*)(xin32 + off + bj * 128); xa[bj][1] = *(const f32x4*)(xin32 + off + bj * 128 + 4); }
#pragma unroll
                    for (int bj = 0; bj < 2; ++bj) { const f32x4 x0 = xa[bj][0] + g[bj][0] * acc[ai][bj][m][0], x1 = xa[bj][1] + g[bj][1] * acc[ai][bj][m][1];
                        u32x4 o; o.x = cvt_pk_bf16(x0[0], x0[1]); o.y = cvt_pk_bf16(x0[2], x0[3]); o.z = cvt_pk_bf16(x1[0], x1[1]); o.w = cvt_pk_bf16(x1[2], x1[3]);
                        *(u32x4*)(X + off + bj * 128) = o; }
                    asm volatile("" ::: "memory"); }
            } else {
                u32x4 xh[2][2];
#pragma unroll
                for (int mm = 0; mm < 2; ++mm) { const int rg = bt + mm, ai = rg >> 2, m = rg & 3; const size_t off = (size_t)(row0 + ai * 128 + m * 16) * D + col0;
#pragma unroll
                    for (int bj = 0; bj < 2; ++bj) xh[mm][bj] = *(const u32x4*)(X + off + bj * 128); }
#pragma unroll
                for (int mm = 0; mm < 2; ++mm) { const int rg = bt + mm, ai = rg >> 2, m = rg & 3; const size_t off = (size_t)(row0 + ai * 128 + m * 16) * D + col0;
#pragma unroll
                    for (int bj = 0; bj < 2; ++bj) { const u32x4 w = xh[mm][bj];
                        f32x4 x0 = (f32x4){bf_lo(w.x), bf_hi(w.x), bf_lo(w.y), bf_hi(w.y)}, x1 = (f32x4){bf_lo(w.z), bf_hi(w.z), bf_lo(w.w), bf_hi(w.w)};
                        x0 = x0 + g[bj][0] * acc[ai][bj][m][0]; x1 = x1 + g[bj][1] * acc[ai][bj][m][1];
                        u32x4 o; o.x = cvt_pk_bf16(x0[0], x0[1]); o.y = cvt_pk_bf16(x0[2], x0[3]); o.z = cvt_pk_bf16(x1[0], x1[1]); o.w = cvt_pk_bf16(x1[2], x1[3]);
                        *(u32x4*)(X + off + bj * 128) = o; } }
                asm volatile("" ::: "memory");
            }
        }
    }
};

struct MoeTab { const LAS int* lcnt; const LAS int* ltoff; };
DI bool moe_decode(const MoeTab& T, int tile, Unit& u) {
    int itot = NCLS; asm volatile("" : "+v"(itot));
    const int tot = __builtin_amdgcn_readfirstlane(T.ltoff[itot]); if (tile >= tot) return false;
    int ln; asm volatile("v_mbcnt_lo_u32_b32 %0, -1, 0\n\tv_mbcnt_hi_u32_b32 %0, -1, %0" : "=v"(ln));
    const int lo = T.ltoff[ln < NCLS ? ln : 0];
    const int c = __builtin_popcountll(__ballot(ln >= 1 && ln < NCLS && tile >= lo));
    u.cls = c; u.pm = __builtin_amdgcn_readfirstlane(tile - T.ltoff[c]); u.cnt = __builtin_amdgcn_readfirstlane(T.lcnt[c]); u.rowpos = tile * 256; return true;
}
DI void cls_experts(int cls, int& eA, int& eB) { const int g = cls / 6, p = cls % 6; const int lo = p < 3 ? 0 : (p < 5 ? 1 : 2), hi = p < 3 ? p + 1 : (p < 5 ? p - 1 : 3); eA = 4 * g + lo; eB = 4 * g + hi; }

struct PMoe1 {
    static constexpr int NT = 8, LDA = 1024, LDB = 1024, AIOFF = 0, TMID = -1; static constexpr bool PERM = true, HAS_MID = false, FP8 = true;
    struct Adr { unsigned tb; unsigned b; };
    static constexpr bool HAS_DONE = true, DMA_ADDR = true;
    const char* wsb; LAS unsigned char* lds; int l; MoeTab T; int G, c, W; unsigned* ctr; int Tl;
    DI bool next(int i, Unit& u) const { const int x = c & 7, j = c >> 3;
        u.seq = i;
        if (G != 256) { const int L0 = i * G + c; if (!moe_decode(T, L0 >> 3, u)) return false; u.pn = L0 & 7; return true; }
        const int U = i * 32 + j, tau = U >> 3; if (tau >= Tl) return false;
        if (!moe_decode(T, tau * 8 + x, u)) return false; u.pn = U & 7; return true; }
    DI void done(const Unit& u) const { asm volatile("s_waitcnt vmcnt(0)" ::: "memory");
        if ((ltid(W) & 63) == 0) (void)__hip_atomic_fetch_add(ctr + (u.seq < 8 ? 0 : 1), 1u, __ATOMIC_RELAXED, __HIP_MEMORY_SCOPE_AGENT); }
    DI void addr(const Unit& u, Adr& r) const {
        const int* list = (const int*)(wsb + WS_LIST); const int tid = ltid(W), wv_ = __builtin_amdgcn_readfirstlane(tid >> 6);
        int R, C; pg::stage_rc(tid * 16, R, C); (void)C;
        r.tb = (unsigned)(LDS_IDT + (u.seq & 1) * 8192);
        const int* lp = list + (size_t)u.cls * M + u.pm * 256 + R;
#pragma unroll
        for (int k = 0; k < 4; ++k) __builtin_amdgcn_global_load_lds((const unsigned*)(lp + 64 * k), (LAS unsigned*)(lds + r.tb + k * 2048 + wv_ * 256), 4, 0, 0);
        if (wv_ < 4) { const float* wp = (const float*)(wsb + WS_WL) + ((size_t)u.cls * M + u.pm * 256 + tid) * 2;
            LAS unsigned char* wt = lds + LDS_AUX + 9216 + (u.seq % 3) * 2048;
            __builtin_amdgcn_global_load_lds((const unsigned*)wp, (LAS unsigned*)(wt + wv_ * 256), 4, 0, 0);
            __builtin_amdgcn_global_load_lds((const unsigned*)(wp + 1), (LAS unsigned*)(wt + 1024 + wv_ * 256), 4, 0, 0); }
        int eA, eB; cls_experts(u.cls, eA, eB); const int e = (u.pn >> 2) ? eB : eA, q = u.pn & 3;
        r.b = (unsigned)WS_WG + (unsigned)((e * DE + 128 * q) * 1024);
    }
    DI unsigned abase(const Adr&, int, int t) const { return (unsigned)t * 128u; }
    DI unsigned apre(const Adr& r, int h) const { const LAS unsigned* tp = (const LAS unsigned*)(lds + r.tb + h * 4096 + ltid(W) * 4); return (tp[0] & 0xffffu) | (tp[512] << 16); }
    DI unsigned avoff(const Adr&, int, int i, unsigned v, unsigned pk) const { const unsigned tok = (pk >> (16 * i)) & 0xffffu; return (unsigned)WS_AB + tok * 1024u + (tok >> 12) * (unsigned)H2_BX + (v & 127u); }
    DI unsigned bbase(const Adr& r, int h, int t) const { return r.b + (unsigned)h * (unsigned)(WS_WU - WS_WG) + (unsigned)t * 128u; }
    DI void epi(const Acc& acc, const Unit& u, int wr, int wc, int fr, int fq) const {
        unsigned char* ACT = (unsigned char*)(wsb + WS_Z); const LAS float* wt = (const LAS float*)(lds + LDS_AUX + 9216 + (u.seq % 3) * 2048);
        const int k = u.pn >> 2, q = u.pn & 3;
        const int r0 = wr * 64 + fr, colw = k * 512 + 128 * q + wc * 32 + 8 * fq;
        float wv[2][4];
#pragma unroll
        for (int ai = 0; ai < 2; ++ai)
#pragma unroll
            for (int m = 0; m < 4; ++m) { const int rr_ = r0 + ai * 128 + m * 16; const float w_ = wt[k * 256 + rr_]; wv[ai][m] = (u.pm * 256 + rr_ < u.cnt) ? w_ : 0.f; }
#pragma unroll
        for (int ai = 0; ai < 2; ++ai)
#pragma unroll
            for (int m = 0; m < 4; ++m) {
                const int rit = r0 + ai * 128 + m * 16; const float w = wv[ai][m];
                constexpr float qs = 1.f / (S8_ACT * S8_W);
                const f32x4 g0 = acc[ai][0][m][0] * qs, g1 = acc[ai][0][m][1] * qs, u0 = acc[ai][1][m][0] * (qs * w), u1 = acc[ai][1][m][1] * (qs * w);
                u32x2 o;
                o.x = pk_fp8x4(silu(g0[0]) * u0[0], silu(g0[1]) * u0[1], silu(g0[2]) * u0[2], silu(g0[3]) * u0[3], S8_ACT2);
                o.y = pk_fp8x4(silu(g1[0]) * u1[0], silu(g1[1]) * u1[1], silu(g1[2]) * u1[2], silu(g1[3]) * u1[3], S8_ACT2);
                *(u32x2*)(ACT + (size_t)(u.rowpos + rit) * 1024 + colw) = o;
            }
    }
};
struct PMoe2 {
    static constexpr int NT = 8, LDA = 1024, LDB = 512, AIOFF = 64 * 1024, TMID = -1; static constexpr bool PERM = true, HAS_MID = false, FP8 = true;
    struct Adr { unsigned a, b; int b2off; };
    static constexpr bool DMA_ADDR = true;
    const char* wsb; LAS unsigned char* lds; int l; MoeTab T; int G, c, W; int hstart, nH, nL;
    DI bool next(int i, Unit& u) const { const int x = c & 7; u.seq = i;
        if (G != 256) { const int L0 = i * G + c; if (!moe_decode(T, L0 >> 2, u)) return false; u.pn = L0 & 3; return true; }
        if (i >= nH) return false;
        const int e = hstart + i, V = e < nL ? 128 + e : e - nL;
        if (!moe_decode(T, (V >> 2) * 8 + x, u)) return false; u.pn = V & 3; return true; }
    DI void addr(const Unit& u, Adr& r) const {
        { const int tid = ltid(W), wv_ = __builtin_amdgcn_readfirstlane(tid >> 6);
          if (wv_ < 4) __builtin_amdgcn_global_load_lds((const unsigned*)((const int*)(wsb + WS_LIST) + (size_t)u.cls * M + u.pm * 256 + tid), (LAS unsigned*)(lds + LDS_AUX + 1024 + (u.seq % 3) * 1024 + wv_ * 256), 4, 0, 0); }
        r.a = (unsigned)WS_Z + (unsigned)u.rowpos * 1024u;
        int eA, eB; cls_experts(u.cls, eA, eB);
        r.b = (unsigned)WS_WD + (unsigned)((eA * D + u.pn * 256) * 512); r.b2off = (eB - eA) * (D * 512) - 4 * 128;
    }
    DI unsigned abase(const Adr& r, int h, int t) const { return r.a + (unsigned)(h * 128 * 1024) + (unsigned)t * 128u; }
    DI unsigned apre(const Adr&, int) const { return 0u; }
    DI unsigned avoff(const Adr&, int, int, unsigned v, unsigned) const { return v; }
    DI unsigned bbase(const Adr& r, int h, int t) const { return r.b + (unsigned)(h * 128 * 512) + (unsigned)t * 128u + (t >= 4 ? (unsigned)r.b2off : 0u); }
    DI void epi(const Acc& acc, const Unit& u, int wr, int wc, int fr, int fq) const {
        const LAS int* idt = (const LAS int*)(lds + LDS_AUX + 1024 + (u.seq % 3) * 1024); const float* gt = (const float*)(wsb + WS_MOD) + (size_t)l * 16 * 6144 + 5120; bf16_t* X = (bf16_t*)(wsb + WS_X16);
        const int r0 = wr * 64 + fr, col0 = u.pn * 256 + wc * 32 + 8 * fq;
        int tk[2][4];
#pragma unroll
        for (int ai = 0; ai < 2; ++ai)
#pragma unroll
            for (int m = 0; m < 4; ++m) { const int rr_ = r0 + ai * 128 + m * 16; const int id = idt[rr_] & 0xffff; tk[ai][m] = (u.pm * 256 + rr_ < u.cnt) ? id : -1; }
#pragma unroll
        for (int am = 0; am < 4; ++am) {
            const int ai = am >> 1;
            u32x4 xw[2][2]; f32x4 gw[2][2][2];
#pragma unroll
            for (int mm = 0; mm < 2; ++mm) { const int tok = tk[ai][2 * (am & 1) + mm]; const int tks = tok < 0 ? 0 : tok;
                const bf16_t* xp = X + (size_t)tks * D + col0; const float* gp = gt + (size_t)(tks >> 12) * 6144 + col0;
#pragma unroll
                for (int bj = 0; bj < 2; ++bj) { xw[mm][bj] = *(const u32x4*)(xp + bj * 128); gw[mm][bj][0] = *(const f32x4*)(gp + bj * 128); gw[mm][bj][1] = *(const f32x4*)(gp + bj * 128 + 4); } }
#pragma unroll
            for (int mm = 0; mm < 2; ++mm) { const int m = 2 * (am & 1) + mm; const int tok = tk[ai][m];
                if (tok >= 0) { bf16_t* xp = X + (size_t)tok * D + col0;
#pragma unroll
                    for (int bj = 0; bj < 2; ++bj) { const u32x4 w = xw[mm][bj]; const f32x4 g0 = gw[mm][bj][0], g1 = gw[mm][bj][1];
                        const f32x4 a0 = acc[ai][bj][m][0] * (1.f / (S8_ACT2 * S8_W)), a1 = acc[ai][bj][m][1] * (1.f / (S8_ACT2 * S8_W)); u32x4 o;
                        o.x = cvt_pk_bf16(bf_lo(w.x) + g0[0] * a0[0], bf_hi(w.x) + g0[1] * a0[1]); o.y = cvt_pk_bf16(bf_lo(w.y) + g0[2] * a0[2], bf_hi(w.y) + g0[3] * a0[3]);
                        o.z = cvt_pk_bf16(bf_lo(w.z) + g1[0] * a1[0], bf_hi(w.z) + g1[1] * a1[1]); o.w = cvt_pk_bf16(bf_lo(w.w) + g1[2] * a1[2], bf_hi(w.w) + g1[3] * a1[3]);
                        *(u32x4*)(xp + bj * 128) = o; } } }
            asm volatile("" ::: "memory");
        }
    }
};

struct Params {
    const float *x, *c, *w_ada, *b_ada, *g_norm1, *g_norm2, *w_in, *lb_logits, *g_hgrn, *g_ret, *w_branch_a, *w_branch_b, *w_out, *w_router, *b_router, *w_exp_gate, *w_exp_up, *w_exp_down, *g_final;
    float* out; unsigned char* ws;
};

struct TDesc { const float* src; bf16_t* dst; int K, N, ldd, dcol0, map, f8; };
DI void t_item(const TDesc& d, int item, LAS float* scr, int lane) {
    const int nblk = d.N / 32, kb = item / nblk, nb = item % nblk, k0 = 64 * kb, n0 = 32 * nb;
    const int nsrc = d.map ? src_col_in(n0 + (lane & 31)) : n0 + (lane & 31);
#pragma unroll
    for (int hh = 0; hh < 2; ++hh) {
        float tv[16];
#pragma unroll
        for (int i = 0; i < 16; ++i) { const int kk = 2 * (16 * hh + i) + (lane >> 5); tv[i] = d.src[(size_t)(k0 + kk) * d.N + nsrc]; }
#pragma unroll
        for (int i = 0; i < 16; ++i) { const int kk = 2 * (16 * hh + i) + (lane >> 5); scr[kk * 33 + (lane & 31)] = tv[i]; }
        asm volatile("" ::: "memory"); }
    LDS_WAIT(); asm volatile("" ::: "memory");
    const int c = lane & 7;
#pragma unroll
    for (int j = 0; j < 4; ++j) { const int n = (lane >> 3) + 8 * j; const LAS float* s = scr + (8 * c) * 33 + n;
        const int nslot = ((n >> 2) & 1) * 16 + (n >> 3) * 4 + (n & 3);
        if (d.f8) { u32x2 o; o.x = pk_fp8x4(s[0 * 33], s[1 * 33], s[2 * 33], s[3 * 33], S8_W); o.y = pk_fp8x4(s[4 * 33], s[5 * 33], s[6 * 33], s[7 * 33], S8_W);
            *(u32x2*)((unsigned char*)d.dst + (size_t)(n0 + nslot) * d.ldd + d.dcol0 + k0 + 8 * c) = o; }
        else { u32x4 o; o.x = cvt_pk_bf16(s[0 * 33], s[1 * 33]); o.y = cvt_pk_bf16(s[2 * 33], s[3 * 33]); o.z = cvt_pk_bf16(s[4 * 33], s[5 * 33]); o.w = cvt_pk_bf16(s[6 * 33], s[7 * 33]);
            *(u32x4*)(d.dst + (size_t)(n0 + nslot) * d.ldd + d.dcol0 + k0 + 8 * c) = o; } }
    LDS_WAIT(); asm volatile("" ::: "memory");
}
constexpr int IT_WIN = 16 * 224, IT_WA = 8 * 32, IT_WB = 16 * 32, IT_WO = 16 * 32, IT_E = 256, IT_NE = IT_WIN + IT_WA + IT_WB + IT_WO, IT_LAYER = IT_NE + NE * 3 * IT_E, IT_ALL = DEPTH * IT_LAYER;
DI void t_dispatch(const Params& p, int it, LAS float* scr, int lane) {
    const int l = it / IT_LAYER; int r = it % IT_LAYER; unsigned char* ws = p.ws; TDesc d;
    if (r < IT_WIN) { d = TDesc{p.w_in + (size_t)l * D * NIN, (bf16_t*)(ws + WS_WIN + (size_t)l * NIN * D), D, NIN, D, 0, 1, 1}; t_item(d, r, scr, lane); return; } r -= IT_WIN;
    if (r < IT_WA) { d = TDesc{p.w_branch_a + (size_t)l * 512 * D, (bf16_t*)(ws + WS_WAB + (size_t)l * D * KAB * (FP8_DE ? 1 : 2)), 512, D, KAB, 0, 0, FP8_DE}; t_item(d, r, scr, lane); return; } r -= IT_WA;
    if (r < IT_WB) { d = TDesc{p.w_branch_b + (size_t)l * D * D, (bf16_t*)(ws + WS_WAB + (size_t)l * D * KAB * (FP8_DE ? 1 : 2)), D, D, KAB, 512, 0, FP8_DE}; t_item(d, r, scr, lane); return; } r -= IT_WB;
    if (r < IT_WO) { d = TDesc{p.w_out + (size_t)l * D * D, (bf16_t*)(ws + WS_WOUT + (size_t)l * D * D * (FP8_DE ? 1 : 2)), D, D, D, 0, 0, FP8_DE}; t_item(d, r, scr, lane); return; } r -= IT_WO;
    const int e = r / (3 * IT_E), k = (r % (3 * IT_E)) / IT_E, ii = r % IT_E; const size_t le = (size_t)l * NE + e;
    if (k == 0) d = TDesc{p.w_exp_gate + le * D * DE, (bf16_t*)(ws + WS_WG + (size_t)e * DE * D), D, DE, D, 0, 0, 1};
    else if (k == 1) d = TDesc{p.w_exp_up + le * D * DE, (bf16_t*)(ws + WS_WU + (size_t)e * DE * D), D, DE, D, 0, 0, 1};
    else d = TDesc{p.w_exp_down + le * DE * D, (bf16_t*)(ws + WS_WD + (size_t)e * D * DE), DE, D, DE, 0, 0, 1};
    t_item(d, ii, scr, lane);
}
DI void mod_item(const Params& p, int item, LAS unsigned char* lds, int W) {
    const int tid = ltid(W), wave = __builtin_amdgcn_readfirstlane(tid >> 6), lane = tid & 63;
    LAS float* cact = (LAS float*)lds;
    LAS float* red = (LAS float*)(lds + 65536);
    for (int i = tid; i < NB * D; i += 512) { const int b = i >> 10, k = i & 1023; cact[k * 16 + b] = silu(p.c[i]); }
    __syncthreads();
    const int l = item / 96, col = (item % 96) * 64 + lane;
    const float* w = p.w_ada + (size_t)l * D * 6144 + col;
    float acc[16];
#pragma unroll
    for (int b = 0; b < 16; ++b) acc[b] = 0.f;
    for (int k = wave * 128; k < wave * 128 + 128; ++k) {
        const float wv = w[(size_t)k * 6144];
        const LAS f32x4* cp = (const LAS f32x4*)(cact + k * 16);
#pragma unroll
        for (int q = 0; q < 4; ++q) { const f32x4 cv = cp[q];
#pragma unroll
            for (int j = 0; j < 4; ++j) acc[4 * q + j] += cv[j] * wv; }
    }
#pragma unroll
    for (int b = 0; b < 16; ++b) red[(wave * 16 + b) * 64 + lane] = acc[b];
    __syncthreads();
    float* mod = (float*)(p.ws + WS_MOD);
    for (int i = tid; i < 1024; i += 512) { const int b = i >> 6, ln = i & 63; float s = 0.f;
#pragma unroll
        for (int wv = 0; wv < 8; ++wv) s += red[(wv * 16 + b) * 64 + ln];
        const int cc = (item % 96) * 64 + ln; mod[((size_t)l * 16 + b) * 6144 + cc] = s + p.b_ada[(size_t)l * 6144 + cc]; }
    __syncthreads();
}
DI void phase_prologue(const Params& p, LAS unsigned char* lds, int W) {
    const int tid = ltid(W), wave = __builtin_amdgcn_readfirstlane(tid >> 6), lane = tid & 63, G = lgrid();
    const int gt = lbid() * 512 + tid, ngt = G * 512;
    f32x2* rot = (f32x2*)(p.ws + WS_ROT);
    for (int base = 0; base < SEQ * 64; base += ngt) { const int i = base + gt;
        if (i < SEQ * 64) { const int s = i >> 6, k = i & 63;
            const float inv = exp2f(-(float)k * (13.287712379549449f / 64.f)); const float ang = (float)s * inv;
            double rev = (double)ang * 0.15915494309189535; rev -= floor(rev); const float rv = (float)rev;
            rot[i] = (f32x2){__builtin_amdgcn_cosf(rv), __builtin_amdgcn_sinf(rv)}; } }
    float* lbt = (float*)(p.ws + WS_LBT);
    if (gt < 512) { const float a = p.lb_logits[gt], b = p.lb_logits[512 + gt], mx = fmaxf(a, b), ea = __expf(a - mx), eb = __expf(b - mx); lbt[gt] = 0.f; lbt[512 + gt] = eb / (ea + eb); }
    for (int item = lbid(); item < 192; item += G) mod_item(p, item, lds, W);
    LAS float* scr = (LAS float*)(lds + wave * 16384);
    for (int it = lbid() * 8 + wave; it < IT_LAYER + IT_NE; it += G * 8) t_dispatch(p, it, scr, lane);
}

DI void load_xrow(const float* x32, const bf16_t* x16, size_t r, int lane, f32x4 (&v)[4]) {
    if (x32) {
#pragma unroll
        for (int j = 0; j < 4; ++j) v[j] = *(const f32x4*)(x32 + r * D + 4 * lane + 256 * j);
    } else {
#pragma unroll
        for (int j = 0; j < 4; ++j) { const u32x2 w = *(const u32x2*)(x16 + r * D + 4 * lane + 256 * j); v[j] = (f32x4){bf_lo(w.x), bf_hi(w.x), bf_lo(w.y), bf_hi(w.y)}; }
    }
}
DI void phase_norm1(const Params& p, const float* x32, int l, int W) {
    const int tid = ltid(W), wave = __builtin_amdgcn_readfirstlane(tid >> 6), lane = tid & 63, gw = lbid() * 8 + wave, ngw = lgrid() * 8;
    const float* mod = (const float*)(p.ws + WS_MOD) + (size_t)l * 16 * 6144; bf16_t* H = (bf16_t*)(p.ws + WS_H); const bf16_t* X = (const bf16_t*)(p.ws + WS_X16);
    for (int blk = lbid(); blk < M / 256; blk += lgrid()) {
        const int r0 = (32 * (blk & 7) + (blk >> 3)) * 256 + wave * 32; (void)gw; (void)ngw;
        const int b = r0 >> 12; const float* mb = mod + (size_t)b * 6144;
        f32x4 gs[4], sh[4];
#pragma unroll
        for (int j = 0; j < 4; ++j) { const int c = 4 * lane + 256 * j; const f32x4 g = *(const f32x4*)(p.g_norm1 + (size_t)l * D + c), sc = *(const f32x4*)(mb + 1024 + c); gs[j] = g * (sc + 1.f); sh[j] = *(const f32x4*)(mb + c); }
        for (int r = r0; r < r0 + 32; r += 2) {
            f32x4 v[2][4];
            load_xrow(x32, X, (size_t)r, lane, v[0]); load_xrow(x32, X, (size_t)r + 1, lane, v[1]);
#pragma unroll
            for (int q = 0; q < 2; ++q) { float ss = 0.f;
#pragma unroll
                for (int j = 0; j < 4; ++j) ss += (v[q][j].x * v[q][j].x + v[q][j].y * v[q][j].y) + (v[q][j].z * v[q][j].z + v[q][j].w * v[q][j].w);
                const float rs = rsqrtf(wave_sum(ss) * (1.f / D) + EPS);
#pragma unroll
                for (int j = 0; j < 4; ++j) { const f32x4 h = v[q][j] * rs * gs[j] + sh[j]; *(unsigned*)((unsigned char*)H + (size_t)(r + q) * D + 4 * lane + 256 * j) = pk_fp8x4(h.x, h.y, h.z, h.w, S8_ACT); } }
        }
    }
}
DI void phase_norm2(const Params& p, int l, LAS unsigned char* lds, int W) {
    const int tid = ltid(W), wave = __builtin_amdgcn_readfirstlane(tid >> 6), lane = tid & 63;
    const float* mod = (const float*)(p.ws + WS_MOD) + (size_t)l * 16 * 6144; bf16_t* H2 = (bf16_t*)(p.ws + WS_AB);
    LAS float* wrl = (LAS float*)lds;
    LAS int* whist = (LAS int*)(lds + 65536);
    unsigned* gcnt = (unsigned*)(p.ws + WS_CTL) + CW_CNT + l * 32; int* list = (int*)(p.ws + WS_LIST); f32x2* wl = (f32x2*)(p.ws + WS_WL);
#pragma unroll 4
    for (int i0 = 0; i0 < D * NE; i0 += 512) { const int i = i0 + tid; wrl[(i & 15) * 1024 + (i >> 4)] = p.w_router[i]; }
    for (int blk = lbid(); blk < M / 256; blk += lgrid()) {
        __syncthreads();
        const int r0 = (32 * (blk & 7) + (blk >> 3)) * 256 + wave * 32, b = r0 >> 12; const float* mb = mod + (size_t)b * 6144;
        f32x4 gs[4], sh[4];
#pragma unroll
        for (int j = 0; j < 4; ++j) { const int c = 4 * lane + 256 * j; const f32x4 g = *(const f32x4*)(p.g_norm2 + (size_t)l * D + c), sc = *(const f32x4*)(mb + 4096 + c); gs[j] = g * (sc + 1.f); sh[j] = *(const f32x4*)(mb + 3072 + c); }
        const bf16_t* X = (const bf16_t*)(p.ws + WS_X16);
        LAS float* lg = (LAS float*)(lds + 65536 + 4096) + wave * 512;
        f32x4 vn[2][4];
        load_xrow(nullptr, X, (size_t)r0, lane, vn[0]); load_xrow(nullptr, X, (size_t)r0 + 1, lane, vn[1]);
        for (int rr = 0; rr < 32; rr += 2) {
            const int r = r0 + rr; f32x4 v[2][4]; float ss[2] = {0.f, 0.f};
#pragma unroll
            for (int q = 0; q < 2; ++q)
#pragma unroll
                for (int j = 0; j < 4; ++j) { v[q][j] = vn[q][j]; ss[q] += (v[q][j].x * v[q][j].x + v[q][j].y * v[q][j].y) + (v[q][j].z * v[q][j].z + v[q][j].w * v[q][j].w); }
            if (rr + 2 < 32) { load_xrow(nullptr, X, (size_t)r + 2, lane, vn[0]); load_xrow(nullptr, X, (size_t)r + 3, lane, vn[1]); }
#pragma unroll
            for (int q = 0; q < 2; ++q) { const float rs = rsqrtf(wave_sum(ss[q]) * (1.f / D) + EPS);
#pragma unroll
                for (int j = 0; j < 4; ++j) { v[q][j] = v[q][j] * rs * gs[j] + sh[j]; *(unsigned*)((unsigned char*)H2 + (size_t)(r + q) * D + (size_t)((r + q) >> 12) * H2_BX + 4 * lane + 256 * j) = pk_fp8x4(v[q][j].x, v[q][j].y, v[q][j].z, v[q][j].w, S8_ACT); } }
            float p0[16], p1[16];
#pragma unroll
            for (int e = 0; e < 16; ++e) { float s0 = 0.f, s1 = 0.f;
#pragma unroll
                for (int j = 0; j < 4; ++j) { const f32x4 w = *(const LAS f32x4*)(wrl + e * 1024 + 4 * lane + 256 * j);
                    s0 += (v[0][j].x * w.x + v[0][j].y * w.y) + (v[0][j].z * w.z + v[0][j].w * w.w); s1 += (v[1][j].x * w.x + v[1][j].y * w.y) + (v[1][j].z * w.z + v[1][j].w * w.w); }
                p0[e] = s0; p1[e] = s1; }
            const float t0 = reduce16(p0, lane), t1 = reduce16(p1, lane);
            if ((lane & 3) == 0) { lg[rr * 16 + (lane >> 2)] = t0; lg[(rr + 1) * 16 + (lane >> 2)] = t1; }
        }
        float keep[16];
#pragma unroll
        for (int e = 0; e < 16; ++e) keep[e] = 0.f;
        if (lane < 32) {
#pragma unroll
            for (int e4 = 0; e4 < 4; ++e4) { const f32x4 k4 = *(const LAS f32x4*)(lg + lane * 16 + 4 * e4); keep[4 * e4] = k4.x; keep[4 * e4 + 1] = k4.y; keep[4 * e4 + 2] = k4.z; keep[4 * e4 + 3] = k4.w; } }
        int cls = -1; float wA = 0.f, wB = 0.f;
        if (lane < 32) {
            float sc[16], bi[16];
#pragma unroll
            for (int e = 0; e < 16; ++e) { sc[e] = 1.f / (1.f + expf(-keep[e])); bi[e] = sc[e] + p.b_router[e]; }
            float best = -1e30f; int gsel = 0, i1s = 0, i2s = 1; float w1s = 0.f, w2s = 0.f;
#pragma unroll
            for (int g = 0; g < 4; ++g) {
                int i1 = 0; float m1 = bi[4 * g];
#pragma unroll
                for (int j = 1; j < 4; ++j) if (bi[4 * g + j] > m1) { m1 = bi[4 * g + j]; i1 = j; }
                int i2 = -1; float m2 = -1e30f;
#pragma unroll
                for (int j = 0; j < 4; ++j) if (j != i1 && bi[4 * g + j] > m2) { m2 = bi[4 * g + j]; i2 = j; }
                float s1 = 0.f, s2 = 0.f;
#pragma unroll
                for (int j = 0; j < 4; ++j) { s1 = (j == i1) ? sc[4 * g + j] : s1; s2 = (j == i2) ? sc[4 * g + j] : s2; }
                const float gsum = m1 + m2;
                if (gsum > best) { best = gsum; gsel = g; i1s = i1; i2s = i2; w1s = s1; w2s = s2; }
            }
            const float inv = 1.f / (w1s + w2s); w1s *= inv; w2s *= inv;
            const int lo = i1s < i2s ? i1s : i2s, hi = i1s < i2s ? i2s : i1s;
            wA = i1s < i2s ? w1s : w2s; wB = i1s < i2s ? w2s : w1s;
            const int pidx = lo == 0 ? hi - 1 : (lo == 1 ? hi + 1 : 5);
            cls = 6 * gsel + pidx;
        }
        int locw = 0, mycnt = 0;
#pragma unroll 1
        for (int c = 0; c < NCLS; ++c) { const unsigned long long mk = __ballot(cls == c); const int n = __popcll(mk);
            if (cls == c) locw = __popcll(mk & ((1ull << lane) - 1ull)); if (lane == c) mycnt = n; }
        { int lq = lane; asm volatile("" : "+v"(lq)); if (lane < 32) whist[wave * 32 + lq] = mycnt; }
        __syncthreads();
        if (tid < 32) { int t = 0;
            for (int w = 0; w < 8; ++w) t += whist[w * 32 + tid];
            int tq = tid; asm volatile("" : "+v"(tq));
            whist[256 + tid] = (tid < NCLS && t > 0) ? (int)atomicAdd(&gcnt[tq], (unsigned)t) : 0; }
        __syncthreads();
        if (lane < 32) { int pre = whist[256 + cls];
            for (int w = 0; w < wave; ++w) pre += whist[w * 32 + cls];
            const int slot = pre + locw; list[(size_t)cls * M + slot] = r0 + lane; wl[(size_t)cls * M + slot] = (f32x2){wA, wB}; }
        __syncthreads();
    }
}
DI void phase_final(const Params& p, int W) {
    const int tid = ltid(W), wave = __builtin_amdgcn_readfirstlane(tid >> 6), lane = tid & 63, gw = lbid() * 8 + wave, ngw = lgrid() * 8;
    const bf16_t* X = (const bf16_t*)(p.ws + WS_X16);
    f32x4 g[4];
#pragma unroll
    for (int j = 0; j < 4; ++j) g[j] = *(const f32x4*)(p.g_final + 4 * lane + 256 * j);
    for (int r0 = gw * 2; r0 < M; r0 += ngw * 2) {
        f32x4 v[2][4];
        load_xrow(nullptr, X, (size_t)r0, lane, v[0]); load_xrow(nullptr, X, (size_t)r0 + 1, lane, v[1]);
#pragma unroll
        for (int q = 0; q < 2; ++q) { float ss = 0.f;
#pragma unroll
            for (int j = 0; j < 4; ++j) ss += (v[q][j].x * v[q][j].x + v[q][j].y * v[q][j].y) + (v[q][j].z * v[q][j].z + v[q][j].w * v[q][j].w);
            const float rs = rsqrtf(wave_sum(ss) * (1.f / D) + EPS);
#pragma unroll
            for (int j = 0; j < 4; ++j) *(f32x4*)(p.out + (size_t)(r0 + q) * D + 4 * lane + 256 * j) = v[q][j] * rs * g[j]; }
    }
}

DI void hgrn_v0_item(const Params& p, int item, int W) {
    const int tid = ltid(W), dg = tid & 15, vv = tid >> 4;
    const int bh = item >> 2, vs = item & 3, b = bh >> 2, h = bh & 3;
    const bf16_t* Z = (const bf16_t*)(p.ws + WS_Z) + (size_t)b * SEQ * NZA; bf16_t* AB = (bf16_t*)(p.ws + WS_AB) + (size_t)b * SEQ * KAB;
    const int dcol = h * 128 + dg * 8, vcol = h * 128 + vs * 32 + vv;
    float s[8];
#pragma unroll
    for (int i = 0; i < 8; ++i) s[i] = 0.f;
    u32x4 qn = *(const u32x4*)(Z + ZQ + dcol), gn = *(const u32x4*)(Z + ZG2 + dcol); bf16_t vn = Z[ZI + vcol];
    for (int t = 0; t < SEQ; ++t) {
        const u32x4 qc = qn, gc = gn; const float val = bf2f(vn);
        if (t + 1 < SEQ) { const bf16_t* zr = Z + (size_t)(t + 1) * NZA; qn = *(const u32x4*)(zr + ZQ + dcol); gn = *(const u32x4*)(zr + ZG2 + dcol); vn = zr[ZI + vcol]; }
        const unsigned qw[4] = {qc.x, qc.y, qc.z, qc.w}, gw[4] = {gc.x, gc.y, gc.z, gc.w};
        float o = 0.f;
#pragma unroll
        for (int i = 0; i < 4; ++i) {
            const float f0 = exp2f(h2f((unsigned short)(gw[i] & 0xffff))), f1 = exp2f(h2f((unsigned short)(gw[i] >> 16)));
            s[2 * i] = f0 * s[2 * i] + (1.f - f0) * val; s[2 * i + 1] = f1 * s[2 * i + 1] + (1.f - f1) * val;
            o += bf_lo(qw[i]) * s[2 * i] + bf_hi(qw[i]) * s[2 * i + 1];
        }
        o = sum16(o);
        if (dg == 0) AB[(size_t)t * KAB + vcol] = (bf16_t)(cvt_pk_bf16(o, 0.f) & 0xffff);
    }
}
DI void ret_v0_item(const Params& p, int item, LAS unsigned char* lds, int W) {
    const int tid = ltid(W);
    const int bh = item >> 3, vs = item & 7, b = bh >> 2, h = bh & 3;
    const bf16_t* Z = (const bf16_t*)(p.ws + WS_Z) + (size_t)b * SEQ * NZA; bf16_t* AB = (bf16_t*)(p.ws + WS_AB) + (size_t)b * SEQ * KAB;
    LAS float* qs = (LAS float*)lds;
    LAS float* ks = qs + 64 * 129;
    LAS float* vsm = ks + 64 * 129;
    LAS float* sc = vsm + 64 * 33;
    LAS float* S = sc + 64 * 65;
    const float lg = log2f(1.f - exp2f(-5.f - (float)h));
    for (int i = tid; i < 128 * 33; i += 512) S[i] = 0.f;
    __syncthreads();
    for (int n = 0; n < SEQ / 64; ++n) {
        const bf16_t* zc = Z + (size_t)n * 64 * NZA;
        for (int i = tid; i < 64 * 128; i += 512) { const int j = i >> 7, d = i & 127; qs[j * 129 + d] = bf2f(zc[(size_t)j * NZA + ZQR + h * 128 + d]); ks[j * 129 + d] = bf2f(zc[(size_t)j * NZA + ZKR + h * 128 + d]); }
        for (int i = tid; i < 64 * 32; i += 512) { const int j = i >> 5, v = i & 31; vsm[j * 33 + v] = bf2f(zc[(size_t)j * NZA + ZV + h * 256 + vs * 32 + v]); }
        __syncthreads();
        for (int i = tid; i < 64 * 64; i += 512) { const int j = i >> 6, l2 = i & 63; float a = 0.f;
            for (int d = 0; d < 128; ++d) a += qs[j * 129 + d] * ks[l2 * 129 + d];
            const int dd = j > l2 ? j - l2 : l2 - j; sc[j * 65 + l2] = a * exp2f(lg * (float)dd); }
        __syncthreads();
        for (int i = tid; i < 64 * 32; i += 512) { const int j = i >> 5, v = i & 31; float a = 0.f, c2 = 0.f;
            for (int l2 = 0; l2 < 64; ++l2) a += sc[j * 65 + l2] * vsm[l2 * 33 + v];
            for (int d = 0; d < 128; ++d) c2 += qs[j * 129 + d] * S[d * 33 + v];
            a += c2 * exp2f(lg * (float)(j + 1));
            AB[(size_t)(n * 64 + j) * KAB + 512 + h * 256 + vs * 32 + v] = (bf16_t)(cvt_pk_bf16(a, 0.f) & 0xffff); }
        __syncthreads();
        for (int i = tid; i < 128 * 32; i += 512) { const int d = i >> 5, v = i & 31; float a = S[d * 33 + v] * exp2f(lg * 64.f);
            for (int l2 = 0; l2 < 64; ++l2) a += ks[l2 * 129 + d] * exp2f(lg * (float)(63 - l2)) * vsm[l2 * 33 + v];
            S[d * 33 + v] = a; }
        __syncthreads();
    }
}
DI void phase_scan_v0(const Params& p, LAS unsigned char* lds, int W) {
    for (int it = lbid(); it < 256 + 512; it += lgrid()) {
        if (it < 256) hgrn_v0_item(p, it, W); else ret_v0_item(p, it - 256, lds, W);
        __syncthreads();
    }
}
DI void phase_headnorm(const Params& p, int l, int W) {
    const int tid = ltid(W), wave = __builtin_amdgcn_readfirstlane(tid >> 6), lane = tid & 63, gw = lbid() * 8 + wave, ngw = lgrid() * 8;
    bf16_t* AB = (bf16_t*)(p.ws + WS_AB);
    float ga[8], gb[16];
#pragma unroll
    for (int i = 0; i < 8; ++i) ga[i] = p.g_hgrn[(size_t)l * 512 + 8 * lane + i];
#pragma unroll
    for (int i = 0; i < 16; ++i) gb[i] = p.g_ret[(size_t)l * 1024 + 16 * lane + i];
    for (int r = gw; r < M; r += ngw) {
        bf16_t* row = AB + (size_t)r * KAB;
        { const u32x4 w = *(const u32x4*)(row + 8 * lane); float v[8] = {bf_lo(w.x), bf_hi(w.x), bf_lo(w.y), bf_hi(w.y), bf_lo(w.z), bf_hi(w.z), bf_lo(w.w), bf_hi(w.w)};
          float ss = 0.f;
#pragma unroll
          for (int i = 0; i < 8; ++i) ss += v[i] * v[i];
          ss = sum16(ss);
          const float rs = rsqrtf(ss * (1.f / 128.f) + EPS);
          u32x4 o; o.x = cvt_pk_bf16(v[0] * rs * ga[0], v[1] * rs * ga[1]); o.y = cvt_pk_bf16(v[2] * rs * ga[2], v[3] * rs * ga[3]); o.z = cvt_pk_bf16(v[4] * rs * ga[4], v[5] * rs * ga[5]); o.w = cvt_pk_bf16(v[6] * rs * ga[6], v[7] * rs * ga[7]);
          *(u32x4*)(row + 8 * lane) = o; }
        { const u32x4 w0 = *(const u32x4*)(row + 512 + 16 * lane), w1 = *(const u32x4*)(row + 512 + 16 * lane + 8);
          float v[16] = {bf_lo(w0.x), bf_hi(w0.x), bf_lo(w0.y), bf_hi(w0.y), bf_lo(w0.z), bf_hi(w0.z), bf_lo(w0.w), bf_hi(w0.w), bf_lo(w1.x), bf_hi(w1.x), bf_lo(w1.y), bf_hi(w1.y), bf_lo(w1.z), bf_hi(w1.z), bf_lo(w1.w), bf_hi(w1.w)};
          float sm = 0.f;
#pragma unroll
          for (int i = 0; i < 16; ++i) sm += v[i];
          sm = sum16(sm);
          const float mu = sm * (1.f / 256.f); float ss = 0.f;
#pragma unroll
          for (int i = 0; i < 16; ++i) { v[i] -= mu; ss += v[i] * v[i]; }
          ss = sum16(ss);
          const float rs = rsqrtf(ss * (1.f / 256.f) + EPS);
          u32x4 o0, o1;
          o0.x = cvt_pk_bf16(v[0] * rs * gb[0], v[1] * rs * gb[1]); o0.y = cvt_pk_bf16(v[2] * rs * gb[2], v[3] * rs * gb[3]); o0.z = cvt_pk_bf16(v[4] * rs * gb[4], v[5] * rs * gb[5]); o0.w = cvt_pk_bf16(v[6] * rs * gb[6], v[7] * rs * gb[7]);
          o1.x = cvt_pk_bf16(v[8] * rs * gb[8], v[9] * rs * gb[9]); o1.y = cvt_pk_bf16(v[10] * rs * gb[10], v[11] * rs * gb[11]); o1.z = cvt_pk_bf16(v[12] * rs * gb[12], v[13] * rs * gb[13]); o1.w = cvt_pk_bf16(v[14] * rs * gb[14], v[15] * rs * gb[15]);
          *(u32x4*)(row + 512 + 16 * lane) = o0; *(u32x4*)(row + 512 + 16 * lane + 8) = o1; }
    }
}

typedef short s16x4 __attribute__((ext_vector_type(4)));
typedef float f32x16 __attribute__((ext_vector_type(16)));
DI unsigned xrow(unsigned row) { return ((row & 3) << 2) | ((row >> 2) & 3); }
DI unsigned off_b(unsigned row, unsigned ch) { return 256u * row + 16u * (ch ^ xrow(row)); }
DI unsigned off_p(unsigned row, unsigned ch) { return 128u * row + 16u * (ch ^ ((row >> 1) & 7)); }
DI unsigned row_addr16(unsigned lane, unsigned rb, unsigned s) { return off_b(16 * rb + (lane & 15), 4 * s + (lane >> 4)); }
DI unsigned tr_addr32(unsigned lane, unsigned c, unsigned ks, unsigned t) {
    const unsigned h = lane >> 5, blk = (lane >> 4) & 1, q = (lane & 15) >> 2, pp = lane & 3;
    return off_b(16 * ks + 8 * h + 4 * t + q, 4 * c + 2 * blk + (pp >> 1)) + 8 * (pp & 1);
}
struct LaneAddr { unsigned trt[2], trq, r16[4], qb, qx2, qx0, pp[4]; };
DI void lane_addr(int lane, LaneAddr& A) {
    const unsigned h = lane >> 5, blk = (lane >> 4) & 1, q = (lane & 15) >> 2, p4 = lane & 3, u = 2 * blk + (p4 >> 1);
#pragma unroll
    for (unsigned t = 0; t < 2; ++t) A.trt[t] = 2048 * h + 1024 * t + 256 * q + 16 * (u ^ ((2 * h + t) & 3)) + 8 * (p4 & 1);
    A.trq = q;
    const unsigned l15 = lane & 15, q4 = lane >> 4, x15 = xrow(l15);
#pragma unroll
    for (unsigned s2 = 0; s2 < 4; ++s2) A.r16[s2] = 256 * l15 + 64 * (s2 ^ (x15 >> 2)) + 16 * (q4 ^ (x15 & 3));
    const unsigned r = lane & 31, xr = xrow(r);
    A.qb = 256 * r + 8 * h; A.qx2 = xr >> 2; A.qx0 = xr & 3;
    const unsigned xp = (r >> 1) & 7;
#pragma unroll
    for (unsigned ks = 0; ks < 4; ++ks) A.pp[ks] = 128 * r + 16 * ((2 * ks + h) ^ xp);
}
#define TRA(A, c, ks, t) ((A).trt[t] + 64u * ((unsigned)(c) ^ (A).trq) + 4096u * (ks))
#define QBA(A, jb, db, k) ((A).qb + 64u * ((unsigned)(db) ^ (A).qx2) + 16u * ((unsigned)(k) ^ (A).qx0) + 8192u * (jb))
DI bf16x8 tr_frag(const LAS unsigned char* img, unsigned a0, unsigned a1) {
    const s16x4 lo = __builtin_amdgcn_ds_read_tr16_b64_v4i16((LAS s16x4*)(img + a0));
    const s16x4 hi = __builtin_amdgcn_ds_read_tr16_b64_v4i16((LAS s16x4*)(img + a1));
    return __builtin_shufflevector(lo, hi, 0, 1, 2, 3, 4, 5, 6, 7);
}
DI bf16x8 pack8(const f32x16& x, int s) {
    u32x4 w; w.x = cvt_pk_bf16(x[8 * s + 0], x[8 * s + 1]); w.y = cvt_pk_bf16(x[8 * s + 2], x[8 * s + 3]); w.z = cvt_pk_bf16(x[8 * s + 4], x[8 * s + 5]); w.w = cvt_pk_bf16(x[8 * s + 6], x[8 * s + 7]);
    return __builtin_bit_cast(bf16x8, w);
}
DI bf16x8 cat8(u32x2 a, u32x2 b) { u32x4 w; w.x = a.x; w.y = a.y; w.z = b.x; w.w = b.y; return __builtin_bit_cast(bf16x8, w); }
#define MFMA32(a, b, c) __builtin_amdgcn_mfma_f32_32x32x16_bf16((a), (b), (c), 0, 0, 0)
#define MFMA16(a, b, c) __builtin_amdgcn_mfma_f32_16x16x32_bf16((a), (b), (c), 0, 0, 0)
#define GLDS16(src, dst) __builtin_amdgcn_global_load_lds((const unsigned*)(src), (LAS unsigned*)(dst), 16, 0, 0)
#define LBAR() asm volatile("s_waitcnt lgkmcnt(0)\n\ts_barrier" ::: "memory")
DI int crow(int reg, int h) { return (reg & 3) + 8 * (reg >> 2) + 4 * h; }
DI float ex2(float x) { return __builtin_amdgcn_exp2f(x); }

DI void ret_chain(const Params& p, int l, int chain, LAS unsigned char* lds, int n_lo, int n_hi, int n_full, int W) {
    const int tid = ltid(W), wave = __builtin_amdgcn_readfirstlane(tid >> 6), lane0 = tid & 63;
    const int b = chain >> 2, hd = chain & 3;
    const float lg = log2f(1.f - exp2f(-5.f - (float)hd));
    const char* wsb = (const char*)p.ws; const unsigned zoff = (unsigned)WS_Z + (unsigned)chain * (unsigned)(SEQ * 1024);
    bf16_t* ABb = (bf16_t*)(p.ws + WS_AB) + (size_t)b * SEQ * KAB + 512 + hd * 256;
    LAS unsigned char* Qimg = lds; LAS unsigned char* Kimg = lds + 16384; LAS unsigned char* Pimg = lds + 65536; LAS unsigned char* stg = lds + 73728;
    LAS float* gl = (LAS float*)(lds + 107520);
    if (tid < 256) gl[tid] = p.g_ret[(size_t)l * 1024 + hd * 256 + tid];
    unsigned goff[2]; float kf[2];
#pragma unroll
    for (int i = 0; i < 2; ++i) { const unsigned idx = tid + 512 * i, row = idx >> 4, ch = (idx & 15) ^ xrow(row); goff[i] = row * 1024 + ch * 16; kf[i] = ex2(lg * (float)(63 - (int)row)); }
    f32x16 S[4];
#pragma unroll
    for (int d = 0; d < 4; ++d)
#pragma unroll
        for (int e = 0; e < 16; ++e) S[d][e] = 0.f;
    u32x4 R[4][2];
#define RET_LOAD(n_) do { const unsigned zc_ = zoff + (unsigned)(n_) * (unsigned)(64 * 1024); \
        _Pragma("unroll") for (int i_ = 0; i_ < 2; ++i_) { \
            R[0][i_] = *(const u32x4*)(wsb + (size_t)(unsigned)(zc_ + goff[i_])); R[1][i_] = *(const u32x4*)(wsb + (size_t)(unsigned)(zc_ + 256 + goff[i_])); \
            R[2][i_] = *(const u32x4*)(wsb + (size_t)(unsigned)(zc_ + 512 + goff[i_])); R[3][i_] = *(const u32x4*)(wsb + (size_t)(unsigned)(zc_ + 768 + goff[i_])); } } while (0)
#define RET_WRITE() do { _Pragma("unroll") for (int i_ = 0; i_ < 2; ++i_) { const unsigned o_ = (tid + 512 * i_) * 16; const float f_ = kf[i_]; const u32x4 v_ = R[1][i_]; u32x4 k_; \
            k_.x = cvt_pk_bf16(bf_lo(v_.x) * f_, bf_hi(v_.x) * f_); k_.y = cvt_pk_bf16(bf_lo(v_.y) * f_, bf_hi(v_.y) * f_); k_.z = cvt_pk_bf16(bf_lo(v_.z) * f_, bf_hi(v_.z) * f_); k_.w = cvt_pk_bf16(bf_lo(v_.w) * f_, bf_hi(v_.w) * f_); \
            *(LAS u32x4*)(lds + o_) = R[0][i_]; *(LAS u32x4*)(lds + 16384 + o_) = k_; *(LAS u32x4*)(lds + 32768 + o_) = R[2][i_]; *(LAS u32x4*)(lds + 49152 + o_) = R[3][i_]; } } while (0)
#define RET_LN(n_) do { const int row_ = tid >> 3, seg_ = tid & 7; const LAS u32x4* sp_ = (const LAS u32x4*)(stg + row_ * 528 + seg_ * 64); \
          float v_[32]; float sm_ = 0.f; \
          _Pragma("unroll") for (int k = 0; k < 4; ++k) { const u32x4 w = sp_[k]; v_[8 * k] = bf_lo(w.x); v_[8 * k + 1] = bf_hi(w.x); v_[8 * k + 2] = bf_lo(w.y); v_[8 * k + 3] = bf_hi(w.y); v_[8 * k + 4] = bf_lo(w.z); v_[8 * k + 5] = bf_hi(w.z); v_[8 * k + 6] = bf_lo(w.w); v_[8 * k + 7] = bf_hi(w.w); } \
          _Pragma("unroll") for (int k = 0; k < 32; ++k) sm_ += v_[k]; \
          sm_ += swz_xor<1>(sm_); sm_ += swz_xor<2>(sm_); sm_ += swz_xor<4>(sm_); \
          const float mu_ = sm_ * (1.f / 256.f); float ss_ = 0.f; \
          _Pragma("unroll") for (int k = 0; k < 32; ++k) { v_[k] -= mu_; ss_ += v_[k] * v_[k]; } \
          ss_ += swz_xor<1>(ss_); ss_ += swz_xor<2>(ss_); ss_ += swz_xor<4>(ss_); \
          const float rs_ = rsqrtf(ss_ * (1.f / 256.f) + EPS); \
          bf16_t* op_ = ABb + (size_t)((n_) * 64 + row_) * KAB + seg_ * 32; const LAS float* gp_ = gl + seg_ * 32; \
          _Pragma("unroll") for (int k = 0; k < 4; ++k) { const f32x4 g0 = *(const LAS f32x4*)(gp_ + 8 * k), g1 = *(const LAS f32x4*)(gp_ + 8 * k + 4); u32x4 o; \
              o.x = cvt_pk_bf16(v_[8 * k] * rs_ * g0[0], v_[8 * k + 1] * rs_ * g0[1]); o.y = cvt_pk_bf16(v_[8 * k + 2] * rs_ * g0[2], v_[8 * k + 3] * rs_ * g0[3]); \
              o.z = cvt_pk_bf16(v_[8 * k + 4] * rs_ * g1[0], v_[8 * k + 5] * rs_ * g1[1]); o.w = cvt_pk_bf16(v_[8 * k + 6] * rs_ * g1[2], v_[8 * k + 7] * rs_ * g1[3]); \
              *(u32x4*)(op_ + 8 * k) = o; } } while (0)
    if (n_full > n_lo) {
        u32x4 KV[3][3][2];
#pragma unroll
        for (int b3 = 0; b3 < 3; ++b3) if (n_lo + b3 < n_full) { const unsigned zc = zoff + (unsigned)(n_lo + b3) * (unsigned)(64 * 1024);
#pragma unroll
            for (int i = 0; i < 2; ++i) { KV[b3][0][i] = *(const u32x4*)(wsb + (size_t)(unsigned)(zc + 256 + goff[i])); KV[b3][1][i] = *(const u32x4*)(wsb + (size_t)(unsigned)(zc + 512 + goff[i])); KV[b3][2][i] = *(const u32x4*)(wsb + (size_t)(unsigned)(zc + 768 + goff[i])); } }
        const float g64 = ex2(lg * 64.f);
#pragma unroll 1
        for (int n = n_lo; n < n_full; n += 3) {
#pragma unroll
            for (int b3 = 0; b3 < 3; ++b3) { const int nn = n + b3;
                if (nn < n_full) {
#pragma unroll
                    for (int i = 0; i < 2; ++i) { const unsigned o = (tid + 512 * i) * 16; const float f = kf[i]; const u32x4 v = KV[b3][0][i]; u32x4 k;
                        k.x = cvt_pk_bf16(bf_lo(v.x) * f, bf_hi(v.x) * f); k.y = cvt_pk_bf16(bf_lo(v.y) * f, bf_hi(v.y) * f); k.z = cvt_pk_bf16(bf_lo(v.z) * f, bf_hi(v.z) * f); k.w = cvt_pk_bf16(bf_lo(v.w) * f, bf_hi(v.w) * f);
                        *(LAS u32x4*)(lds + 16384 + o) = k; *(LAS u32x4*)(lds + 32768 + o) = KV[b3][1][i]; *(LAS u32x4*)(lds + 49152 + o) = KV[b3][2][i]; }
                    if (nn + 3 < n_full) { const unsigned zc = zoff + (unsigned)(nn + 3) * (unsigned)(64 * 1024);
#pragma unroll
                        for (int i = 0; i < 2; ++i) { KV[b3][0][i] = *(const u32x4*)(wsb + (size_t)(unsigned)(zc + 256 + goff[i])); KV[b3][1][i] = *(const u32x4*)(wsb + (size_t)(unsigned)(zc + 512 + goff[i])); KV[b3][2][i] = *(const u32x4*)(wsb + (size_t)(unsigned)(zc + 768 + goff[i])); } }
                    LBAR();
                    { int lane = lane0; asm volatile("" : "+v"(lane)); LaneAddr LA; lane_addr(lane, LA);
                      const LAS unsigned char* Vimg = lds + 32768 + (wave >> 2) * 16384; const int vc = wave & 3;
                      bf16x8 Vf[4], Ka[2][4];
#pragma unroll
                      for (int ks = 0; ks < 4; ++ks) Vf[ks] = tr_frag(Vimg, TRA(LA, vc, ks, 0), TRA(LA, vc, ks, 1));
#pragma unroll
                      for (int ks = 0; ks < 4; ++ks) Ka[0][ks] = tr_frag(Kimg, TRA(LA, 0, ks, 0), TRA(LA, 0, ks, 1));
#pragma unroll
                      for (int db = 0; db < 4; ++db) {
                          if (db < 3) {
#pragma unroll
                              for (int ks = 0; ks < 4; ++ks) Ka[(db + 1) & 1][ks] = tr_frag(Kimg, TRA(LA, db + 1, ks, 0), TRA(LA, db + 1, ks, 1)); }
                          __builtin_amdgcn_sched_barrier(0);
#pragma unroll
                          for (int e = 0; e < 16; ++e) S[db][e] *= g64;
#pragma unroll
                          for (int ks = 0; ks < 4; ++ks) S[db] = MFMA32(Ka[db & 1][ks], Vf[ks], S[db]);
                          __builtin_amdgcn_sched_barrier(0); } }
                    LBAR();
                } }
        }
        n_lo = n_full;
    }
    RET_LOAD(n_lo); RET_WRITE(); if (n_lo + 1 < n_hi) RET_LOAD(n_lo + 1);
    __syncthreads();
#pragma unroll 1
    for (int n = n_lo; n < n_hi; ++n) {
        int lane = lane0; asm volatile("" : "+v"(lane));
        const int r = lane & 31, h5 = lane >> 5;
        const bool full = n >= n_full;
        LaneAddr LA; lane_addr(lane, LA);
        if (n > n_lo && n - 1 >= n_full) RET_LN(n - 1);
        if (full) { const int lt = wave >> 1, q4 = lane >> 4;
#pragma unroll
          for (int jj = 0; jj < 2; ++jj) { const int jt = 2 * (wave & 1) + jj; f32x4 acc = {0.f, 0.f, 0.f, 0.f};
#pragma unroll
              for (int s2 = 0; s2 < 4; ++s2) { const bf16x8 a = *(const LAS bf16x8*)(Kimg + LA.r16[s2] + 4096 * lt); const bf16x8 bq = *(const LAS bf16x8*)(Qimg + LA.r16[s2] + 4096 * jt); acc = MFMA16(a, bq, acc); }
              const int j = 16 * jt + (lane & 15); float pv[4];
#pragma unroll
              for (int e = 0; e < 4; ++e) { const int lq = 16 * lt + 4 * q4 + e; const int ex = j >= lq ? j - 63 : 2 * lq - j - 63; pv[e] = acc[e] * ex2(lg * (float)ex); }
              u32x2 w; w.x = cvt_pk_bf16(pv[0], pv[1]); w.y = cvt_pk_bf16(pv[2], pv[3]);
              *(LAS u32x2*)(Pimg + off_p(j, 2 * lt + (q4 >> 1)) + 8 * (q4 & 1)) = w; } }
        LBAR();
        const LAS unsigned char* Vimg = lds + 32768 + (wave >> 2) * 16384; const int vc = wave & 3;
#define SB0 __builtin_amdgcn_sched_barrier(0)
        bf16x8 Vf[4];
#pragma unroll
        for (int ks = 0; ks < 4; ++ks) Vf[ks] = tr_frag(Vimg, TRA(LA, vc, ks, 0), TRA(LA, vc, ks, 1));
        f32x16 O[2];
#pragma unroll
        for (int jb = 0; jb < 2; ++jb)
#pragma unroll
            for (int e = 0; e < 16; ++e) O[jb][e] = 0.f;
        bf16x8 Ka[2][4];
        if (full) {
        u32x2 qa[2][2][2];
#define RET_QLOAD(buf, st) do { _Pragma("unroll") for (int jb_ = 0; jb_ < 2; ++jb_) { qa[buf][jb_][0] = *(const LAS u32x2*)(Qimg + QBA(LA, jb_, (st) >> 1, 2 * ((st) & 1))); qa[buf][jb_][1] = *(const LAS u32x2*)(Qimg + QBA(LA, jb_, (st) >> 1, 2 * ((st) & 1) + 1)); } } while (0)
        RET_QLOAD(0, 0);
#pragma unroll
        for (int st = 0; st < 8; ++st) {
            if (st < 7) { if (st & 1) RET_QLOAD(0, st + 1); else RET_QLOAD(1, st + 1); }
            SB0;
            const bf16x8 sb = pack8(S[st >> 1], st & 1);
#pragma unroll
            for (int jb = 0; jb < 2; ++jb) O[jb] = MFMA32(cat8(qa[st & 1][jb][0], qa[st & 1][jb][1]), sb, O[jb]);
            SB0;
        }
        bf16x8 Pf[2][4];
#pragma unroll
        for (int jb = 0; jb < 2; ++jb)
#pragma unroll
            for (int ks = 0; ks < 4; ++ks) Pf[jb][ks] = *(const LAS bf16x8*)(Pimg + LA.pp[ks] + 4096 * jb);
#pragma unroll
        for (int ks = 0; ks < 4; ++ks) Ka[0][ks] = tr_frag(Kimg, TRA(LA, 0, ks, 0), TRA(LA, 0, ks, 1));
        SB0;
#pragma unroll
        for (int jb = 0; jb < 2; ++jb)
#pragma unroll
            for (int e = 0; e < 16; ++e) O[jb][e] *= ex2(lg * (float)(32 * jb + crow(e, h5) + 1));
#pragma unroll
        for (int jb = 0; jb < 2; ++jb)
#pragma unroll
            for (int ks = 0; ks < 4; ++ks) O[jb] = MFMA32(Pf[jb][ks], Vf[ks], O[jb]);
        } else {
#pragma unroll
            for (int ks = 0; ks < 4; ++ks) Ka[0][ks] = tr_frag(Kimg, TRA(LA, 0, ks, 0), TRA(LA, 0, ks, 1));
        }
        { const float g64 = ex2(lg * 64.f);
#pragma unroll
          for (int db = 0; db < 4; ++db) {
              if (db < 3) {
#pragma unroll
                  for (int ks = 0; ks < 4; ++ks) Ka[(db + 1) & 1][ks] = tr_frag(Kimg, TRA(LA, db + 1, ks, 0), TRA(LA, db + 1, ks, 1)); }
              SB0;
#pragma unroll
              for (int e = 0; e < 16; ++e) S[db][e] *= g64;
#pragma unroll
              for (int ks = 0; ks < 4; ++ks) S[db] = MFMA32(Ka[db & 1][ks], Vf[ks], S[db]);
              SB0; } }
#undef RET_QLOAD
        LBAR();
        if (full)
#pragma unroll
        for (int jb = 0; jb < 2; ++jb)
#pragma unroll
            for (int e = 0; e < 16; ++e) *(LAS bf16_t*)(stg + (32 * jb + crow(e, h5)) * 528 + (32 * wave + r) * 2) = (bf16_t)(cvt_pk_bf16(O[jb][e], 0.f) & 0xffff);
        if (n + 1 < n_hi) { RET_WRITE(); if (n + 2 < n_hi) RET_LOAD(n + 2); }
        LBAR();
    }
    RET_LN(n_hi - 1);
    __syncthreads();
#undef RET_LOAD
#undef RET_WRITE
#undef RET_LN
}

DI void hgrn_chain(const Params& p, int l, int chain, LAS unsigned char* lds, int n_lo, int n_hi, int n_full, int W) {
    const int tid = ltid(W), wave = __builtin_amdgcn_readfirstlane(tid >> 6), lane0 = tid & 63;
    const int b = chain >> 2, hd = chain & 3;
    const char* wsb = (const char*)p.ws; const unsigned zoff = (unsigned)(WS_Z + HZ_OFF) + (unsigned)chain * (unsigned)(SEQ * 768);
    bf16_t* ABb = (bf16_t*)(p.ws + WS_AB) + (size_t)b * SEQ * KAB + hd * 128;
    LAS unsigned char* Vimg = lds; LAS unsigned char* Qimg = lds + 16384; LAS unsigned char* Kimg = lds + 32768; LAS unsigned char* Pimg = lds + 49152; LAS unsigned char* stg = Qimg;
    LAS float* tot = (LAS float*)(lds + 57344);
    LAS float* eref = (LAS float*)(lds + 61440); LAS float* e2t = (LAS float*)(lds + 61952); LAS float* gl = (LAS float*)(lds + 62464);
    if (tid < 128) gl[tid] = p.g_hgrn[(size_t)l * 512 + hd * 128 + tid];
    const int vb = wave & 3, jb = wave >> 2;
    unsigned gq, gv[2];
    gq = (unsigned)(8 * wave) * 768u + (unsigned)(4 * lane0);
#pragma unroll
    for (int i = 0; i < 2; ++i) { const unsigned idx = tid + 512 * i, row = idx >> 4, sl = idx & 15; gv[i] = row * 768u + 512u + (sl ^ xrow(row)) * 16; }
    f32x16 S[4];
#pragma unroll
    for (int d = 0; d < 4; ++d)
#pragma unroll
        for (int e = 0; e < 16; ++e) S[d][e] = 0.f;
    unsigned Qr[8], Gr[8]; u32x4 Vr[2];
#define HG_LOADQG(n_) do { const unsigned zc_ = zoff + (unsigned)(n_) * (unsigned)(64 * 768) + gq; \
        _Pragma("unroll") for (int i_ = 0; i_ < 8; ++i_) { Qr[i_] = *(const unsigned*)(wsb + (size_t)(unsigned)(zc_ + i_ * 768)); Gr[i_] = *(const unsigned*)(wsb + (size_t)(unsigned)(zc_ + i_ * 768 + 256)); } } while (0)
#define HG_LOADV(n_) do { const unsigned zc_ = zoff + (unsigned)(n_) * (unsigned)(64 * 768); \
        _Pragma("unroll") for (int i_ = 0; i_ < 2; ++i_) Vr[i_] = *(const u32x4*)(wsb + (size_t)(unsigned)(zc_ + gv[i_])); } while (0)
#define HG_WRITEV() do { _Pragma("unroll") for (int i_ = 0; i_ < 2; ++i_) *(LAS u32x4*)(Vimg + (tid + 512 * i_) * 16) = Vr[i_]; } while (0)
#define HG_LN(n_) do { const int row_ = tid >> 3, seg_ = tid & 7; const LAS u32x4* sp_ = (const LAS u32x4*)(stg + row_ * 272 + seg_ * 32); \
          float v_[16]; float ss_ = 0.f; \
          _Pragma("unroll") for (int k = 0; k < 2; ++k) { const u32x4 w = sp_[k]; v_[8 * k] = bf_lo(w.x); v_[8 * k + 1] = bf_hi(w.x); v_[8 * k + 2] = bf_lo(w.y); v_[8 * k + 3] = bf_hi(w.y); v_[8 * k + 4] = bf_lo(w.z); v_[8 * k + 5] = bf_hi(w.z); v_[8 * k + 6] = bf_lo(w.w); v_[8 * k + 7] = bf_hi(w.w); } \
          _Pragma("unroll") for (int k = 0; k < 16; ++k) ss_ += v_[k] * v_[k]; \
          ss_ += swz_xor<1>(ss_); ss_ += swz_xor<2>(ss_); ss_ += swz_xor<4>(ss_); \
          const float rs_ = rsqrtf(ss_ * (1.f / 128.f) + EPS); \
          bf16_t* op_ = ABb + (size_t)((n_) * 64 + row_) * KAB + seg_ * 16; const LAS float* gp_ = gl + seg_ * 16; \
          _Pragma("unroll") for (int k = 0; k < 2; ++k) { const f32x4 g0 = *(const LAS f32x4*)(gp_ + 8 * k), g1 = *(const LAS f32x4*)(gp_ + 8 * k + 4); u32x4 o; \
              o.x = cvt_pk_bf16(v_[8 * k] * rs_ * g0[0], v_[8 * k + 1] * rs_ * g0[1]); o.y = cvt_pk_bf16(v_[8 * k + 2] * rs_ * g0[2], v_[8 * k + 3] * rs_ * g0[3]); \
              o.z = cvt_pk_bf16(v_[8 * k + 4] * rs_ * g1[0], v_[8 * k + 5] * rs_ * g1[1]); o.w = cvt_pk_bf16(v_[8 * k + 6] * rs_ * g1[2], v_[8 * k + 7] * rs_ * g1[3]); \
              *(u32x4*)(op_ + 8 * k) = o; } } while (0)
    if (n_full > n_lo) {
        unsigned G3[2][8]; u32x4 V3[2][2];
#pragma unroll
        for (int b3 = 0; b3 < 2; ++b3) if (n_lo + b3 < n_full) { const unsigned zc = zoff + (unsigned)(n_lo + b3) * (unsigned)(64 * 768);
#pragma unroll
            for (int i = 0; i < 8; ++i) G3[b3][i] = *(const unsigned*)(wsb + (size_t)(unsigned)(zc + gq + i * 768 + 256));
#pragma unroll
            for (int i = 0; i < 2; ++i) V3[b3][i] = *(const u32x4*)(wsb + (size_t)(unsigned)(zc + gv[i])); }
#pragma unroll 1
        for (int n = n_lo; n < n_full; n += 2) {
#pragma unroll
            for (int b3 = 0; b3 < 2; ++b3) { const int nn = n + b3;
                if (nn < n_full) {
                    int lane = lane0; asm volatile("" : "+v"(lane)); const int h5 = lane >> 5, cp = lane;
                    LaneAddr LA; lane_addr(lane, LA);
                    float c0[8], c1[8];
                    { float a0 = 0.f, a1 = 0.f;
#pragma unroll
                      for (int i = 0; i < 8; ++i) { a0 += h2f((unsigned short)(G3[b3][i] & 0xffff)); a1 += h2f((unsigned short)(G3[b3][i] >> 16)); c0[i] = a0; c1[i] = a1; }
                      *(LAS f32x2*)(tot + wave * 128 + 2 * cp) = (f32x2){a0, a1}; }
#pragma unroll
                    for (int i = 0; i < 2; ++i) *(LAS u32x4*)(Vimg + (tid + 512 * i) * 16) = V3[b3][i];
                    LBAR();
                    { float o0 = 0.f, o1 = 0.f, rf0 = 0.f, rf1 = 0.f, t0 = 0.f, t1 = 0.f;
#pragma unroll
                      for (int t = 0; t < 8; ++t) { const f32x2 v = *(const LAS f32x2*)(tot + t * 128 + 2 * cp); if (t < wave) { o0 += v.x; o1 += v.y; } if (t < 4) { rf0 += v.x; rf1 += v.y; } t0 += v.x; t1 += v.y; }
                      if (wave == 0) { *(LAS f32x2*)(eref + 2 * cp) = (f32x2){ex2(rf0), ex2(rf1)}; *(LAS f32x2*)(e2t + 2 * cp) = (f32x2){ex2(t0 - rf0), ex2(t1 - rf1)}; }
#pragma unroll
                      for (int i = 0; i < 8; ++i) { const int tok = 8 * wave + i;
                          const float g0 = h2f((unsigned short)(G3[b3][i] & 0xffff)), g1 = h2f((unsigned short)(G3[b3][i] >> 16));
                          const float cu0 = o0 + c0[i], cu1 = o1 + c1[i];
                          const float k0 = (1.f - ex2(g0)) * ex2(fminf(rf0 - cu0, 120.f)), k1 = (1.f - ex2(g1)) * ex2(fminf(rf1 - cu1, 120.f));
                          *(LAS unsigned*)(Kimg + off_b(tok, cp >> 2) + (cp & 3) * 4) = cvt_pk_bf16(k0, k1); } }
                    if (nn + 2 < n_full) { const unsigned zc = zoff + (unsigned)(nn + 2) * (unsigned)(64 * 768);
#pragma unroll
                        for (int i = 0; i < 8; ++i) G3[b3][i] = *(const unsigned*)(wsb + (size_t)(unsigned)(zc + gq + i * 768 + 256));
#pragma unroll
                        for (int i = 0; i < 2; ++i) V3[b3][i] = *(const u32x4*)(wsb + (size_t)(unsigned)(zc + gv[i])); }
                    LBAR();
                    { bf16x8 Vf[4], Ka[2][4];
#pragma unroll
                      for (int ks = 0; ks < 4; ++ks) Vf[ks] = tr_frag(Vimg, TRA(LA, vb, ks, 0), TRA(LA, vb, ks, 1));
#pragma unroll
                      for (int ks = 0; ks < 4; ++ks) Ka[0][ks] = tr_frag(Kimg, TRA(LA, 0, ks, 0), TRA(LA, 0, ks, 1));
#pragma unroll
                      for (int db = 0; db < 4; ++db) {
                          f32x4 fe[4];
#pragma unroll
                          for (int g = 0; g < 4; ++g) fe[g] = *(const LAS f32x4*)(eref + 32 * db + 8 * g + 4 * h5);
                          if (db < 3) {
#pragma unroll
                              for (int ks = 0; ks < 4; ++ks) Ka[(db + 1) & 1][ks] = tr_frag(Kimg, TRA(LA, db + 1, ks, 0), TRA(LA, db + 1, ks, 1)); }
                          __builtin_amdgcn_sched_barrier(0);
#pragma unroll
                          for (int g = 0; g < 4; ++g)
#pragma unroll
                              for (int e = 0; e < 4; ++e) S[db][4 * g + e] *= fe[g][e];
#pragma unroll
                          for (int g = 0; g < 4; ++g) fe[g] = *(const LAS f32x4*)(e2t + 32 * db + 8 * g + 4 * h5);
#pragma unroll
                          for (int ks = 0; ks < 4; ++ks) S[db] = MFMA32(Ka[db & 1][ks], Vf[ks], S[db]);
#pragma unroll
                          for (int g = 0; g < 4; ++g)
#pragma unroll
                              for (int e = 0; e < 4; ++e) S[db][4 * g + e] *= fe[g][e];
                          __builtin_amdgcn_sched_barrier(0); } }
                    LBAR();
                } }
        }
        n_lo = n_full;
    }
    HG_LOADQG(n_lo); HG_LOADV(n_lo); HG_WRITEV(); if (n_lo + 1 < n_hi) HG_LOADV(n_lo + 1);
    __syncthreads();
#pragma unroll 1
    for (int n = n_lo; n < n_hi; ++n) {
        const bool full = n >= n_full;
        int lane = lane0; asm volatile("" : "+v"(lane));
        const int r = lane & 31, h5 = lane >> 5, cp = lane;
        LaneAddr LA; lane_addr(lane, LA);
        float c0[8], c1[8];
        { float a0 = 0.f, a1 = 0.f;
#pragma unroll
          for (int i = 0; i < 8; ++i) { a0 += h2f((unsigned short)(Gr[i] & 0xffff)); a1 += h2f((unsigned short)(Gr[i] >> 16)); c0[i] = a0; c1[i] = a1; }
          *(LAS f32x2*)(tot + wave * 128 + 2 * cp) = (f32x2){a0, a1}; }
        if (n > n_lo && n - 1 >= n_full) HG_LN(n - 1);
        LBAR();
        { float o0 = 0.f, o1 = 0.f, rf0 = 0.f, rf1 = 0.f, t0 = 0.f, t1 = 0.f;
#pragma unroll
          for (int t = 0; t < 8; ++t) { const f32x2 v = *(const LAS f32x2*)(tot + t * 128 + 2 * cp); if (t < wave) { o0 += v.x; o1 += v.y; } if (t < 4) { rf0 += v.x; rf1 += v.y; } t0 += v.x; t1 += v.y; }
          if (wave == 0) { *(LAS f32x2*)(eref + 2 * cp) = (f32x2){ex2(rf0), ex2(rf1)}; *(LAS f32x2*)(e2t + 2 * cp) = (f32x2){ex2(t0 - rf0), ex2(t1 - rf1)}; }
#pragma unroll
          for (int i = 0; i < 8; ++i) { const int tok = 8 * wave + i;
              const float g0 = h2f((unsigned short)(Gr[i] & 0xffff)), g1 = h2f((unsigned short)(Gr[i] >> 16));
              const float cu0 = o0 + c0[i], cu1 = o1 + c1[i];
              const float q0 = bf_lo(Qr[i]) * ex2(cu0 - rf0), q1 = bf_hi(Qr[i]) * ex2(cu1 - rf1);
              const float k0 = (1.f - ex2(g0)) * ex2(fminf(rf0 - cu0, 120.f)), k1 = (1.f - ex2(g1)) * ex2(fminf(rf1 - cu1, 120.f));
              const unsigned a = off_b(tok, cp >> 2) + (cp & 3) * 4;
              *(LAS unsigned*)(Qimg + a) = cvt_pk_bf16(q0, q1); *(LAS unsigned*)(Kimg + a) = cvt_pk_bf16(k0, k1); } }
        if (n + 1 < n_hi) HG_LOADQG(n + 1);
        LBAR();
        if (full) { const int lt = wave >> 1, q4 = lane >> 4;
#pragma unroll
          for (int jj = 0; jj < 2; ++jj) { const int jt = 2 * (wave & 1) + jj; f32x4 acc = {0.f, 0.f, 0.f, 0.f};
#pragma unroll
              for (int s2 = 0; s2 < 4; ++s2) { const bf16x8 a = *(const LAS bf16x8*)(Kimg + LA.r16[s2] + 4096 * lt); const bf16x8 bq = *(const LAS bf16x8*)(Qimg + LA.r16[s2] + 4096 * jt); acc = MFMA16(a, bq, acc); }
              const int j = 16 * jt + (lane & 15); float pv[4];
#pragma unroll
              for (int e = 0; e < 4; ++e) { const int lq = 16 * lt + 4 * q4 + e; pv[e] = (lq <= j) ? acc[e] : 0.f; }
              u32x2 w; w.x = cvt_pk_bf16(pv[0], pv[1]); w.y = cvt_pk_bf16(pv[2], pv[3]);
              *(LAS u32x2*)(Pimg + off_p(j, 2 * lt + (q4 >> 1)) + 8 * (q4 & 1)) = w; } }
        LBAR();
        bf16x8 Vf[4];
#pragma unroll
        for (int ks = 0; ks < 4; ++ks) Vf[ks] = tr_frag(Vimg, TRA(LA, vb, ks, 0), TRA(LA, vb, ks, 1));
        f32x16 O;
#pragma unroll
        for (int e = 0; e < 16; ++e) O[e] = 0.f;
        bf16x8 Pf[4];
#pragma unroll
        for (int ks = 0; ks < 4; ++ks) Pf[ks] = *(const LAS bf16x8*)(Pimg + LA.pp[ks] + 4096 * jb);
        u32x2 qa[2][2][2]; bf16x8 Ka[2][4];
#define HG_DLOAD(buf, db_) do { _Pragma("unroll") for (int s_ = 0; s_ < 2; ++s_) { qa[buf][s_][0] = *(const LAS u32x2*)(Qimg + QBA(LA, jb, db_, 2 * s_)); qa[buf][s_][1] = *(const LAS u32x2*)(Qimg + QBA(LA, jb, db_, 2 * s_ + 1)); } \
            _Pragma("unroll") for (int ks_ = 0; ks_ < 4; ++ks_) Ka[buf][ks_] = tr_frag(Kimg, TRA(LA, db_, ks_, 0), TRA(LA, db_, ks_, 1)); } while (0)
        HG_DLOAD(0, 0);
        __builtin_amdgcn_sched_barrier(0);
        if (full) {
#pragma unroll
            for (int ks = 0; ks < 4; ++ks) O = MFMA32(Pf[ks], Vf[ks], O); }
#pragma unroll
        for (int db = 0; db < 4; ++db) {
            f32x4 fe[4];
#pragma unroll
            for (int g = 0; g < 4; ++g) fe[g] = *(const LAS f32x4*)(eref + 32 * db + 8 * g + 4 * h5);
            if (db < 3) { if (db & 1) HG_DLOAD(0, db + 1); else HG_DLOAD(1, db + 1); }
            __builtin_amdgcn_sched_barrier(0);
#pragma unroll
            for (int g = 0; g < 4; ++g)
#pragma unroll
                for (int e = 0; e < 4; ++e) S[db][4 * g + e] *= fe[g][e];
#pragma unroll
            for (int g = 0; g < 4; ++g) fe[g] = *(const LAS f32x4*)(e2t + 32 * db + 8 * g + 4 * h5);
            if (full) {
#pragma unroll
                for (int s2 = 0; s2 < 2; ++s2) O = MFMA32(cat8(qa[db & 1][s2][0], qa[db & 1][s2][1]), pack8(S[db], s2), O); }
#pragma unroll
            for (int ks = 0; ks < 4; ++ks) S[db] = MFMA32(Ka[db & 1][ks], Vf[ks], S[db]);
#pragma unroll
            for (int g = 0; g < 4; ++g)
#pragma unroll
                for (int e = 0; e < 4; ++e) S[db][4 * g + e] *= fe[g][e];
            __builtin_amdgcn_sched_barrier(0);
        }
#undef HG_DLOAD
        LBAR();
        if (full)
#pragma unroll
        for (int e = 0; e < 16; ++e) *(LAS bf16_t*)(stg + (32 * jb + crow(e, h5)) * 272 + (32 * vb + r) * 2) = (bf16_t)(cvt_pk_bf16(O[e], 0.f) & 0xffff);
        if (n + 1 < n_hi) { HG_WRITEV(); if (n + 2 < n_hi) HG_LOADV(n + 2); }
        LBAR();
    }
    HG_LN(n_hi - 1);
    __syncthreads();
#undef HG_LOADQG
#undef HG_LOADV
#undef HG_WRITEV
#undef HG_LN
}
#ifndef SPLIT_RET
#define SPLIT_RET 36
#endif
#ifndef SPLIT_HG
#define SPLIT_HG 41
#endif
DI void phase_scan(const Params& p, int l, LAS unsigned char* lds, int W) {
    for (int it = lbid(); it < 256; it += lgrid()) {
        const int j = it >> 3, bsel = 2 * (it & 7) + (j >> 4), jj = j & 15, chain = (jj >> 3) * 64 + bsel * 4 + ((jj >> 1) & 3), part = jj & 1;
        if (chain < 64) { if (part == 0) ret_chain(p, l, chain, lds, 0, SPLIT_RET, 0, W); else ret_chain(p, l, chain, lds, 0, SEQ / 64, SPLIT_RET, W); }
        else { if (part == 0) hgrn_chain(p, l, chain - 64, lds, 0, SPLIT_HG, 0, W); else hgrn_chain(p, l, chain - 64, lds, 0, SEQ / 64, SPLIT_HG, W); }
    }
}

#define XB_TMO      128
#define XB_XCNT(j)  (256  + 64 * (j))
#define XB_XSUB(j)  (1280 + 64 * (j))
#define XB_XGEN(j)  (2304 + 64 * (j))
#define XB_TOP      3328
#define XB_TOPGEN   3392
#define XB_LSUB(j)  (3456 + 64 * (j))
#define XB_LGEN(j)  (4480 + 64 * (j))
#define XCD_BAR_WORDS 5504
#define XB_SPIN_CAP (1u << 18)
DI unsigned xb_ld(unsigned* p)              { return __hip_atomic_load(p, __ATOMIC_RELAXED, __HIP_MEMORY_SCOPE_AGENT); }
DI unsigned xb_add(unsigned* p, unsigned v) { return __hip_atomic_fetch_add(p, v, __ATOMIC_RELAXED, __HIP_MEMORY_SCOPE_AGENT); }
DI unsigned xb_xcc_id() { return (unsigned)__builtin_amdgcn_s_getreg((3 << 11) | 20) & 0xFu; }
#define XB_SPIN(cond, bar) do { unsigned _sp = 0; while (cond) { __builtin_amdgcn_s_sleep(1); \
    if ((++_sp & 255u) == 0u) { if (xb_ld(&(bar)[XB_TMO])) break; if (_sp > XB_SPIN_CAP) { atomicAdd(&(bar)[XB_TMO], 1u); break; } } } } while (0)
DI void xcd_barrier_post(unsigned* bar, int W) { if (ltid(W) == 0) (void)xb_add(&bar[XB_XCNT(xb_xcc_id())], 1u); }
DI void xcd_barrier_complete(unsigned* bar, unsigned x, unsigned& nloc, unsigned& nx) {
    const unsigned G = (unsigned)lgrid();
    unsigned sum, cnt, mine, sp = 0u;
    for (;;) {
        sum = 0u; cnt = 0u; mine = 0u;
#pragma unroll
        for (unsigned j = 0; j < 16; ++j) { const unsigned c = xb_ld(&bar[XB_XCNT(j)]); sum += c; cnt += (c > 0u) ? 1u : 0u; mine = (j == x) ? c : mine; }
        if (sum == G) break;
        __builtin_amdgcn_s_sleep(1);
        if ((++sp & 255u) == 0u) { if (xb_ld(&bar[XB_TMO])) break; if (sp > XB_SPIN_CAP) { atomicAdd(&bar[XB_TMO], 1u); break; } }
    }
    nloc = mine > 0u ? mine : 1u; nx = cnt > 0u ? cnt : 1u;
}
DI void xcd_barrier(unsigned* bar, volatile LAS unsigned* st, int W) {
    asm volatile("s_waitcnt vmcnt(0)" ::: "memory");
    __syncthreads();
    if (ltid(W) == 0) {
        const unsigned x = xb_xcc_id();
        __builtin_amdgcn_s_waitcnt(0);
        unsigned nloc = st[0], nx = st[1];
        if (nloc == 0u) { xcd_barrier_complete(bar, x, nloc, nx); st[0] = nloc; st[1] = nx; }
        const unsigned old = xb_add(&bar[XB_XSUB(x)], 1u);
        const unsigned gen = old / nloc;
        if (old + 1u == (gen + 1u) * nloc) {
            __builtin_amdgcn_fence(__ATOMIC_RELEASE, "agent");
            asm volatile("s_waitcnt vmcnt(0)" ::: "memory");
            const unsigned og = xb_add(&bar[XB_TOP], 1u);
            const unsigned tg = og / nx;
            if (og + 1u == (tg + 1u) * nx) xb_add(&bar[XB_TOPGEN], 1u);
            else XB_SPIN(xb_ld(&bar[XB_TOPGEN]) == tg, bar);
            __builtin_amdgcn_fence(__ATOMIC_ACQUIRE, "agent");
            xb_add(&bar[XB_XGEN(x)], 1u);
            asm volatile("s_waitcnt vmcnt(0)" ::: "memory");
        } else {
            XB_SPIN(xb_ld(&bar[XB_XGEN(x)]) == gen, bar);
            __builtin_amdgcn_fence(__ATOMIC_ACQUIRE, "agent");
            asm volatile("s_waitcnt vmcnt(0)" ::: "memory");
        }
    }
    __syncthreads();
}

DI void local_barrier(unsigned* bar, int W) {
    asm volatile("s_waitcnt vmcnt(0)" ::: "memory");
    __syncthreads();
    if (ltid(W) == 0) {
        const unsigned x = (unsigned)lbid() & 7u;
        const unsigned old = xb_add(&bar[XB_LSUB(x)], 1u), gen = old >> 5;
        if ((old & 31u) == 31u) xb_add(&bar[XB_LGEN(x)], 1u);
        else XB_SPIN(xb_ld(&bar[XB_LGEN(x)]) == gen, bar);
        asm volatile("buffer_inv sc0\n\ts_waitcnt vmcnt(0)" ::: "memory");
    }
    __syncthreads();
}

#ifndef PROBE_REP_A
#define PROBE_REP_A 0
#endif
#ifndef PROBE_WHICH
#define PROBE_WHICH 0
#endif
#ifndef PROBE_REP_S
#define PROBE_REP_S 0
#endif
#ifndef PROBE_N1
#define PROBE_N1 0
#endif
#ifndef PROBE_PRO
#define PROBE_PRO 0
#endif
#ifndef PROBE_SYNC
#define PROBE_SYNC 0
#endif
#ifndef PROBE_RET2
#define PROBE_RET2 0
#endif
#ifndef PROBE_HG2
#define PROBE_HG2 0
#endif
#ifndef DBG_STOP
#define DBG_STOP 0
#endif
DI void dbg_dump(const Params& p, size_t ws_off, int W) {
    const bf16_t* b = (const bf16_t*)(p.ws + ws_off); const size_t n = (size_t)M * D; const size_t g = (size_t)lbid() * 512 + ltid(W), ng = (size_t)lgrid() * 512;
    for (size_t base = 0; base < n; base += ng) { const size_t i = base + g; if (i < n) p.out[i] = bf2f(b[i]); }
}
#define DBG_AT(k, off) do { if (DBG_STOP == (k)) { if ((off) != ~(size_t)0) dbg_dump(PP, (off), W); return; } } while (0)
typedef const __attribute__((address_space(4))) Params* KP;
DI KP launder(KP k) { asm volatile("" : "+s"(k)); return k; }
#define PP (*(const Params*)launder(kp))
#define CGSYNC() do { asm volatile("s_waitcnt vmcnt(0) lgkmcnt(0)" ::: "memory"); grid.sync(); __builtin_amdgcn_fence(__ATOMIC_ACQUIRE, "agent"); asm volatile("s_waitcnt vmcnt(0)" ::: "memory"); __syncthreads(); } while (0)
#define GSYNC() xcd_barrier((unsigned*)WSP(WS_CTL) + CW_BAR, (volatile LAS unsigned*)(lds + 147392), W)
#define WSP(off) (PP.ws + (off))
#ifndef LS_MASK
#define LS_MASK 127
#endif
#define LSYNC(k) do { if (((LS_MASK >> (k)) & 1) && ((volatile LAS unsigned*)(lds + 147392))[2] != 0u) local_barrier((unsigned*)WSP(WS_CTL) + CW_BAR, W); else GSYNC(); } while (0)
template <int l> DI void run_layer(KP kp, LAS unsigned char* lds, int W) {
#if PROBE_N1
        for (int rep = 0; rep < PROBE_N1; ++rep) { if (l == 0) { const Params& p = PP; phase_norm1(p, p.x, l, W); GSYNC(); } }
#endif
        { const Params& p = PP; phase_norm1(p, l == 0 ? p.x : (const float*)nullptr, l, W);
          if (l == 1) { const int tid = ltid(W), wave = __builtin_amdgcn_readfirstlane(tid >> 6), lane = tid & 63; LAS float* scr = (LAS float*)(lds + wave * 16384);
              for (int it = IT_LAYER + IT_NE + lbid() * 8 + wave; it < IT_ALL; it += lgrid() * 8) t_dispatch(p, it, scr, lane); } }
        LSYNC(0);
#if PROBE_REP_A
        for (int rep = 0; rep < PROBE_REP_A; ++rep) { if (l == 0) { PInA_bare P; P.wsb = (const char*)WSP(0); P.aoff0 = (unsigned)WS_H; P.boff0 = (unsigned)(WS_WIN + (size_t)l * NIN * D); P.l = l;
          P.so.init(lgrid(), lbid()); pg::gemm_phase(lds, P, W); GSYNC(); } }
#endif
        { PInA P; P.wsb = (const char*)WSP(0); P.aoff0 = (unsigned)WS_H; P.boff0 = (unsigned)(WS_WIN + (size_t)l * NIN * D); P.l = l;
          P.so.init(lgrid(), lbid()); pg::gemm_phase(lds, P, W); }
        LSYNC(1);
        DBG_AT(1, WS_Z);
#if SCAN_V0
        phase_scan_v0(PP, lds, W);
        GSYNC();
        phase_headnorm(PP, l, W);
        GSYNC();
#else
#if PROBE_REP_S
        for (int rep = 0; rep < PROBE_REP_S; ++rep) { if (l == 0) { phase_scan(PP, l, lds, W); GSYNC(); } }
#endif
        phase_scan(PP, l, lds, W);
        LSYNC(2);
#endif
        DBG_AT(2, WS_AB);
        { PInC P; P.wsb = (const char*)WSP(0); P.aoff0 = (unsigned)WS_H; P.boff0 = (unsigned)(WS_WIN + ((size_t)l * NIN + NZA) * D);
          P.so.init(lgrid(), lbid()); pg::gemm_phase(lds, P, W); }
        LSYNC(3);
        DBG_AT(3, WS_Z);
        { PMerge P; P.wsb = (const char*)WSP(0); P.aoff0 = (unsigned)(FP8_DE ? WS_Z + AB8_OFF : WS_AB); P.boff0 = (unsigned)(WS_WAB + (size_t)l * D * KAB * (FP8_DE ? 1 : 2));
          P.so.init(lgrid(), lbid()); pg::gemm_phase(lds, P, W); }
        LSYNC(4);
        DBG_AT(4, WS_H);
        { const Params& p = PP; PWout P; P.wsb = (const char*)p.ws; P.aoff0 = (unsigned)WS_H; P.boff0 = (unsigned)(WS_WOUT + (size_t)l * D * D * (FP8_DE ? 1 : 2)); P.xin32 = p.x; P.l = l;
          P.so.init(lgrid(), lbid()); pg::gemm_phase(lds, P, W); }
        LSYNC(5);
        DBG_AT(5, ~(size_t)0);
        phase_norm2(PP, l, lds, W);
        GSYNC();
        LAS int* lcnt = (LAS int*)(lds + LDS_AUX); LAS int* ltoff = lcnt + 32;
        { const int t = ltid(W);
          if (t < 32) { const unsigned* gcnt = (const unsigned*)WSP(WS_CTL) + CW_CNT + l * 32; lcnt[t] = t < NCLS ? (int)__hip_atomic_load(gcnt + t, __ATOMIC_RELAXED, __HIP_MEMORY_SCOPE_AGENT) : 0; }
          if (t == 0) { int off = 0;
            for (int c = 0; c < NCLS; ++c) { ltoff[c] = off; off += (lcnt[c] + 255) >> 8; }
            ltoff[NCLS] = off; } }
        __syncthreads();
        const int mx = lbid() & 7, mj = lbid() >> 3, mtot = __builtin_amdgcn_readfirstlane(ltoff[NCLS]);
        const int Tl = mtot > mx ? (mtot - mx + 7) >> 3 : 0;
        unsigned* mctr = (unsigned*)WSP(WS_CTL) + CW_MOE + (l * 8 + mx) * 64;
        int hstart = 0, nH = 0; const int nL = 4 * (Tl > 32 ? Tl - 32 : 0);
        { const int tot12 = 12 * Tl, q = tot12 >> 5, rem = tot12 & 31;
          for (int jj = 0; jj <= mj; ++jj) { const int g8 = 8 * Tl - jj, nG = g8 > 0 ? (g8 + 31) >> 5 : 0; int h = q + (jj < rem ? 1 : 0) - nG; h = h < 0 ? 0 : h; if (jj < mj) hstart += h; else nH = h; } }
        { PMoe1 P; P.wsb = (const char*)WSP(0); P.l = l; P.T.lcnt = lcnt; P.T.ltoff = ltoff; P.G = lgrid(); P.c = lbid(); P.W = W; P.lds = lds; P.ctr = mctr; P.Tl = Tl;
          pg::gemm_phase(lds, P, W); }
        if (((LS_MASK >> 6) & 1) && ((volatile LAS unsigned*)(lds + 147392))[2] != 0u) {
            if (ltid(W) == 0) { unsigned* bar = (unsigned*)WSP(WS_CTL) + CW_BAR;
                const unsigned nA = (unsigned)(64 * (Tl < 32 ? Tl : 32)), nB = (unsigned)(64 * (Tl > 32 ? Tl - 32 : 0));
                XB_SPIN(xb_ld(mctr) < nA, bar);
                if (hstart < nL) XB_SPIN(xb_ld(mctr + 1) < nB, bar);
                asm volatile("buffer_inv sc0\n\ts_waitcnt vmcnt(0)" ::: "memory"); }
            __syncthreads();
        } else GSYNC();
        DBG_AT(6, WS_Z);
        { PMoe2 P; P.wsb = (const char*)WSP(0); P.l = l; P.T.lcnt = lcnt; P.T.ltoff = ltoff; P.G = lgrid(); P.c = lbid(); P.W = W; P.lds = lds; P.hstart = hstart; P.nH = nH; P.nL = nL;
          pg::gemm_phase(lds, P, W); }
        GSYNC();
        DBG_AT(7, ~(size_t)0);
    }
__global__ void __launch_bounds__(512, 2) fwd_mega(Params p_unused) {
    extern __shared__ __attribute__((aligned(16))) unsigned char lds_raw[];
    LAS unsigned char* lds = (LAS unsigned char*)lds_raw;
    int W = __builtin_amdgcn_readfirstlane((int)threadIdx.x >> 6); asm volatile("" : "+s"(W));
    cg::grid_group grid = cg::this_grid();
    KP kp = (KP)__builtin_amdgcn_kernarg_segment_ptr();

    { const int t0 = ltid(W); if (t0 < 4) ((volatile LAS unsigned*)(lds + 147392))[t0] = 0u;
      if (t0 == 0) { unsigned* lab = (unsigned*)WSP(WS_CTL) + CW_LAB + 2 * (lbid() & 7); const unsigned xcc = xb_xcc_id();
          atomicMax(lab, xcc + 1u); atomicMax(lab + 1, 16u - xcc); } }
    __syncthreads();
    xcd_barrier_post((unsigned*)WSP(WS_CTL) + CW_BAR, W);
#if PROBE_PRO
    for (int rep = 0; rep < PROBE_PRO; ++rep) { phase_prologue(PP, lds, W); GSYNC(); }
#endif
    phase_prologue(PP, lds, W);
    CGSYNC();
    if (ltid(W) == 0) {
        const unsigned* lab = (const unsigned*)WSP(WS_CTL) + CW_LAB; unsigned ok = (lgrid() == 256) ? 1u : 0u;
        for (int x = 0; x < 8; ++x) { const unsigned a = xb_ld((unsigned*)lab + 2 * x), b = xb_ld((unsigned*)lab + 2 * x + 1); ok &= (a + b == 17u) ? 1u : 0u; }
        ((volatile LAS unsigned*)(lds + 147392))[2] = ok; }
    __syncthreads();
#if PROBE_SYNC
    for (int rep = 0; rep < PROBE_SYNC; ++rep) GSYNC();
#endif
    run_layer<0>(kp, lds, W);
    run_layer<1>(kp, lds, W);
    phase_final(PP, W);
#undef PP
#undef GSYNC
#undef CGSYNC
#undef WSP
}

extern "C" void kernel_launch(void* const* d_in, const int* in_sizes, int n_in, void* d_out, int out_size, void* d_ws, size_t ws_size, hipStream_t stream) {
    static int grid_blocks = 0;
    if (grid_blocks == 0) {
        if (n_in != 19 || out_size != M * D || ws_size < WS_END) { fprintf(stderr, "kernel_launch: unexpected shapes (n_in %d, out %d, ws %zu; need ws >= %zu)\n", n_in, out_size, ws_size, (size_t)WS_END); grid_blocks = -1; return; }
        int dev = 0, cus = 0, per_cu = 0;
        (void)hipGetDevice(&dev);
        (void)hipDeviceGetAttribute(&cus, hipDeviceAttributeMultiprocessorCount, dev);
        (void)hipFuncSetAttribute((const void*)fwd_mega, hipFuncAttributeMaxDynamicSharedMemorySize, LDS_BYTES);
        (void)hipOccupancyMaxActiveBlocksPerMultiprocessor(&per_cu, (const void*)fwd_mega, 512, LDS_BYTES);
        if (per_cu < 1) { fprintf(stderr, "kernel_launch: occupancy query says %d blocks per CU\n", per_cu); per_cu = 1; }
        grid_blocks = cus * 1;
        fprintf(stderr, "kernel_launch: cus %d per_cu %d grid %d ws %zu\n", cus, per_cu, grid_blocks, ws_size);
    }
    if (grid_blocks < 0) return;
    (void)hipMemsetAsync((char*)d_ws + WS_CTL, 0, CTL_BYTES, stream);
    Params p{};
    const float** pp = (const float**)&p;
    for (int i = 0; i < 19; ++i) pp[i] = (const float*)d_in[i];
    p.out = (float*)d_out; p.ws = (unsigned char*)d_ws;
    void* args[] = {&p};
    hipError_t e = hipLaunchCooperativeKernel((const void*)fwd_mega, dim3(grid_blocks), dim3(512), args, LDS_BYTES, stream);
    if (e != hipSuccess) fprintf(stderr, "cooperative launch failed: %s (grid %d)\n", hipGetErrorString(e), grid_blocks);
}
```

```cpp
#include <hip/hip_runtime.h>
#include <hip/hip_cooperative_groups.h>
#include <cstdio>
#include <cstdint>
namespace cg = cooperative_groups;
#ifndef SCAN_V0
#define SCAN_V0 0
#endif

#define LAS __attribute__((address_space(3)))
typedef unsigned short bf16_t;
typedef short bf16x8 __attribute__((ext_vector_type(8)));
typedef float f32x4 __attribute__((ext_vector_type(4)));
typedef float f32x2 __attribute__((ext_vector_type(2)));
typedef unsigned u32x4 __attribute__((ext_vector_type(4)));
typedef unsigned u32x2 __attribute__((ext_vector_type(2)));
#define DI __device__ __forceinline__

constexpr int D = 1024, NB = 16, SEQ = 4096, M = NB * SEQ, DEPTH = 2;
constexpr int NZA = 3584, NZC = 3584, NIN = 7168;
constexpr int KAB = 1536;
constexpr int NE = 16, DE = 512, NCLS = 24;
constexpr float EPS = 1e-6f;
constexpr int ZQ = 0, ZG2 = 512, ZI = 1024, ZQR = 1536, ZKR = 2048, ZV = 2560;
constexpr size_t HZ_OFF = 256u << 20;

constexpr size_t MiB = 1u << 20;
constexpr size_t WS_CTL = 0, CTL_BYTES = 1 * MiB;
constexpr size_t WS_ROT = 1 * MiB;
constexpr size_t WS_MOD = 3 * MiB;
constexpr size_t WS_LBT = 3 * MiB + 768 * 1024;
constexpr size_t WS_WIN = 4 * MiB;
constexpr size_t WS_WAB = 32 * MiB;
constexpr size_t WS_WOUT = 38 * MiB;
constexpr size_t WS_WG = 42 * MiB;
constexpr size_t WS_WU = 58 * MiB;
constexpr size_t WS_WD = 74 * MiB;
constexpr size_t WS_LIST = 90 * MiB;
constexpr size_t WS_WL = 96 * MiB;
constexpr size_t WS_TOKI = 108 * MiB;
constexpr size_t WS_X16 = 110 * MiB;
constexpr size_t WS_H = 238 * MiB;
constexpr size_t WS_AB = 366 * MiB;
constexpr size_t WS_Z = 558 * MiB;
constexpr size_t WS_END = 1006 * MiB;
constexpr int CW_BAR = 16384;
constexpr int CW_CNT = 1024;

constexpr int LDS_BYTES = 163840;
constexpr int LDS_IDT = 147456;
constexpr int LDS_AUX = 131072;

typedef __bf16 bf16x2_t __attribute__((ext_vector_type(2)));
DI unsigned cvt_pk_bf16(float lo, float hi) { const bf16x2_t r = __builtin_convertvector((f32x2){lo, hi}, bf16x2_t); return __builtin_bit_cast(unsigned, r); }
typedef int i32x4 __attribute__((ext_vector_type(4)));
typedef int i32x8 __attribute__((ext_vector_type(8)));
DI unsigned pk_fp8x4(float a, float b, float c, float d, float S) {
    a = __builtin_amdgcn_fmed3f(a * S, -448.f, 448.f); b = __builtin_amdgcn_fmed3f(b * S, -448.f, 448.f); c = __builtin_amdgcn_fmed3f(c * S, -448.f, 448.f); d = __builtin_amdgcn_fmed3f(d * S, -448.f, 448.f);
    int pk = __builtin_amdgcn_cvt_pk_fp8_f32(a, b, 0, false); pk = __builtin_amdgcn_cvt_pk_fp8_f32(c, d, pk, true); return (unsigned)pk; }
constexpr float S8_ACT = 4.f, S8_W = 64.f, S8_ACT2 = 8.f;
#ifndef FP8_DE
#define FP8_DE 1
#endif
constexpr size_t AB8_BX = (size_t)6 << 20;
constexpr size_t H2_BX = (size_t)8 << 20;
constexpr int CW_MOE = 3072;
constexpr int CW_LAB = 2048;
constexpr size_t AB8_OFF = (size_t)256 << 20;
DI float bf_lo(unsigned u) { return __uint_as_float(u << 16); }
DI float bf_hi(unsigned u) { return __uint_as_float(u & 0xffff0000u); }
DI float bf2f(bf16_t b) { return __uint_as_float(((unsigned)b) << 16); }
DI float sigm(float x) { return __builtin_amdgcn_rcpf(1.f + __expf(-x)); }
DI float silu(float x) { return x * sigm(x); }
DI unsigned pk_f16(float a, float b) { _Float16 ha = (_Float16)a, hb = (_Float16)b; return (unsigned)__builtin_bit_cast(unsigned short, ha) | ((unsigned)__builtin_bit_cast(unsigned short, hb) << 16); }
DI float h2f(unsigned short u) { return (float)__builtin_bit_cast(_Float16, u); }
template <int X> DI float swz_xor(float v) { return __int_as_float(__builtin_amdgcn_ds_swizzle(__float_as_int(v), (X << 10) | 0x1f)); }
DI float sum16(float v) { v += swz_xor<1>(v); v += swz_xor<2>(v); v += swz_xor<4>(v); v += swz_xor<8>(v); return v; }
DI float wave_sum(float v) {
    v = sum16(v); v += swz_xor<16>(v);
    const auto r = __builtin_amdgcn_permlane32_swap(__float_as_uint(v), __float_as_uint(v), false, false);
    return __uint_as_float(r[0]) + __uint_as_float(r[1]);
}
template <int CTRL> DI float dppf(float x) { return __int_as_float(__builtin_amdgcn_update_dpp(0, __float_as_int(x), CTRL, 0xf, 0xf, false)); }
DI float reduce16(const float (&p)[16], int lane) {
    float q[8], r4[4], t[2];
#pragma unroll
    for (int e = 0; e < 8; ++e) { const auto r = __builtin_amdgcn_permlane32_swap(__float_as_uint(p[e]), __float_as_uint(p[e + 8]), false, false); q[e] = __uint_as_float(r[0]) + __uint_as_float(r[1]); }
#pragma unroll
    for (int e = 0; e < 4; ++e) { const auto r = __builtin_amdgcn_permlane16_swap(__float_as_uint(q[e]), __float_as_uint(q[e + 4]), false, false); r4[e] = __uint_as_float(r[0]) + __uint_as_float(r[1]); }
    const bool b3 = (lane & 8) != 0, b2 = (lane & 4) != 0;
#pragma unroll
    for (int e = 0; e < 2; ++e) { const float sel = b3 ? r4[e + 2] : r4[e], oth = b3 ? r4[e] : r4[e + 2]; t[e] = sel + dppf<0x140>(oth); }
    const float sel = b2 ? t[1] : t[0], oth = b2 ? t[0] : t[1];
    float u = sel + dppf<0x141>(oth);
    u += dppf<0xB1>(u); u += dppf<0x4E>(u);
    return u;
}
#define LDS_WAIT() asm volatile("s_waitcnt lgkmcnt(0)" ::: "memory")
DI int ltid(int W) { int t; asm volatile("v_mbcnt_lo_u32_b32 %0, -1, 0\n\tv_mbcnt_hi_u32_b32 %0, -1, %0\n\tv_lshl_add_u32 %0, %1, 6, %0" : "=&v"(t) : "s"(W)); return t; }
DI int lbid() { int b = blockIdx.x; asm volatile("" : "+s"(b)); return b; }
DI int lgrid() { int g = gridDim.x; asm volatile("" : "+s"(g)); return g; }

DI int src_col_in(int r) {
    if (r < NZA) {
        if (r < 1536) return r;
        if (r < 2560) { const int seg = (r - 1536) >> 9, w = (r - 1536) & 511, head = w >> 7, p = w & 127, i = p >> 1, half = p & 1;
            return 2048 + seg * 512 + head * 128 + half * 64 + i; }
        return 3072 + (r - 2560);
    }
    const int q = r - NZA;
    if (q < 512) return 1536 + q;
    if (q < 1536) return 4096 + (q - 512);
    { const int qq = q - 1536, k = qq >> 8, w = qq & 255; return 5120 + (w >> 7) * 1024 + k * 128 + (w & 127); }
}

namespace pg {
constexpr int BM = 256, BK = 64, HALF = 128, HTB = HALF * BK * 2, STAGE_BYTES = 8 * HTB;
DI int lds_byte(int r, int c) { const int st = (r >> 4) * 2 + (c >> 5), rr = r & 15, cc = c & 31, ob = rr * 64 + cc * 2; return st * 1024 + (ob ^ (((ob >> 9) & 1) << 5)); }
DI void stage_rc(int b, int& R, int& C) { const int st = b / 1024, sb = b % 1024, swz = sb ^ (((sb >> 9) & 1) << 5); R = (st >> 1) * 16 + swz / 64; C = (st & 1) * 32 + (swz % 64) / 2; }
DI int perm32(int rho) { const int n = rho >> 4, i = rho & 15; return 8 * (i >> 2) + 4 * n + (i & 3); }

struct Unit { int pm, pn, cls, cnt, rowpos, seq; };
typedef f32x4 Acc[2][2][4][2];

template <int NM, int NN> struct StaticOrder {
    int G, c;
    DI void init(int G_, int c_) { G = G_; c = c_; }
    DI bool next(int i, Unit& u) const {
        constexpr int nwg = NM * NN; static_assert(nwg % 8 == 0 && NM % 8 == 0, "shape");
        const int L = i * G + c; if (L >= nwg) return false;
        const int wgid = (L % 8) * (nwg / 8) + L / 8;
        constexpr int nig = 8 * NN; const int gid = wgid / nig, fm = gid * 8;
        u.pm = fm + ((wgid % nig) % 8); u.pn = (wgid % nig) / 8; u.cls = 0; u.cnt = 0; u.rowpos = 0; u.seq = i; return true;
    }
};

template <class P, class = void> struct HasDone { static constexpr bool v = false; };
template <class P> struct HasDone<P, decltype((void)P::HAS_DONE)> { static constexpr bool v = P::HAS_DONE; };
template <class P, class = void> struct HasDmaAddr { static constexpr bool v = false; };
template <class P> struct HasDmaAddr<P, decltype((void)P::DMA_ADDR)> { static constexpr bool v = P::DMA_ADDR; };
template <class P>
DI void gemm_phase(LAS unsigned char* lds, const P& p, int W) {
    constexpr int NT = P::NT;
    typedef typename P::Adr Adr;
    const int tid = ltid(W), wid = __builtin_amdgcn_readfirstlane(tid >> 6), lane = tid & 63, wr = wid >> 2, wc = wid & 3, fr = lane & 15, fq = lane >> 4;
    unsigned voffA;
    { int R, C; stage_rc(tid * 16, R, C); voffA = (unsigned)(R * P::LDA + C * 2); }
#define voffB (P::LDA == P::LDB ? voffA : ((voffA / (unsigned)P::LDA) * (unsigned)P::LDB + (voffA & 127u)))
    const unsigned ldsw = (unsigned)wid * 1024u;
    int lfrag = lds_byte(fr, fq * 8); const int aU = wr * 8192, bU = wc * 4096;
#define aoff (aU + lfrag)
#define boff (bU + lfrag)
#define PG_SA(b, h) (((b) * 2 + (h)) * HTB)
#define PG_SB(b, h) ((4 + (b) * 2 + (h)) * HTB)
#define PG_GLDS(src, dstoff) __builtin_amdgcn_global_load_lds((const unsigned*)(src), (LAS unsigned*)(lds + (dstoff)), 16, 0, 0)
#define PG_STAGE_A(bufoff, adr, h, t) do { const unsigned _ab = p.abase(adr, h, t), _pre = p.apre(adr, h); _Pragma("unroll") for (int _i = 0; _i < 2; ++_i) PG_GLDS(p.wsb + (size_t)(unsigned)(_ab + p.avoff(adr, h, _i, voffA, _pre) + (unsigned)(_i * P::AIOFF)), (bufoff) + ldsw + _i * 8192); } while (0)
#define PG_STAGE_B(bufoff, adr, h, t) do { const unsigned _bb = p.bbase(adr, h, t); _Pragma("unroll") for (int _i = 0; _i < 2; ++_i) PG_GLDS(p.wsb + (size_t)(unsigned)(_bb + voffB + (unsigned)(_i * 64 * P::LDB)), (bufoff) + ldsw + _i * 8192); } while (0)
#define PG_LDA(dst, b, h) do { _Pragma("unroll") for (int m = 0; m < 4; ++m) _Pragma("unroll") for (int k = 0; k < 2; ++k) dst[m][k] = *(const LAS bf16x8*)(lds + PG_SA(b, h) + aoff + m * 2048 + k * 1024); } while (0)
#define PG_LDB(dst, b, h) do { _Pragma("unroll") for (int n = 0; n < 2; ++n) _Pragma("unroll") for (int k = 0; k < 2; ++k) dst[n][k] = *(const LAS bf16x8*)(lds + PG_SB(b, h) + boff + n * 2048 + k * 1024); } while (0)
#define PG_CAT8(x) __builtin_shufflevector(__builtin_bit_cast(i32x4, x[0]), __builtin_bit_cast(i32x4, x[1]), 0, 1, 2, 3, 4, 5, 6, 7)
#define PG_MMA(ai, bj, At, Bt) do { __builtin_amdgcn_s_setprio(1); \
        if constexpr (P::FP8) { _Pragma("unroll") for (int m = 0; m < 4; ++m) _Pragma("unroll") for (int n = 0; n < 2; ++n) \
            acc[ai][bj][m][n] = __builtin_amdgcn_mfma_scale_f32_16x16x128_f8f6f4(PG_CAT8(Bt[n]), PG_CAT8(At[m]), acc[ai][bj][m][n], 0, 0, 0, 0, 0, 0); } \
        else { _Pragma("unroll") for (int m = 0; m < 4; ++m) _Pragma("unroll") for (int n = 0; n < 2; ++n) _Pragma("unroll") for (int k = 0; k < 2; ++k) \
            acc[ai][bj][m][n] = __builtin_amdgcn_mfma_f32_16x16x32_bf16(Bt[n][k], At[m][k], acc[ai][bj][m][n], 0, 0, 0); } \
        __builtin_amdgcn_s_setprio(0); } while (0)
#define PG_WAIT_V(n) asm volatile("s_waitcnt vmcnt(" #n ")" ::: "memory")
#define PG_WAIT_L(n) asm volatile("s_waitcnt lgkmcnt(" #n ")" ::: "memory")
#define PG_BAR __builtin_amdgcn_s_barrier()
#define PG_SCHED __builtin_amdgcn_sched_barrier(0)
    Unit cur, nxt; int ui = 0;
    if (!p.next(0, cur)) return;
    Adr ca, na;
    p.addr(cur, ca);
    if constexpr (HasDmaAddr<P>::v) asm volatile("s_waitcnt vmcnt(0)" ::: "memory");
    Acc acc;
#pragma unroll
    for (int a = 0; a < 2; ++a)
#pragma unroll
        for (int b = 0; b < 2; ++b)
#pragma unroll
            for (int m = 0; m < 4; ++m)
#pragma unroll
                for (int n = 0; n < 2; ++n) acc[a][b][m][n] = (f32x4){0.f, 0.f, 0.f, 0.f};
    bf16x8 At[4][2], B0[2][2], B1[2][2];
    PG_STAGE_B(PG_SB(0, 0), ca, 0, 0); PG_STAGE_B(PG_SB(0, 1), ca, 1, 0); PG_STAGE_A(PG_SA(0, 0), ca, 0, 0); PG_STAGE_A(PG_SA(0, 1), ca, 1, 0);
    if (wr == 1) PG_BAR;
    PG_WAIT_V(2); PG_BAR;
    PG_STAGE_B(PG_SB(1, 0), ca, 0, 1); PG_STAGE_A(PG_SA(1, 0), ca, 0, 1); PG_STAGE_B(PG_SB(1, 1), ca, 1, 1);
    PG_WAIT_V(6); PG_BAR;
    for (;;) {
        const bool has_next = p.next(ui + 1, nxt);
        if (has_next) p.addr(nxt, na); else na = ca;
        for (int t = 0; t < NT; t += 2) {
            asm volatile("" : "+v"(voffA), "+v"(lfrag));
            const bool last = (t == NT - 2);
            if constexpr (P::HAS_MID) { if (t == P::TMID) { const int l2 = ltid(W) & 63; p.mid(acc, cur, wr, wc, l2 & 15, l2 >> 4); } }
            const Adr xa = last ? na : ca;
            const int t1 = t + 1, t2 = last ? 0 : t + 2, t3 = t2 + 1;
            PG_LDB(B0, 0, 0); PG_LDB(B1, 0, 1); PG_SCHED; PG_LDA(At, 0, 0); PG_STAGE_A(PG_SA(1, 1), ca, 1, t1);
            PG_WAIT_V(8); PG_WAIT_L(0); PG_BAR; PG_MMA(0, 0, At, B0); PG_MMA(0, 1, At, B1); PG_BAR; PG_SCHED;
            PG_LDA(At, 0, 1); PG_STAGE_B(PG_SB(0, 0), xa, 0, t2); PG_STAGE_B(PG_SB(0, 1), xa, 1, t2); PG_STAGE_A(PG_SA(0, 0), xa, 0, t2);
            PG_WAIT_V(8); PG_WAIT_L(0); PG_BAR; PG_MMA(1, 0, At, B0); PG_MMA(1, 1, At, B1); PG_BAR; PG_SCHED;
            PG_LDB(B0, 1, 0); PG_LDB(B1, 1, 1); PG_SCHED; PG_LDA(At, 1, 0); PG_STAGE_A(PG_SA(0, 1), xa, 1, t2);
            PG_WAIT_V(8); PG_WAIT_L(0); PG_BAR; PG_MMA(0, 0, At, B0); PG_MMA(0, 1, At, B1); PG_BAR; PG_SCHED;
            PG_LDA(At, 1, 1); PG_STAGE_B(PG_SB(1, 0), xa, 0, t3); PG_STAGE_B(PG_SB(1, 1), xa, 1, t3); PG_STAGE_A(PG_SA(1, 0), xa, 0, t3);
            PG_WAIT_V(8); PG_WAIT_L(0); PG_BAR; PG_MMA(1, 0, At, B0); PG_MMA(1, 1, At, B1); PG_BAR; PG_SCHED;
        }
        if (wr == 0) PG_BAR;
        { const int l2 = ltid(W) & 63; p.epi(acc, cur, wr, wc, l2 & 15, l2 >> 4); }
        if constexpr (HasDone<P>::v) p.done(cur);
        if (!has_next) break;
#pragma unroll
        for (int a = 0; a < 2; ++a)
#pragma unroll
            for (int b = 0; b < 2; ++b)
#pragma unroll
                for (int m = 0; m < 4; ++m)
#pragma unroll
                    for (int n = 0; n < 2; ++n) acc[a][b][m][n] = (f32x4){0.f, 0.f, 0.f, 0.f};
        cur = nxt; ca = na; ++ui;
        if (wr == 1) PG_BAR;
    }
    PG_WAIT_V(0);
    PG_BAR;
#undef PG_SA
#undef PG_SB
#undef PG_GLDS
#undef PG_STAGE_A
#undef PG_STAGE_B
#undef PG_LDA
#undef PG_LDB
#undef PG_MMA
#undef aoff
#undef boff
#undef voffB
#undef PG_CAT8
#undef PG_WAIT_V
#undef PG_WAIT_L
#undef PG_BAR
#undef PG_SCHED
}
}

using pg::Unit; using pg::Acc;

struct AdrReg { unsigned a, b; };
#define REGULAR_ADDR(LDA_, LDB_) REGULAR_ADDR3(LDA_, LDB_, 0)
#define REGULAR_ADDR3(LDA_, LDB_, ABX_) \
    typedef AdrReg Adr; static constexpr int LDA = LDA_, LDB = LDB_, AIOFF = 64 * LDA_; \
    DI void addr(const Unit& u, Adr& r) const { r.a = aoff0 + (unsigned)u.pm * (256u * LDA_) + (unsigned)(u.pm >> 4) * (unsigned)(ABX_); r.b = boff0 + (unsigned)u.pn * (256u * LDB_); } \
    DI unsigned abase(const Adr& r, int h, int t) const { return r.a + (unsigned)(h * 128 * LDA_) + (unsigned)t * 128u; } \
    DI unsigned apre(const Adr&, int) const { return 0u; } \
    DI unsigned avoff(const Adr&, int, int, unsigned v, unsigned) const { return v; } \
    DI unsigned bbase(const Adr& r, int h, int t) const { return r.b + (unsigned)(h * 128 * LDB_) + (unsigned)t * 128u; }

struct PInA {
    static constexpr int NT = 8, TMID = -1; static constexpr bool PERM = true, HAS_MID = false, FP8 = true;
    const char* wsb; unsigned aoff0, boff0; int l; pg::StaticOrder<M / 256, NZA / 256> so;
    DI bool next(int i, Unit& u) const { return so.next(i, u); }
    REGULAR_ADDR(1024, 1024)
    DI void epi(const Acc& acc, const Unit& u, int wr, int wc, int fr, int fq) const {
        bf16_t* Z = (bf16_t*)(wsb + WS_Z); const float* lbt = (const float*)(wsb + WS_LBT) + l * 512;
        asm volatile("" : "+v"(fr), "+v"(fq));
        const int seg = u.pn >> 1;
        const int row0 = u.pm * 256 + wr * 64 + fr, colw = wc * 32 + 8 * fq;
        f32x4 lbv[2][2];
        if (seg == 1) {
#pragma unroll
            for (int bj = 0; bj < 2; ++bj) { const int c = u.pn * 256 - 512 + bj * 128 + colw; lbv[bj][0] = *(const f32x4*)(lbt + c); lbv[bj][1] = *(const f32x4*)(lbt + c + 4); }
        }
        float invf[4] = {0.f, 0.f, 0.f, 0.f};
        if (seg == 3 || seg == 4) {
#pragma unroll
            for (int i = 0; i < 4; ++i) invf[i] = exp2f(-(float)((colw >> 1) + i) * (13.287712379549449f / 64.f));
        }
#pragma unroll
        for (int ai = 0; ai < 2; ++ai)
#pragma unroll
            for (int m = 0; m < 4; ++m) {
                const int row = row0 + ai * 128 + m * 16;
#if SCAN_V0
                bf16_t* rowp = Z + (size_t)row * NZA + u.pn * 256 + colw; const size_t bjstep = 128;
#else
                const size_t tok = (size_t)(row & (SEQ - 1)), bh0 = (size_t)(row >> 12) * 4;
                bf16_t* rowp; size_t bjstep;
                if (seg < 3)      { rowp = Z + (HZ_OFF >> 1) + ((bh0 + 2 * (u.pn & 1)) * SEQ + tok) * 384 + seg * 128 + colw; bjstep = (size_t)SEQ * 384; }
                else if (seg < 5) { rowp = Z + ((bh0 + 2 * (u.pn & 1)) * SEQ + tok) * 512 + (seg - 3) * 128 + colw; bjstep = (size_t)SEQ * 512; }
                else              { rowp = Z + ((bh0 + (u.pn - 10)) * SEQ + tok) * 512 + 256 + colw; bjstep = 128; }
#endif
                f32x4 cs0 = {1.f, 0.f, 1.f, 0.f}, cs1 = {1.f, 0.f, 1.f, 0.f};
                if (seg == 3 || seg == 4) { const float pos = (float)(row & (SEQ - 1)); float cc[4], ss[4];
#pragma unroll
                    for (int i = 0; i < 4; ++i) { const float ang = pos * invf[i];
                        const float pr = ang * 0.15915494f, er = fmaf(ang, 0.15915494f, -pr); const float rv = (pr - floorf(pr)) + (er + ang * 6.4206383e-9f);
                        cc[i] = __builtin_amdgcn_cosf(rv); ss[i] = __builtin_amdgcn_sinf(rv); }
                    cs0 = (f32x4){cc[0], ss[0], cc[1], ss[1]}; cs1 = (f32x4){cc[2], ss[2], cc[3], ss[3]}; }
#pragma unroll
                for (int bj = 0; bj < 2; ++bj) {
                    f32x4 v0 = acc[ai][bj][m][0] * (1.f / (S8_ACT * S8_W)), v1 = acc[ai][bj][m][1] * (1.f / (S8_ACT * S8_W));
                    u32x4 w;
                    if (seg == 1) {
#pragma unroll
                        for (int j = 0; j < 4; ++j) { const float l0 = lbv[bj][0][j], l1 = lbv[bj][1][j];
                            v0[j] = __log2f(l0 + (1.f - l0) * sigm(v0[j])); v1[j] = __log2f(l1 + (1.f - l1) * sigm(v1[j])); }
                        w.x = pk_f16(v0[0], v0[1]); w.y = pk_f16(v0[2], v0[3]); w.z = pk_f16(v1[0], v1[1]); w.w = pk_f16(v1[2], v1[3]);
                    } else {
                        if (seg == 0) {
#pragma unroll
                            for (int j = 0; j < 4; ++j) { v0[j] = silu(v0[j]); v1[j] = silu(v1[j]); }
                        } else if (seg == 3 || seg == 4) {
                            const float sc = (seg == 3) ? 0.08838834764831845f : 1.f;
                            f32x4 o0, o1;
                            o0[0] = (v0[0] * cs0[0] - v0[1] * cs0[1]) * sc; o0[1] = (v0[0] * cs0[1] + v0[1] * cs0[0]) * sc;
                            o0[2] = (v0[2] * cs0[2] - v0[3] * cs0[3]) * sc; o0[3] = (v0[2] * cs0[3] + v0[3] * cs0[2]) * sc;
                            o1[0] = (v1[0] * cs1[0] - v1[1] * cs1[1]) * sc; o1[1] = (v1[0] * cs1[1] + v1[1] * cs1[0]) * sc;
                            o1[2] = (v1[2] * cs1[2] - v1[3] * cs1[3]) * sc; o1[3] = (v1[2] * cs1[3] + v1[3] * cs1[2]) * sc;
                            v0 = o0; v1 = o1;
                        }
                        w.x = cvt_pk_bf16(v0[0], v0[1]); w.y = cvt_pk_bf16(v0[2], v0[3]); w.z = cvt_pk_bf16(v1[0], v1[1]); w.w = cvt_pk_bf16(v1[2], v1[3]);
                    }
                    *(u32x4*)(rowp + bj * bjstep) = w;
                }
            }
    }
};

struct PInA_bare {
    static constexpr int NT = 8, TMID = -1; static constexpr bool PERM = true, HAS_MID = false, FP8 = true;
    const char* wsb; unsigned aoff0, boff0; int l; pg::StaticOrder<M / 256, NZA / 256> so;
    DI bool next(int i, Unit& u) const { return so.next(i, u); }
    REGULAR_ADDR(1024, 1024)
    DI void epi(const Acc& acc, const Unit& u, int wr, int wc, int fr, int fq) const {
        bf16_t* Z = (bf16_t*)(wsb + WS_Z); const int row0 = u.pm * 256 + wr * 64 + fr, colw = wc * 32 + 8 * fq;
#pragma unroll
        for (int ai = 0; ai < 2; ++ai)
#pragma unroll
            for (int m = 0; m < 4; ++m) { bf16_t* rowp = Z + (size_t)(row0 + ai * 128 + m * 16) * NZA + u.pn * 256 + colw;
#pragma unroll
                for (int bj = 0; bj < 2; ++bj) { const f32x4 v0 = acc[ai][bj][m][0], v1 = acc[ai][bj][m][1]; u32x4 w;
                    w.x = cvt_pk_bf16(v0[0], v0[1]); w.y = cvt_pk_bf16(v0[2], v0[3]); w.z = cvt_pk_bf16(v1[0], v1[1]); w.w = cvt_pk_bf16(v1[2], v1[3]); *(u32x4*)(rowp + bj * 128) = w; } }
    }
};

struct PInC {
    static constexpr int NT = 8, TMID = -1; static constexpr bool PERM = true, HAS_MID = false, FP8 = true;
    const char* wsb; unsigned aoff0, boff0; pg::StaticOrder<M / 256, NZC / 256> so;
    DI bool next(int i, Unit& u) const { return so.next(i, u); }
    REGULAR_ADDR(1024, 1024)
    DI void epi(const Acc& acc, const Unit& u, int wr, int wc, int fr, int fq) const {
        bf16_t* AB = (bf16_t*)(wsb + WS_AB); bf16_t* ZG = (bf16_t*)(wsb + WS_Z);
        asm volatile("" : "+v"(fr), "+v"(fq));
        const int row0 = u.pm * 256 + wr * 64 + fr, col0 = u.pn * 256 + wc * 32 + 8 * fq;
        const bool gate = u.pn < 6;
        u32x4 ob[2][4][2];
        if (gate) {
#pragma unroll
            for (int ai = 0; ai < 2; ++ai)
#pragma unroll
                for (int m = 0; m < 4; ++m)
#pragma unroll
                    for (int bj = 0; bj < 2; ++bj) ob[ai][m][bj] = *(const u32x4*)(AB + (size_t)(row0 + ai * 128 + m * 16) * KAB + col0 + bj * 128);
        }
#pragma unroll
        for (int ai = 0; ai < 2; ++ai)
#pragma unroll
            for (int m = 0; m < 4; ++m) {
                const int row = row0 + ai * 128 + m * 16;
#pragma unroll
                for (int bj = 0; bj < 2; ++bj) {
                    f32x4 v0 = acc[ai][bj][m][0] * (1.f / (S8_ACT * S8_W)), v1 = acc[ai][bj][m][1] * (1.f / (S8_ACT * S8_W));
                    u32x4 w;
                    if (gate) {
                        bf16_t* pab = AB + (size_t)row * KAB + col0 + bj * 128;
                        const u32x4 o = ob[ai][m][bj];
#if FP8_DE
                        u32x2 w8; (void)pab;
                        w8.x = pk_fp8x4(bf_lo(o.x) * silu(v0[0]), bf_hi(o.x) * silu(v0[1]), bf_lo(o.y) * silu(v0[2]), bf_hi(o.y) * silu(v0[3]), S8_ACT);
                        w8.y = pk_fp8x4(bf_lo(o.z) * silu(v1[0]), bf_hi(o.z) * silu(v1[1]), bf_lo(o.w) * silu(v1[2]), bf_hi(o.w) * silu(v1[3]), S8_ACT);
                        *(u32x2*)((unsigned char*)ZG + AB8_OFF + (size_t)row * KAB + (size_t)(row >> 12) * AB8_BX + col0 + bj * 128) = w8;
#else
                        w.x = cvt_pk_bf16(bf_lo(o.x) * silu(v0[0]), bf_hi(o.x) * silu(v0[1])); w.y = cvt_pk_bf16(bf_lo(o.y) * silu(v0[2]), bf_hi(o.y) * silu(v0[3]));
                        w.z = cvt_pk_bf16(bf_lo(o.z) * silu(v1[0]), bf_hi(o.z) * silu(v1[1])); w.w = cvt_pk_bf16(bf_lo(o.w) * silu(v1[2]), bf_hi(o.w) * silu(v1[3]));
                        *(u32x4*)pab = w;
#endif
                    } else if (bj == 0) {
                        const f32x4 b0 = acc[ai][1][m][0] * (1.f / (S8_ACT * S8_W)), b1 = acc[ai][1][m][1] * (1.f / (S8_ACT * S8_W));
                        float sa[8], sb[8];
#pragma unroll
                        for (int e = 0; e < 4; ++e) { sa[e] = sigm(v0[e]); sa[4 + e] = sigm(v1[e]); sb[e] = sigm(b0[e]); sb[4 + e] = sigm(b1[e]); }
                        u32x4 wr_, ws_;
                        wr_.x = cvt_pk_bf16(sa[0] * __builtin_amdgcn_rcpf(sb[0]), sa[1] * __builtin_amdgcn_rcpf(sb[1])); wr_.y = cvt_pk_bf16(sa[2] * __builtin_amdgcn_rcpf(sb[2]), sa[3] * __builtin_amdgcn_rcpf(sb[3]));
                        wr_.z = cvt_pk_bf16(sa[4] * __builtin_amdgcn_rcpf(sb[4]), sa[5] * __builtin_amdgcn_rcpf(sb[5])); wr_.w = cvt_pk_bf16(sa[6] * __builtin_amdgcn_rcpf(sb[6]), sa[7] * __builtin_amdgcn_rcpf(sb[7]));
                        ws_.x = cvt_pk_bf16(sb[0], sb[1]); ws_.y = cvt_pk_bf16(sb[2], sb[3]); ws_.z = cvt_pk_bf16(sb[4], sb[5]); ws_.w = cvt_pk_bf16(sb[6], sb[7]);
                        bf16_t* zp = ZG + (size_t)row * 2048 + (u.pn - 6) * 128 + wc * 32 + 8 * fq;
                        *(u32x4*)zp = wr_; *(u32x4*)(zp + 1024) = ws_;
                    }
                }
            }
    }
};

struct PMerge {
    static constexpr int NT = FP8_DE ? 12 : 24, TMID = FP8_DE ? 4 : 8; static constexpr bool PERM = true, HAS_MID = true, FP8 = FP8_DE != 0;
    const char* wsb; unsigned aoff0, boff0; pg::StaticOrder<M / 256, D / 256> so;
    DI bool next(int i, Unit& u) const { return so.next(i, u); }
    REGULAR_ADDR3((FP8_DE ? 1536 : 3072), (FP8_DE ? 1536 : 3072), (FP8_DE ? AB8_BX : 0))
    DI void mid(Acc& acc, const Unit& u, int wr, int wc, int fr, int fq) const {
        const bf16_t* ZG = (const bf16_t*)(wsb + WS_Z);
        asm volatile("" : "+v"(fr), "+v"(fq));
        const int row0 = u.pm * 256 + wr * 64 + fr, col0 = u.pn * 256 + wc * 32 + 8 * fq;
        u32x4 ga[2][4][2];
#pragma unroll
        for (int ai = 0; ai < 2; ++ai)
#pragma unroll
            for (int m = 0; m < 4; ++m) { const bf16_t* zp = ZG + (size_t)(row0 + ai * 128 + m * 16) * 2048 + col0;
#pragma unroll
                for (int bj = 0; bj < 2; ++bj) ga[ai][m][bj] = *(const u32x4*)(zp + bj * 128); }
#pragma unroll
        for (int ai = 0; ai < 2; ++ai)
#pragma unroll
            for (int m = 0; m < 4; ++m)
#pragma unroll
                for (int bj = 0; bj < 2; ++bj) { const u32x4 a = ga[ai][m][bj];
                    f32x4& v0 = acc[ai][bj][m][0]; f32x4& v1 = acc[ai][bj][m][1];
                    v0[0] *= bf_lo(a.x); v0[1] *= bf_hi(a.x); v0[2] *= bf_lo(a.y); v0[3] *= bf_hi(a.y);
                    v1[0] *= bf_lo(a.z); v1[1] *= bf_hi(a.z); v1[2] *= bf_lo(a.w); v1[3] *= bf_hi(a.w); }
        asm volatile("" ::: "memory");
    }
    DI void epi(const Acc& acc, const Unit& u, int wr, int wc, int fr, int fq) const {
        const bf16_t* ZG = (const bf16_t*)(wsb + WS_Z); bf16_t* Y = (bf16_t*)(wsb + WS_H);
        const int row0 = u.pm * 256 + wr * 64 + fr, col0 = u.pn * 256 + wc * 32 + 8 * fq;
        u32x4 gbb[2][4][2];
#pragma unroll
        for (int ai = 0; ai < 2; ++ai)
#pragma unroll
            for (int m = 0; m < 4; ++m)
#pragma unroll
                for (int bj = 0; bj < 2; ++bj) gbb[ai][m][bj] = *(const u32x4*)(ZG + (size_t)(row0 + ai * 128 + m * 16) * 2048 + 1024 + col0 + bj * 128);
#pragma unroll
        for (int ai = 0; ai < 2; ++ai)
#pragma unroll
            for (int m = 0; m < 4; ++m) {
                const int row = row0 + ai * 128 + m * 16;
#pragma unroll
                for (int bj = 0; bj < 2; ++bj) {
                    const u32x4 gb = gbb[ai][m][bj];
                    const f32x4 v0 = acc[ai][bj][m][0], v1 = acc[ai][bj][m][1];
                    u32x4 w;
#if FP8_DE
                    constexpr float qs = 1.f / S8_W;
                    u32x2 w8; (void)w;
                    w8.x = pk_fp8x4(v0[0] * bf_lo(gb.x), v0[1] * bf_hi(gb.x), v0[2] * bf_lo(gb.y), v0[3] * bf_hi(gb.y), qs);
                    w8.y = pk_fp8x4(v1[0] * bf_lo(gb.z), v1[1] * bf_hi(gb.z), v1[2] * bf_lo(gb.w), v1[3] * bf_hi(gb.w), qs);
                    *(u32x2*)((unsigned char*)Y + (size_t)row * D + col0 + bj * 128) = w8;
#else
                    w.x = cvt_pk_bf16(v0[0] * bf_lo(gb.x), v0[1] * bf_hi(gb.x)); w.y = cvt_pk_bf16(v0[2] * bf_lo(gb.y), v0[3] * bf_hi(gb.y));
                    w.z = cvt_pk_bf16(v1[0] * bf_lo(gb.z), v1[1] * bf_hi(gb.z)); w.w = cvt_pk_bf16(v1[2] * bf_lo(gb.w), v1[3] * bf_hi(gb.w));
                    *(u32x4*)(Y + (size_t)row * D + col0 + bj * 128) = w;
#endif
                }
            }
    }
};

struct PWout {
    static constexpr int NT = FP8_DE ? 8 : 16, TMID = -1; static constexpr bool PERM = true, HAS_MID = false, FP8 = FP8_DE != 0;
    const char* wsb; unsigned aoff0, boff0; const float* xin32; int l; pg::StaticOrder<M / 256, D / 256> so;
    DI bool next(int i, Unit& u) const { return so.next(i, u); }
    REGULAR_ADDR((FP8_DE ? 1024 : 2048), (FP8_DE ? 1024 : 2048))
    DI void epi(const Acc& acc, const Unit& u, int wr, int wc, int fr, int fq) const {
        bf16_t* X = (bf16_t*)(wsb + WS_X16);
        const int row0 = u.pm * 256 + wr * 64 + fr, col0 = u.pn * 256 + wc * 32 + 8 * fq;
        const float* gtb = (const float*)(wsb + WS_MOD) + (size_t)(l * 16 + (u.pm >> 4)) * 6144 + 2048 + col0;
        f32x4 g[2][2];
#pragma unroll
        for (int bj = 0; bj < 2; ++bj)
#pragma unroll
            for (int n = 0; n < 2; ++n) g[bj][n] = *(const f32x4*)(gtb + bj * 128 + n * 4) * (FP8_DE ? 1.f / (S8_ACT * S8_W) : 1.f);
#pragma unroll
        for (int bt = 0; bt < 8; bt += 2) {
            if (l == 0) {
#pragma unroll
                for (int h2 = 0; h2 < 2; ++h2) { const int rg = bt + h2, ai = rg >> 2, m = rg & 3; const size_t off = (size_t)(row0 + ai * 128 + m * 16) * D + col0;
                    f32x4 xa[2][2];
#pragma unroll
                    for (int bj = 0; bj < 2; ++bj) { xa[bj][0] = *(const f32x4*)(xin32 + off + bj * 128); xa[bj][1] = *(const f32x4*)(xin32 + off + bj * 128 + 4); }
#pragma unroll
                    for (int bj = 0; bj < 2; ++bj) { const f32x4 x0 = xa[bj][0] + g[bj][0] * acc[ai][bj][m][0], x1 = xa[bj][1] + g[bj][1] * acc[ai][bj][m][1];
                        u32x4 o; o.x = cvt_pk_bf16(x0[0], x0[1]); o.y = cvt_pk_bf16(x0[2], x0[3]); o.z = cvt_pk_bf16(x1[0], x1[1]); o.w = cvt_pk_bf16(x1[2], x1[3]);
                        *(u32x4*)(X + off + bj * 128) = o; }
                    asm volatile("" ::: "memory"); }
            } else {
                u32x4 xh[2][2];
#pragma unroll
                for (int mm = 0; mm < 2; ++mm) { const int rg = bt + mm, ai = rg >> 2, m = rg & 3; const size_t off = (size_t)(row0 + ai * 128 + m * 16) * D + col0;
#pragma unroll
                    for (int bj = 0; bj < 2; ++bj) xh[mm][bj] = *(const u32x4*)(X + off + bj * 128); }
#pragma unroll
                for (int mm = 0; mm < 2; ++mm) { const int rg = bt + mm, ai = rg >> 2, m = rg & 3; const size_t off = (size_t)(row0 + ai * 128 + m * 16) * D + col0;
#pragma unroll
                    for (int bj = 0; bj < 2; ++bj) { const u32x4 w = xh[mm][bj];
                        f32x4 x0 = (f32x4){bf_lo(w.x), bf_hi(w.x), bf_lo(w.y), bf_hi(w.y)}, x1 = (f32x4){bf_lo(w.z), bf_hi(w.z), bf_lo(w.w), bf_hi(w.w)};
                        x0 = x0 + g[bj][0] * acc[ai][bj][m][0]; x1 = x1 + g[bj][1] * acc[ai][bj][m][1];
                        u32x4 o; o.x = cvt_pk_bf16(x0[0], x0[1]); o.y = cvt_pk_bf16(x0[2], x0[3]); o.z = cvt_pk_bf16(x1[0], x1[1]); o.w = cvt_pk_bf16(x1[2], x1[3]);
                        *(u32x4*)(X + off + bj * 128) = o; } }
                asm volatile("" ::: "memory");
            }
        }
    }
};

struct MoeTab { const LAS int* lcnt; const LAS int* ltoff; };
DI bool moe_decode(const MoeTab& T, int tile, Unit& u) {
    int itot = NCLS; asm volatile("" : "+v"(itot));
    const int tot = __builtin_amdgcn_readfirstlane(T.ltoff[itot]); if (tile >= tot) return false;
    int ln; asm volatile("v_mbcnt_lo_u32_b32 %0, -1, 0\n\tv_mbcnt_hi_u32_b32 %0, -1, %0" : "=v"(ln));
    const int lo = T.ltoff[ln < NCLS ? ln : 0];
    const int c = __builtin_popcountll(__ballot(ln >= 1 && ln < NCLS && tile >= lo));
    u.cls = c; u.pm = __builtin_amdgcn_readfirstlane(tile - T.ltoff[c]); u.cnt = __builtin_amdgcn_readfirstlane(T.lcnt[c]); u.rowpos = tile * 256; return true;
}
DI void cls_experts(int cls, int& eA, int& eB) { const int g = cls / 6, p = cls % 6; const int lo = p < 3 ? 0 : (p < 5 ? 1 : 2), hi = p < 3 ? p + 1 : (p < 5 ? p - 1 : 3); eA = 4 * g + lo; eB = 4 * g + hi; }

struct PMoe1 {
    static constexpr int NT = 8, LDA = 1024, LDB = 1024, AIOFF = 0, TMID = -1; static constexpr bool PERM = true, HAS_MID = false, FP8 = true;
    struct Adr { unsigned tb; unsigned b; };
    static constexpr bool HAS_DONE = true, DMA_ADDR = true;
    const char* wsb; LAS unsigned char* lds; int l; MoeTab T; int G, c, W; unsigned* ctr; int Tl;
    DI bool next(int i, Unit& u) const { const int x = c & 7, j = c >> 3;
        u.seq = i;
        if (G != 256) { const int L0 = i * G + c; if (!moe_decode(T, L0 >> 3, u)) return false; u.pn = L0 & 7; return true; }
        const int U = i * 32 + j, tau = U >> 3; if (tau >= Tl) return false;
        if (!moe_decode(T, tau * 8 + x, u)) return false; u.pn = U & 7; return true; }
    DI void done(const Unit& u) const { asm volatile("s_waitcnt vmcnt(0)" ::: "memory");
        if ((ltid(W) & 63) == 0) (void)__hip_atomic_fetch_add(ctr + (u.seq < 8 ? 0 : 1), 1u, __ATOMIC_RELAXED, __HIP_MEMORY_SCOPE_AGENT); }
    DI void addr(const Unit& u, Adr& r) const {
        const int* list = (const int*)(wsb + WS_LIST); const int tid = ltid(W), wv_ = __builtin_amdgcn_readfirstlane(tid >> 6);
        int R, C; pg::stage_rc(tid * 16, R, C); (void)C;
        r.tb = (unsigned)(LDS_IDT + (u.seq & 1) * 8192);
        const int* lp = list + (size_t)u.cls * M + u.pm * 256 + R;
#pragma unroll
        for (int k = 0; k < 4; ++k) __builtin_amdgcn_global_load_lds((const unsigned*)(lp + 64 * k), (LAS unsigned*)(lds + r.tb + k * 2048 + wv_ * 256), 4, 0, 0);
        if (wv_ < 4) { const float* wp = (const float*)(wsb + WS_WL) + ((size_t)u.cls * M + u.pm * 256 + tid) * 2;
            LAS unsigned char* wt = lds + LDS_AUX + 9216 + (u.seq % 3) * 2048;
            __builtin_amdgcn_global_load_lds((const unsigned*)wp, (LAS unsigned*)(wt + wv_ * 256), 4, 0, 0);
            __builtin_amdgcn_global_load_lds((const unsigned*)(wp + 1), (LAS unsigned*)(wt + 1024 + wv_ * 256), 4, 0, 0); }
        int eA, eB; cls_experts(u.cls, eA, eB); const int e = (u.pn >> 2) ? eB : eA, q = u.pn & 3;
        r.b = (unsigned)WS_WG + (unsigned)((e * DE + 128 * q) * 1024);
    }
    DI unsigned abase(const Adr&, int, int t) const { return (unsigned)t * 128u; }
    DI unsigned apre(const Adr& r, int h) const { const LAS unsigned* tp = (const LAS unsigned*)(lds + r.tb + h * 4096 + ltid(W) * 4); return (tp[0] & 0xffffu) | (tp[512] << 16); }
    DI unsigned avoff(const Adr&, int, int i, unsigned v, unsigned pk) const { const unsigned tok = (pk >> (16 * i)) & 0xffffu; return (unsigned)WS_AB + tok * 1024u + (tok >> 12) * (unsigned)H2_BX + (v & 127u); }
    DI unsigned bbase(const Adr& r, int h, int t) const { return r.b + (unsigned)h * (unsigned)(WS_WU - WS_WG) + (unsigned)t * 128u; }
    DI void epi(const Acc& acc, const Unit& u, int wr, int wc, int fr, int fq) const {
        unsigned char* ACT = (unsigned char*)(wsb + WS_Z); const LAS float* wt = (const LAS float*)(lds + LDS_AUX + 9216 + (u.seq % 3) * 2048);
        const int k = u.pn >> 2, q = u.pn & 3;
        const int r0 = wr * 64 + fr, colw = k * 512 + 128 * q + wc * 32 + 8 * fq;
        float wv[2][4];
#pragma unroll
        for (int ai = 0; ai < 2; ++ai)
#pragma unroll
            for (int m = 0; m < 4; ++m) { const int rr_ = r0 + ai * 128 + m * 16; const float w_ = wt[k * 256 + rr_]; wv[ai][m] = (u.pm * 256 + rr_ < u.cnt) ? w_ : 0.f; }
#pragma unroll
        for (int ai = 0; ai < 2; ++ai)
#pragma unroll
            for (int m = 0; m < 4; ++m) {
                const int rit = r0 + ai * 128 + m * 16; const float w = wv[ai][m];
                constexpr float qs = 1.f / (S8_ACT * S8_W);
                const f32x4 g0 = acc[ai][0][m][0] * qs, g1 = acc[ai][0][m][1] * qs, u0 = acc[ai][1][m][0] * (qs * w), u1 = acc[ai][1][m][1] * (qs * w);
                u32x2 o;
                o.x = pk_fp8x4(silu(g0[0]) * u0[0], silu(g0[1]) * u0[1], silu(g0[2]) * u0[2], silu(g0[3]) * u0[3], S8_ACT2);
                o.y = pk_fp8x4(silu(g1[0]) * u1[0], silu(g1[1]) * u1[1], silu(g1[2]) * u1[2], silu(g1[3]) * u1[3], S8_ACT2);
                *(u32x2*)(ACT + (size_t)(u.rowpos + rit) * 1024 + colw) = o;
            }
    }
};
struct PMoe2 {
    static constexpr int NT = 8, LDA = 1024, LDB = 512, AIOFF = 64 * 1024, TMID = -1; static constexpr bool PERM = true, HAS_MID = false, FP8 = true;
    struct Adr { unsigned a, b; int b2off; };
    const char* wsb; int l; MoeTab T; int G, c; int hstart, nH, nL;
    DI bool next(int i, Unit& u) const { const int x = c & 7;
        if (G != 256) { const int L0 = i * G + c; if (!moe_decode(T, L0 >> 2, u)) return false; u.pn = L0 & 3; return true; }
        if (i >= nH) return false;
        const int e = hstart + i, V = e < nL ? 128 + e : e - nL;
        if (!moe_decode(T, (V >> 2) * 8 + x, u)) return false; u.pn = V & 3; return true; }
    DI void addr(const Unit& u, Adr& r) const {
        r.a = (unsigned)WS_Z + (unsigned)u.rowpos * 1024u;
        int eA, eB; cls_experts(u.cls, eA, eB);
        r.b = (unsigned)WS_WD + (unsigned)((eA * D + u.pn * 256) * 512); r.b2off = (eB - eA) * (D * 512) - 4 * 128;
    }
    DI unsigned abase(const Adr& r, int h, int t) const { return r.a + (unsigned)(h * 128 * 1024) + (unsigned)t * 128u; }
    DI unsigned apre(const Adr&, int) const { return 0u; }
    DI unsigned avoff(const Adr&, int, int, unsigned v, unsigned) const { return v; }
    DI unsigned bbase(const Adr& r, int h, int t) const { return r.b + (unsigned)(h * 128 * 512) + (unsigned)t * 128u + (t >= 4 ? (unsigned)r.b2off : 0u); }
    DI void epi(const Acc& acc, const Unit& u, int wr, int wc, int fr, int fq) const {
        const int* list = (const int*)(wsb + WS_LIST); const float* gt = (const float*)(wsb + WS_MOD) + (size_t)l * 16 * 6144 + 5120; bf16_t* X = (bf16_t*)(wsb + WS_X16);
        const int r0 = wr * 64 + fr, col0 = u.pn * 256 + wc * 32 + 8 * fq;
        int tk[2][4];
#pragma unroll
        for (int ai = 0; ai < 2; ++ai)
#pragma unroll
            for (int m = 0; m < 4; ++m) { const int slot = u.pm * 256 + r0 + ai * 128 + m * 16; tk[ai][m] = slot < u.cnt ? list[(size_t)u.cls * M + slot] : -1; }
#pragma unroll
        for (int am = 0; am < 4; ++am) {
            const int ai = am >> 1;
            u32x4 xw[2][2]; f32x4 gw[2][2][2];
#pragma unroll
            for (int mm = 0; mm < 2; ++mm) { const int tok = tk[ai][2 * (am & 1) + mm]; const int tks = tok < 0 ? 0 : tok;
                const bf16_t* xp = X + (size_t)tks * D + col0; const float* gp = gt + (size_t)(tks >> 12) * 6144 + col0;
#pragma unroll
                for (int bj = 0; bj < 2; ++bj) { xw[mm][bj] = *(const u32x4*)(xp + bj * 128); gw[mm][bj][0] = *(const f32x4*)(gp + bj * 128); gw[mm][bj][1] = *(const f32x4*)(gp + bj * 128 + 4); } }
#pragma unroll
            for (int mm = 0; mm < 2; ++mm) { const int m = 2 * (am & 1) + mm; const int tok = tk[ai][m];
                if (tok >= 0) { bf16_t* xp = X + (size_t)tok * D + col0;
#pragma unroll
                    for (int bj = 0; bj < 2; ++bj) { const u32x4 w = xw[mm][bj]; const f32x4 g0 = gw[mm][bj][0], g1 = gw[mm][bj][1];
                        const f32x4 a0 = acc[ai][bj][m][0] * (1.f / (S8_ACT2 * S8_W)), a1 = acc[ai][bj][m][1] * (1.f / (S8_ACT2 * S8_W)); u32x4 o;
                        o.x = cvt_pk_bf16(bf_lo(w.x) + g0[0] * a0[0], bf_hi(w.x) + g0[1] * a0[1]); o.y = cvt_pk_bf16(bf_lo(w.y) + g0[2] * a0[2], bf_hi(w.y) + g0[3] * a0[3]);
                        o.z = cvt_pk_bf16(bf_lo(w.z) + g1[0] * a1[0], bf_hi(w.z) + g1[1] * a1[1]); o.w = cvt_pk_bf16(bf_lo(w.w) + g1[2] * a1[2], bf_hi(w.w) + g1[3] * a1[3]);
                        *(u32x4*)(xp + bj * 128) = o; } } }
            asm volatile("" ::: "memory");
        }
    }
};

struct Params {
    const float *x, *c, *w_ada, *b_ada, *g_norm1, *g_norm2, *w_in, *lb_logits, *g_hgrn, *g_ret, *w_branch_a, *w_branch_b, *w_out, *w_router, *b_router, *w_exp_gate, *w_exp_up, *w_exp_down, *g_final;
    float* out; unsigned char* ws;
};

struct TDesc { const float* src; bf16_t* dst; int K, N, ldd, dcol0, map, f8; };
DI void t_item(const TDesc& d, int item, LAS float* scr, int lane) {
    const int nblk = d.N / 32, kb = item / nblk, nb = item % nblk, k0 = 64 * kb, n0 = 32 * nb;
    const int nsrc = d.map ? src_col_in(n0 + (lane & 31)) : n0 + (lane & 31);
#pragma unroll
    for (int hh = 0; hh < 2; ++hh) {
        float tv[16];
#pragma unroll
        for (int i = 0; i < 16; ++i) { const int kk = 2 * (16 * hh + i) + (lane >> 5); tv[i] = d.src[(size_t)(k0 + kk) * d.N + nsrc]; }
#pragma unroll
        for (int i = 0; i < 16; ++i) { const int kk = 2 * (16 * hh + i) + (lane >> 5); scr[kk * 33 + (lane & 31)] = tv[i]; }
        asm volatile("" ::: "memory"); }
    LDS_WAIT(); asm volatile("" ::: "memory");
    const int c = lane & 7;
#pragma unroll
    for (int j = 0; j < 4; ++j) { const int n = (lane >> 3) + 8 * j; const LAS float* s = scr + (8 * c) * 33 + n;
        const int nslot = ((n >> 2) & 1) * 16 + (n >> 3) * 4 + (n & 3);
        if (d.f8) { u32x2 o; o.x = pk_fp8x4(s[0 * 33], s[1 * 33], s[2 * 33], s[3 * 33], S8_W); o.y = pk_fp8x4(s[4 * 33], s[5 * 33], s[6 * 33], s[7 * 33], S8_W);
            *(u32x2*)((unsigned char*)d.dst + (size_t)(n0 + nslot) * d.ldd + d.dcol0 + k0 + 8 * c) = o; }
        else { u32x4 o; o.x = cvt_pk_bf16(s[0 * 33], s[1 * 33]); o.y = cvt_pk_bf16(s[2 * 33], s[3 * 33]); o.z = cvt_pk_bf16(s[4 * 33], s[5 * 33]); o.w = cvt_pk_bf16(s[6 * 33], s[7 * 33]);
            *(u32x4*)(d.dst + (size_t)(n0 + nslot) * d.ldd + d.dcol0 + k0 + 8 * c) = o; } }
    LDS_WAIT(); asm volatile("" ::: "memory");
}
constexpr int IT_WIN = 16 * 224, IT_WA = 8 * 32, IT_WB = 16 * 32, IT_WO = 16 * 32, IT_E = 256, IT_NE = IT_WIN + IT_WA + IT_WB + IT_WO, IT_LAYER = IT_NE + NE * 3 * IT_E, IT_ALL = DEPTH * IT_LAYER;
DI void t_dispatch(const Params& p, int it, LAS float* scr, int lane) {
    const int l = it / IT_LAYER; int r = it % IT_LAYER; unsigned char* ws = p.ws; TDesc d;
    if (r < IT_WIN) { d = TDesc{p.w_in + (size_t)l * D * NIN, (bf16_t*)(ws + WS_WIN + (size_t)l * NIN * D), D, NIN, D, 0, 1, 1}; t_item(d, r, scr, lane); return; } r -= IT_WIN;
    if (r < IT_WA) { d = TDesc{p.w_branch_a + (size_t)l * 512 * D, (bf16_t*)(ws + WS_WAB + (size_t)l * D * KAB * (FP8_DE ? 1 : 2)), 512, D, KAB, 0, 0, FP8_DE}; t_item(d, r, scr, lane); return; } r -= IT_WA;
    if (r < IT_WB) { d = TDesc{p.w_branch_b + (size_t)l * D * D, (bf16_t*)(ws + WS_WAB + (size_t)l * D * KAB * (FP8_DE ? 1 : 2)), D, D, KAB, 512, 0, FP8_DE}; t_item(d, r, scr, lane); return; } r -= IT_WB;
    if (r < IT_WO) { d = TDesc{p.w_out + (size_t)l * D * D, (bf16_t*)(ws + WS_WOUT + (size_t)l * D * D * (FP8_DE ? 1 : 2)), D, D, D, 0, 0, FP8_DE}; t_item(d, r, scr, lane); return; } r -= IT_WO;
    const int e = r / (3 * IT_E), k = (r % (3 * IT_E)) / IT_E, ii = r % IT_E; const size_t le = (size_t)l * NE + e;
    if (k == 0) d = TDesc{p.w_exp_gate + le * D * DE, (bf16_t*)(ws + WS_WG + (size_t)e * DE * D), D, DE, D, 0, 0, 1};
    else if (k == 1) d = TDesc{p.w_exp_up + le * D * DE, (bf16_t*)(ws + WS_WU + (size_t)e * DE * D), D, DE, D, 0, 0, 1};
    else d = TDesc{p.w_exp_down + le * DE * D, (bf16_t*)(ws + WS_WD + (size_t)e * D * DE), DE, D, DE, 0, 0, 1};
    t_item(d, ii, scr, lane);
}
DI void mod_item(const Params& p, int item, LAS unsigned char* lds, int W) {
    const int tid = ltid(W), wave = __builtin_amdgcn_readfirstlane(tid >> 6), lane = tid & 63;
    LAS float* cact = (LAS float*)lds;
    LAS float* red = (LAS float*)(lds + 65536);
    for (int i = tid; i < NB * D; i += 512) { const int b = i >> 10, k = i & 1023; cact[k * 16 + b] = silu(p.c[i]); }
    __syncthreads();
    const int l = item / 96, col = (item % 96) * 64 + lane;
    const float* w = p.w_ada + (size_t)l * D * 6144 + col;
    float acc[16];
#pragma unroll
    for (int b = 0; b < 16; ++b) acc[b] = 0.f;
    for (int k = wave * 128; k < wave * 128 + 128; ++k) {
        const float wv = w[(size_t)k * 6144];
        const LAS f32x4* cp = (const LAS f32x4*)(cact + k * 16);
#pragma unroll
        for (int q = 0; q < 4; ++q) { const f32x4 cv = cp[q];
#pragma unroll
            for (int j = 0; j < 4; ++j) acc[4 * q + j] += cv[j] * wv; }
    }
#pragma unroll
    for (int b = 0; b < 16; ++b) red[(wave * 16 + b) * 64 + lane] = acc[b];
    __syncthreads();
    float* mod = (float*)(p.ws + WS_MOD);
    for (int i = tid; i < 1024; i += 512) { const int b = i >> 6, ln = i & 63; float s = 0.f;
#pragma unroll
        for (int wv = 0; wv < 8; ++wv) s += red[(wv * 16 + b) * 64 + ln];
        const int cc = (item % 96) * 64 + ln; mod[((size_t)l * 16 + b) * 6144 + cc] = s + p.b_ada[(size_t)l * 6144 + cc]; }
    __syncthreads();
}
DI void phase_prologue(const Params& p, LAS unsigned char* lds, int W) {
    const int tid = ltid(W), wave = __builtin_amdgcn_readfirstlane(tid >> 6), lane = tid & 63, G = lgrid();
    const int gt = lbid() * 512 + tid, ngt = G * 512;
    float* lbt = (float*)(p.ws + WS_LBT);
    if (gt < 512) { const float a = p.lb_logits[gt], b = p.lb_logits[512 + gt], mx = fmaxf(a, b), ea = __expf(a - mx), eb = __expf(b - mx); lbt[gt] = 0.f; lbt[512 + gt] = eb / (ea + eb); }
    for (int item = lbid(); item < 192; item += G) mod_item(p, item, lds, W);
    LAS float* scr = (LAS float*)(lds + wave * 16384);
    for (int it = lbid() * 8 + wave; it < IT_LAYER + IT_NE; it += G * 8) t_dispatch(p, it, scr, lane);
}

DI void load_xrow(const float* x32, const bf16_t* x16, size_t r, int lane, f32x4 (&v)[4]) {
    if (x32) {
#pragma unroll
        for (int j = 0; j < 4; ++j) v[j] = *(const f32x4*)(x32 + r * D + 4 * lane + 256 * j);
    } else {
#pragma unroll
        for (int j = 0; j < 4; ++j) { const u32x2 w = *(const u32x2*)(x16 + r * D + 4 * lane + 256 * j); v[j] = (f32x4){bf_lo(w.x), bf_hi(w.x), bf_lo(w.y), bf_hi(w.y)}; }
    }
}
DI void phase_norm1(const Params& p, const float* x32, int l, int W) {
    const int tid = ltid(W), wave = __builtin_amdgcn_readfirstlane(tid >> 6), lane = tid & 63, gw = lbid() * 8 + wave, ngw = lgrid() * 8;
    const float* mod = (const float*)(p.ws + WS_MOD) + (size_t)l * 16 * 6144; bf16_t* H = (bf16_t*)(p.ws + WS_H); const bf16_t* X = (const bf16_t*)(p.ws + WS_X16);
    for (int blk = lbid(); blk < M / 256; blk += lgrid()) {
        const int r0 = (32 * (blk & 7) + (blk >> 3)) * 256 + wave * 32; (void)gw; (void)ngw;
        const int b = r0 >> 12; const float* mb = mod + (size_t)b * 6144;
        f32x4 gs[4], sh[4];
#pragma unroll
        for (int j = 0; j < 4; ++j) { const int c = 4 * lane + 256 * j; const f32x4 g = *(const f32x4*)(p.g_norm1 + (size_t)l * D + c), sc = *(const f32x4*)(mb + 1024 + c); gs[j] = g * (sc + 1.f); sh[j] = *(const f32x4*)(mb + c); }
        for (int r = r0; r < r0 + 32; r += 2) {
            f32x4 v[2][4];
            load_xrow(x32, X, (size_t)r, lane, v[0]); load_xrow(x32, X, (size_t)r + 1, lane, v[1]);
#pragma unroll
            for (int q = 0; q < 2; ++q) { float ss = 0.f;
#pragma unroll
                for (int j = 0; j < 4; ++j) ss += (v[q][j].x * v[q][j].x + v[q][j].y * v[q][j].y) + (v[q][j].z * v[q][j].z + v[q][j].w * v[q][j].w);
                const float rs = rsqrtf(wave_sum(ss) * (1.f / D) + EPS);
#pragma unroll
                for (int j = 0; j < 4; ++j) { const f32x4 h = v[q][j] * rs * gs[j] + sh[j]; *(unsigned*)((unsigned char*)H + (size_t)(r + q) * D + 4 * lane + 256 * j) = pk_fp8x4(h.x, h.y, h.z, h.w, S8_ACT); } }
        }
    }
}
DI void phase_norm2(const Params& p, int l, LAS unsigned char* lds, int W) {
    const int tid = ltid(W), wave = __builtin_amdgcn_readfirstlane(tid >> 6), lane = tid & 63;
    const float* mod = (const float*)(p.ws + WS_MOD) + (size_t)l * 16 * 6144; bf16_t* H2 = (bf16_t*)(p.ws + WS_AB);
    LAS float* wrl = (LAS float*)lds;
    LAS int* whist = (LAS int*)(lds + 65536);
    unsigned* gcnt = (unsigned*)(p.ws + WS_CTL) + CW_CNT + l * 32; int* list = (int*)(p.ws + WS_LIST); f32x2* wl = (f32x2*)(p.ws + WS_WL);
#pragma unroll 4
    for (int i0 = 0; i0 < D * NE; i0 += 512) { const int i = i0 + tid; wrl[(i & 15) * 1024 + (i >> 4)] = p.w_router[i]; }
    for (int blk = lbid(); blk < M / 256; blk += lgrid()) {
        __syncthreads();
        const int r0 = (32 * (blk & 7) + (blk >> 3)) * 256 + wave * 32, b = r0 >> 12; const float* mb = mod + (size_t)b * 6144;
        f32x4 gs[4], sh[4];
#pragma unroll
        for (int j = 0; j < 4; ++j) { const int c = 4 * lane + 256 * j; const f32x4 g = *(const f32x4*)(p.g_norm2 + (size_t)l * D + c), sc = *(const f32x4*)(mb + 4096 + c); gs[j] = g * (sc + 1.f); sh[j] = *(const f32x4*)(mb + 3072 + c); }
        const bf16_t* X = (const bf16_t*)(p.ws + WS_X16);
        LAS float* lg = (LAS float*)(lds + 65536 + 4096) + wave * 512;
        f32x4 vn[2][4];
        load_xrow(nullptr, X, (size_t)r0, lane, vn[0]); load_xrow(nullptr, X, (size_t)r0 + 1, lane, vn[1]);
        for (int rr = 0; rr < 32; rr += 2) {
            const int r = r0 + rr; f32x4 v[2][4]; float ss[2] = {0.f, 0.f};
#pragma unroll
            for (int q = 0; q < 2; ++q)
#pragma unroll
                for (int j = 0; j < 4; ++j) { v[q][j] = vn[q][j]; ss[q] += (v[q][j].x * v[q][j].x + v[q][j].y * v[q][j].y) + (v[q][j].z * v[q][j].z + v[q][j].w * v[q][j].w); }
            if (rr + 2 < 32) { load_xrow(nullptr, X, (size_t)r + 2, lane, vn[0]); load_xrow(nullptr, X, (size_t)r + 3, lane, vn[1]); }
#pragma unroll
            for (int q = 0; q < 2; ++q) { const float rs = rsqrtf(wave_sum(ss[q]) * (1.f / D) + EPS);
#pragma unroll
                for (int j = 0; j < 4; ++j) { v[q][j] = v[q][j] * rs * gs[j] + sh[j]; *(unsigned*)((unsigned char*)H2 + (size_t)(r + q) * D + (size_t)((r + q) >> 12) * H2_BX + 4 * lane + 256 * j) = pk_fp8x4(v[q][j].x, v[q][j].y, v[q][j].z, v[q][j].w, S8_ACT); } }
            float p0[16], p1[16];
#pragma unroll
            for (int e = 0; e < 16; ++e) { float s0 = 0.f, s1 = 0.f;
#pragma unroll
                for (int j = 0; j < 4; ++j) { const f32x4 w = *(const LAS f32x4*)(wrl + e * 1024 + 4 * lane + 256 * j);
                    s0 += (v[0][j].x * w.x + v[0][j].y * w.y) + (v[0][j].z * w.z + v[0][j].w * w.w); s1 += (v[1][j].x * w.x + v[1][j].y * w.y) + (v[1][j].z * w.z + v[1][j].w * w.w); }
                p0[e] = s0; p1[e] = s1; }
            const float t0 = reduce16(p0, lane), t1 = reduce16(p1, lane);
            if ((lane & 3) == 0) { lg[rr * 16 + (lane >> 2)] = t0; lg[(rr + 1) * 16 + (lane >> 2)] = t1; }
        }
        float keep[16];
#pragma unroll
        for (int e = 0; e < 16; ++e) keep[e] = 0.f;
        if (lane < 32) {
#pragma unroll
            for (int e4 = 0; e4 < 4; ++e4) { const f32x4 k4 = *(const LAS f32x4*)(lg + lane * 16 + 4 * e4); keep[4 * e4] = k4.x; keep[4 * e4 + 1] = k4.y; keep[4 * e4 + 2] = k4.z; keep[4 * e4 + 3] = k4.w; } }
        int cls = -1; float wA = 0.f, wB = 0.f;
        if (lane < 32) {
            float sc[16], bi[16];
#pragma unroll
            for (int e = 0; e < 16; ++e) { sc[e] = 1.f / (1.f + expf(-keep[e])); bi[e] = sc[e] + p.b_router[e]; }
            float best = -1e30f; int gsel = 0, i1s = 0, i2s = 1; float w1s = 0.f, w2s = 0.f;
#pragma unroll
            for (int g = 0; g < 4; ++g) {
                int i1 = 0; float m1 = bi[4 * g];
#pragma unroll
                for (int j = 1; j < 4; ++j) if (bi[4 * g + j] > m1) { m1 = bi[4 * g + j]; i1 = j; }
                int i2 = -1; float m2 = -1e30f;
#pragma unroll
                for (int j = 0; j < 4; ++j) if (j != i1 && bi[4 * g + j] > m2) { m2 = bi[4 * g + j]; i2 = j; }
                float s1 = 0.f, s2 = 0.f;
#pragma unroll
                for (int j = 0; j < 4; ++j) { s1 = (j == i1) ? sc[4 * g + j] : s1; s2 = (j == i2) ? sc[4 * g + j] : s2; }
                const float gsum = m1 + m2;
                if (gsum > best) { best = gsum; gsel = g; i1s = i1; i2s = i2; w1s = s1; w2s = s2; }
            }
            const float inv = 1.f / (w1s + w2s); w1s *= inv; w2s *= inv;
            const int lo = i1s < i2s ? i1s : i2s, hi = i1s < i2s ? i2s : i1s;
            wA = i1s < i2s ? w1s : w2s; wB = i1s < i2s ? w2s : w1s;
            const int pidx = lo == 0 ? hi - 1 : (lo == 1 ? hi + 1 : 5);
            cls = 6 * gsel + pidx;
        }
        int locw = 0, mycnt = 0;
#pragma unroll 1
        for (int c = 0; c < NCLS; ++c) { const unsigned long long mk = __ballot(cls == c); const int n = __popcll(mk);
            if (cls == c) locw = __popcll(mk & ((1ull << lane) - 1ull)); if (lane == c) mycnt = n; }
        { int lq = lane; asm volatile("" : "+v"(lq)); if (lane < 32) whist[wave * 32 + lq] = mycnt; }
        __syncthreads();
        if (tid < 32) { int t = 0;
            for (int w = 0; w < 8; ++w) t += whist[w * 32 + tid];
            int tq = tid; asm volatile("" : "+v"(tq));
            whist[256 + tid] = (tid < NCLS && t > 0) ? (int)atomicAdd(&gcnt[tq], (unsigned)t) : 0; }
        __syncthreads();
        if (lane < 32) { int pre = whist[256 + cls];
            for (int w = 0; w < wave; ++w) pre += whist[w * 32 + cls];
            const int slot = pre + locw; list[(size_t)cls * M + slot] = r0 + lane; wl[(size_t)cls * M + slot] = (f32x2){wA, wB}; }
        __syncthreads();
    }
}
DI void phase_final(const Params& p, int W) {
    const int tid = ltid(W), wave = __builtin_amdgcn_readfirstlane(tid >> 6), lane = tid & 63, gw = lbid() * 8 + wave, ngw = lgrid() * 8;
    const bf16_t* X = (const bf16_t*)(p.ws + WS_X16);
    f32x4 g[4];
#pragma unroll
    for (int j = 0; j < 4; ++j) g[j] = *(const f32x4*)(p.g_final + 4 * lane + 256 * j);
    for (int r0 = gw * 2; r0 < M; r0 += ngw * 2) {
        f32x4 v[2][4];
        load_xrow(nullptr, X, (size_t)r0, lane, v[0]); load_xrow(nullptr, X, (size_t)r0 + 1, lane, v[1]);
#pragma unroll
        for (int q = 0; q < 2; ++q) { float ss = 0.f;
#pragma unroll
            for (int j = 0; j < 4; ++j) ss += (v[q][j].x * v[q][j].x + v[q][j].y * v[q][j].y) + (v[q][j].z * v[q][j].z + v[q][j].w * v[q][j].w);
            const float rs = rsqrtf(wave_sum(ss) * (1.f / D) + EPS);
#pragma unroll
            for (int j = 0; j < 4; ++j) *(f32x4*)(p.out + (size_t)(r0 + q) * D + 4 * lane + 256 * j) = v[q][j] * rs * g[j]; }
    }
}

DI void hgrn_v0_item(const Params& p, int item, int W) {
    const int tid = ltid(W), dg = tid & 15, vv = tid >> 4;
    const int bh = item >> 2, vs = item & 3, b = bh >> 2, h = bh & 3;
    const bf16_t* Z = (const bf16_t*)(p.ws + WS_Z) + (size_t)b * SEQ * NZA; bf16_t* AB = (bf16_t*)(p.ws + WS_AB) + (size_t)b * SEQ * KAB;
    const int dcol = h * 128 + dg * 8, vcol = h * 128 + vs * 32 + vv;
    float s[8];
#pragma unroll
    for (int i = 0; i < 8; ++i) s[i] = 0.f;
    u32x4 qn = *(const u32x4*)(Z + ZQ + dcol), gn = *(const u32x4*)(Z + ZG2 + dcol); bf16_t vn = Z[ZI + vcol];
    for (int t = 0; t < SEQ; ++t) {
        const u32x4 qc = qn, gc = gn; const float val = bf2f(vn);
        if (t + 1 < SEQ) { const bf16_t* zr = Z + (size_t)(t + 1) * NZA; qn = *(const u32x4*)(zr + ZQ + dcol); gn = *(const u32x4*)(zr + ZG2 + dcol); vn = zr[ZI + vcol]; }
        const unsigned qw[4] = {qc.x, qc.y, qc.z, qc.w}, gw[4] = {gc.x, gc.y, gc.z, gc.w};
        float o = 0.f;
#pragma unroll
        for (int i = 0; i < 4; ++i) {
            const float f0 = exp2f(h2f((unsigned short)(gw[i] & 0xffff))), f1 = exp2f(h2f((unsigned short)(gw[i] >> 16)));
            s[2 * i] = f0 * s[2 * i] + (1.f - f0) * val; s[2 * i + 1] = f1 * s[2 * i + 1] + (1.f - f1) * val;
            o += bf_lo(qw[i]) * s[2 * i] + bf_hi(qw[i]) * s[2 * i + 1];
        }
        o = sum16(o);
        if (dg == 0) AB[(size_t)t * KAB + vcol] = (bf16_t)(cvt_pk_bf16(o, 0.f) & 0xffff);
    }
}
DI void ret_v0_item(const Params& p, int item, LAS unsigned char* lds, int W) {
    const int tid = ltid(W);
    const int bh = item >> 3, vs = item & 7, b = bh >> 2, h = bh & 3;
    const bf16_t* Z = (const bf16_t*)(p.ws + WS_Z) + (size_t)b * SEQ * NZA; bf16_t* AB = (bf16_t*)(p.ws + WS_AB) + (size_t)b * SEQ * KAB;
    LAS float* qs = (LAS float*)lds;
    LAS float* ks = qs + 64 * 129;
    LAS float* vsm = ks + 64 * 129;
    LAS float* sc = vsm + 64 * 33;
    LAS float* S = sc + 64 * 65;
    const float lg = log2f(1.f - exp2f(-5.f - (float)h));
    for (int i = tid; i < 128 * 33; i += 512) S[i] = 0.f;
    __syncthreads();
    for (int n = 0; n < SEQ / 64; ++n) {
        const bf16_t* zc = Z + (size_t)n * 64 * NZA;
        for (int i = tid; i < 64 * 128; i += 512) { const int j = i >> 7, d = i & 127; qs[j * 129 + d] = bf2f(zc[(size_t)j * NZA + ZQR + h * 128 + d]); ks[j * 129 + d] = bf2f(zc[(size_t)j * NZA + ZKR + h * 128 + d]); }
        for (int i = tid; i < 64 * 32; i += 512) { const int j = i >> 5, v = i & 31; vsm[j * 33 + v] = bf2f(zc[(size_t)j * NZA + ZV + h * 256 + vs * 32 + v]); }
        __syncthreads();
        for (int i = tid; i < 64 * 64; i += 512) { const int j = i >> 6, l2 = i & 63; float a = 0.f;
            for (int d = 0; d < 128; ++d) a += qs[j * 129 + d] * ks[l2 * 129 + d];
            const int dd = j > l2 ? j - l2 : l2 - j; sc[j * 65 + l2] = a * exp2f(lg * (float)dd); }
        __syncthreads();
        for (int i = tid; i < 64 * 32; i += 512) { const int j = i >> 5, v = i & 31; float a = 0.f, c2 = 0.f;
            for (int l2 = 0; l2 < 64; ++l2) a += sc[j * 65 + l2] * vsm[l2 * 33 + v];
            for (int d = 0; d < 128; ++d) c2 += qs[j * 129 + d] * S[d * 33 + v];
            a += c2 * exp2f(lg * (float)(j + 1));
            AB[(size_t)(n * 64 + j) * KAB + 512 + h * 256 + vs * 32 + v] = (bf16_t)(cvt_pk_bf16(a, 0.f) & 0xffff); }
        __syncthreads();
        for (int i = tid; i < 128 * 32; i += 512) { const int d = i >> 5, v = i & 31; float a = S[d * 33 + v] * exp2f(lg * 64.f);
            for (int l2 = 0; l2 < 64; ++l2) a += ks[l2 * 129 + d] * exp2f(lg * (float)(63 - l2)) * vsm[l2 * 33 + v];
            S[d * 33 + v] = a; }
        __syncthreads();
    }
}
DI void phase_scan_v0(const Params& p, LAS unsigned char* lds, int W) {
    for (int it = lbid(); it < 256 + 512; it += lgrid()) {
        if (it < 256) hgrn_v0_item(p, it, W); else ret_v0_item(p, it - 256, lds, W);
        __syncthreads();
    }
}
DI void phase_headnorm(const Params& p, int l, int W) {
    const int tid = ltid(W), wave = __builtin_amdgcn_readfirstlane(tid >> 6), lane = tid & 63, gw = lbid() * 8 + wave, ngw = lgrid() * 8;
    bf16_t* AB = (bf16_t*)(p.ws + WS_AB);
    float ga[8], gb[16];
#pragma unroll
    for (int i = 0; i < 8; ++i) ga[i] = p.g_hgrn[(size_t)l * 512 + 8 * lane + i];
#pragma unroll
    for (int i = 0; i < 16; ++i) gb[i] = p.g_ret[(size_t)l * 1024 + 16 * lane + i];
    for (int r = gw; r < M; r += ngw) {
        bf16_t* row = AB + (size_t)r * KAB;
        { const u32x4 w = *(const u32x4*)(row + 8 * lane); float v[8] = {bf_lo(w.x), bf_hi(w.x), bf_lo(w.y), bf_hi(w.y), bf_lo(w.z), bf_hi(w.z), bf_lo(w.w), bf_hi(w.w)};
          float ss = 0.f;
#pragma unroll
          for (int i = 0; i < 8; ++i) ss += v[i] * v[i];
          ss = sum16(ss);
          const float rs = rsqrtf(ss * (1.f / 128.f) + EPS);
          u32x4 o; o.x = cvt_pk_bf16(v[0] * rs * ga[0], v[1] * rs * ga[1]); o.y = cvt_pk_bf16(v[2] * rs * ga[2], v[3] * rs * ga[3]); o.z = cvt_pk_bf16(v[4] * rs * ga[4], v[5] * rs * ga[5]); o.w = cvt_pk_bf16(v[6] * rs * ga[6], v[7] * rs * ga[7]);
          *(u32x4*)(row + 8 * lane) = o; }
        { const u32x4 w0 = *(const u32x4*)(row + 512 + 16 * lane), w1 = *(const u32x4*)(row + 512 + 16 * lane + 8);
          float v[16] = {bf_lo(w0.x), bf_hi(w0.x), bf_lo(w0.y), bf_hi(w0.y), bf_lo(w0.z), bf_hi(w0.z), bf_lo(w0.w), bf_hi(w0.w), bf_lo(w1.x), bf_hi(w1.x), bf_lo(w1.y), bf_hi(w1.y), bf_lo(w1.z), bf_hi(w1.z), bf_lo(w1.w), bf_hi(w1.w)};
          float sm = 0.f;
#pragma unroll
          for (int i = 0; i < 16; ++i) sm += v[i];
          sm = sum16(sm);
          const float mu = sm * (1.f / 256.f); float ss = 0.f;
#pragma unroll
          for (int i = 0; i < 16; ++i) { v[i] -= mu; ss += v[i] * v[i]; }
          ss = sum16(ss);
          const float rs = rsqrtf(ss * (1.f / 256.f) + EPS);
          u32x4 o0, o1;
          o0.x = cvt_pk_bf16(v[0] * rs * gb[0], v[1] * rs * gb[1]); o0.y = cvt_pk_bf16(v[2] * rs * gb[2], v[3] * rs * gb[3]); o0.z = cvt_pk_bf16(v[4] * rs * gb[4], v[5] * rs * gb[5]); o0.w = cvt_pk_bf16(v[6] * rs * gb[6], v[7] * rs * gb[7]);
          o1.x = cvt_pk_bf16(v[8] * rs * gb[8], v[9] * rs * gb[9]); o1.y = cvt_pk_bf16(v[10] * rs * gb[10], v[11] * rs * gb[11]); o1.z = cvt_pk_bf16(v[12] * rs * gb[12], v[13] * rs * gb[13]); o1.w = cvt_pk_bf16(v[14] * rs * gb[14], v[15] * rs * gb[15]);
          *(u32x4*)(row + 512 + 16 * lane) = o0; *(u32x4*)(row + 512 + 16 * lane + 8) = o1; }
    }
}

typedef short s16x4 __attribute__((ext_vector_type(4)));
typedef float f32x16 __attribute__((ext_vector_type(16)));
DI unsigned xrow(unsigned row) { return ((row & 3) << 2) | ((row >> 2) & 3); }
DI unsigned off_b(unsigned row, unsigned ch) { return 256u * row + 16u * (ch ^ xrow(row)); }
DI unsigned off_p(unsigned row, unsigned ch) { return 128u * row + 16u * (ch ^ ((row >> 1) & 7)); }
DI unsigned row_addr16(unsigned lane, unsigned rb, unsigned s) { return off_b(16 * rb + (lane & 15), 4 * s + (lane >> 4)); }
DI unsigned tr_addr32(unsigned lane, unsigned c, unsigned ks, unsigned t) {
    const unsigned h = lane >> 5, blk = (lane >> 4) & 1, q = (lane & 15) >> 2, pp = lane & 3;
    return off_b(16 * ks + 8 * h + 4 * t + q, 4 * c + 2 * blk + (pp >> 1)) + 8 * (pp & 1);
}
struct LaneAddr { unsigned trt[2], trq, r16[4], qb, qx2, qx0, pp[4]; };
DI void lane_addr(int lane, LaneAddr& A) {
    const unsigned h = lane >> 5, blk = (lane >> 4) & 1, q = (lane & 15) >> 2, p4 = lane & 3, u = 2 * blk + (p4 >> 1);
#pragma unroll
    for (unsigned t = 0; t < 2; ++t) A.trt[t] = 2048 * h + 1024 * t + 256 * q + 16 * (u ^ ((2 * h + t) & 3)) + 8 * (p4 & 1);
    A.trq = q;
    const unsigned l15 = lane & 15, q4 = lane >> 4, x15 = xrow(l15);
#pragma unroll
    for (unsigned s2 = 0; s2 < 4; ++s2) A.r16[s2] = 256 * l15 + 64 * (s2 ^ (x15 >> 2)) + 16 * (q4 ^ (x15 & 3));
    const unsigned r = lane & 31, xr = xrow(r);
    A.qb = 256 * r + 8 * h; A.qx2 = xr >> 2; A.qx0 = xr & 3;
    const unsigned xp = (r >> 1) & 7;
#pragma unroll
    for (unsigned ks = 0; ks < 4; ++ks) A.pp[ks] = 128 * r + 16 * ((2 * ks + h) ^ xp);
}
#define TRA(A, c, ks, t) ((A).trt[t] + 64u * ((unsigned)(c) ^ (A).trq) + 4096u * (ks))
#define QBA(A, jb, db, k) ((A).qb + 64u * ((unsigned)(db) ^ (A).qx2) + 16u * ((unsigned)(k) ^ (A).qx0) + 8192u * (jb))
DI bf16x8 tr_frag(const LAS unsigned char* img, unsigned a0, unsigned a1) {
    const s16x4 lo = __builtin_amdgcn_ds_read_tr16_b64_v4i16((LAS s16x4*)(img + a0));
    const s16x4 hi = __builtin_amdgcn_ds_read_tr16_b64_v4i16((LAS s16x4*)(img + a1));
    return __builtin_shufflevector(lo, hi, 0, 1, 2, 3, 4, 5, 6, 7);
}
DI bf16x8 pack8(const f32x16& x, int s) {
    u32x4 w; w.x = cvt_pk_bf16(x[8 * s + 0], x[8 * s + 1]); w.y = cvt_pk_bf16(x[8 * s + 2], x[8 * s + 3]); w.z = cvt_pk_bf16(x[8 * s + 4], x[8 * s + 5]); w.w = cvt_pk_bf16(x[8 * s + 6], x[8 * s + 7]);
    return __builtin_bit_cast(bf16x8, w);
}
DI bf16x8 cat8(u32x2 a, u32x2 b) { u32x4 w; w.x = a.x; w.y = a.y; w.z = b.x; w.w = b.y; return __builtin_bit_cast(bf16x8, w); }
#define MFMA32(a, b, c) __builtin_amdgcn_mfma_f32_32x32x16_bf16((a), (b), (c), 0, 0, 0)
#define MFMA16(a, b, c) __builtin_amdgcn_mfma_f32_16x16x32_bf16((a), (b), (c), 0, 0, 0)
#define GLDS16(src, dst) __builtin_amdgcn_global_load_lds((const unsigned*)(src), (LAS unsigned*)(dst), 16, 0, 0)
#define LBAR() asm volatile("s_waitcnt lgkmcnt(0)\n\ts_barrier" ::: "memory")
DI int crow(int reg, int h) { return (reg & 3) + 8 * (reg >> 2) + 4 * h; }
DI float ex2(float x) { return __builtin_amdgcn_exp2f(x); }

DI void ret_chain(const Params& p, int l, int chain, LAS unsigned char* lds, int n_lo, int n_hi, int n_full, int W) {
    const int tid = ltid(W), wave = __builtin_amdgcn_readfirstlane(tid >> 6), lane0 = tid & 63;
    const int b = chain >> 2, hd = chain & 3;
    const float lg = log2f(1.f - exp2f(-5.f - (float)hd));
    const char* wsb = (const char*)p.ws; const unsigned zoff = (unsigned)WS_Z + (unsigned)chain * (unsigned)(SEQ * 1024);
    bf16_t* ABb = (bf16_t*)(p.ws + WS_AB) + (size_t)b * SEQ * KAB + 512 + hd * 256;
    LAS unsigned char* Qimg = lds; LAS unsigned char* Kimg = lds + 16384; LAS unsigned char* Pimg = lds + 65536; LAS unsigned char* stg = lds + 73728;
    LAS float* gl = (LAS float*)(lds + 107520);
    if (tid < 256) gl[tid] = p.g_ret[(size_t)l * 1024 + hd * 256 + tid];
    unsigned goff[2]; float kf[2];
#pragma unroll
    for (int i = 0; i < 2; ++i) { const unsigned idx = tid + 512 * i, row = idx >> 4, ch = (idx & 15) ^ xrow(row); goff[i] = row * 1024 + ch * 16; kf[i] = ex2(lg * (float)(63 - (int)row)); }
    f32x16 S[4];
#pragma unroll
    for (int d = 0; d < 4; ++d)
#pragma unroll
        for (int e = 0; e < 16; ++e) S[d][e] = 0.f;
    u32x4 R[4][2];
#define RET_LOAD(n_) do { const unsigned zc_ = zoff + (unsigned)(n_) * (unsigned)(64 * 1024); \
        _Pragma("unroll") for (int i_ = 0; i_ < 2; ++i_) { \
            R[0][i_] = *(const u32x4*)(wsb + (size_t)(unsigned)(zc_ + goff[i_])); R[1][i_] = *(const u32x4*)(wsb + (size_t)(unsigned)(zc_ + 256 + goff[i_])); \
            R[2][i_] = *(const u32x4*)(wsb + (size_t)(unsigned)(zc_ + 512 + goff[i_])); R[3][i_] = *(const u32x4*)(wsb + (size_t)(unsigned)(zc_ + 768 + goff[i_])); } } while (0)
#define RET_WRITE() do { _Pragma("unroll") for (int i_ = 0; i_ < 2; ++i_) { const unsigned o_ = (tid + 512 * i_) * 16; const float f_ = kf[i_]; const u32x4 v_ = R[1][i_]; u32x4 k_; \
            k_.x = cvt_pk_bf16(bf_lo(v_.x) * f_, bf_hi(v_.x) * f_); k_.y = cvt_pk_bf16(bf_lo(v_.y) * f_, bf_hi(v_.y) * f_); k_.z = cvt_pk_bf16(bf_lo(v_.z) * f_, bf_hi(v_.z) * f_); k_.w = cvt_pk_bf16(bf_lo(v_.w) * f_, bf_hi(v_.w) * f_); \
            *(LAS u32x4*)(lds + o_) = R[0][i_]; *(LAS u32x4*)(lds + 16384 + o_) = k_; *(LAS u32x4*)(lds + 32768 + o_) = R[2][i_]; *(LAS u32x4*)(lds + 49152 + o_) = R[3][i_]; } } while (0)
#define RET_LN(n_) do { const int row_ = tid >> 3, seg_ = tid & 7; const LAS u32x4* sp_ = (const LAS u32x4*)(stg + row_ * 528 + seg_ * 64); \
          float v_[32]; float sm_ = 0.f; \
          _Pragma("unroll") for (int k = 0; k < 4; ++k) { const u32x4 w = sp_[k]; v_[8 * k] = bf_lo(w.x); v_[8 * k + 1] = bf_hi(w.x); v_[8 * k + 2] = bf_lo(w.y); v_[8 * k + 3] = bf_hi(w.y); v_[8 * k + 4] = bf_lo(w.z); v_[8 * k + 5] = bf_hi(w.z); v_[8 * k + 6] = bf_lo(w.w); v_[8 * k + 7] = bf_hi(w.w); } \
          _Pragma("unroll") for (int k = 0; k < 32; ++k) sm_ += v_[k]; \
          sm_ += swz_xor<1>(sm_); sm_ += swz_xor<2>(sm_); sm_ += swz_xor<4>(sm_); \
          const float mu_ = sm_ * (1.f / 256.f); float ss_ = 0.f; \
          _Pragma("unroll") for (int k = 0; k < 32; ++k) { v_[k] -= mu_; ss_ += v_[k] * v_[k]; } \
          ss_ += swz_xor<1>(ss_); ss_ += swz_xor<2>(ss_); ss_ += swz_xor<4>(ss_); \
          const float rs_ = rsqrtf(ss_ * (1.f / 256.f) + EPS); \
          bf16_t* op_ = ABb + (size_t)((n_) * 64 + row_) * KAB + seg_ * 32; const LAS float* gp_ = gl + seg_ * 32; \
          _Pragma("unroll") for (int k = 0; k < 4; ++k) { const f32x4 g0 = *(const LAS f32x4*)(gp_ + 8 * k), g1 = *(const LAS f32x4*)(gp_ + 8 * k + 4); u32x4 o; \
              o.x = cvt_pk_bf16(v_[8 * k] * rs_ * g0[0], v_[8 * k + 1] * rs_ * g0[1]); o.y = cvt_pk_bf16(v_[8 * k + 2] * rs_ * g0[2], v_[8 * k + 3] * rs_ * g0[3]); \
              o.z = cvt_pk_bf16(v_[8 * k + 4] * rs_ * g1[0], v_[8 * k + 5] * rs_ * g1[1]); o.w = cvt_pk_bf16(v_[8 * k + 6] * rs_ * g1[2], v_[8 * k + 7] * rs_ * g1[3]); \
              *(u32x4*)(op_ + 8 * k) = o; } } while (0)
    if (n_full > n_lo) {
        u32x4 KV[3][3][2];
#pragma unroll
        for (int b3 = 0; b3 < 3; ++b3) if (n_lo + b3 < n_full) { const unsigned zc = zoff + (unsigned)(n_lo + b3) * (unsigned)(64 * 1024);
#pragma unroll
            for (int i = 0; i < 2; ++i) { KV[b3][0][i] = *(const u32x4*)(wsb + (size_t)(unsigned)(zc + 256 + goff[i])); KV[b3][1][i] = *(const u32x4*)(wsb + (size_t)(unsigned)(zc + 512 + goff[i])); KV[b3][2][i] = *(const u32x4*)(wsb + (size_t)(unsigned)(zc + 768 + goff[i])); } }
        const float g64 = ex2(lg * 64.f);
#pragma unroll 1
        for (int n = n_lo; n < n_full; n += 3) {
#pragma unroll
            for (int b3 = 0; b3 < 3; ++b3) { const int nn = n + b3;
                if (nn < n_full) {
#pragma unroll
                    for (int i = 0; i < 2; ++i) { const unsigned o = (tid + 512 * i) * 16; const float f = kf[i]; const u32x4 v = KV[b3][0][i]; u32x4 k;
                        k.x = cvt_pk_bf16(bf_lo(v.x) * f, bf_hi(v.x) * f); k.y = cvt_pk_bf16(bf_lo(v.y) * f, bf_hi(v.y) * f); k.z = cvt_pk_bf16(bf_lo(v.z) * f, bf_hi(v.z) * f); k.w = cvt_pk_bf16(bf_lo(v.w) * f, bf_hi(v.w) * f);
                        *(LAS u32x4*)(lds + 16384 + o) = k; *(LAS u32x4*)(lds + 32768 + o) = KV[b3][1][i]; *(LAS u32x4*)(lds + 49152 + o) = KV[b3][2][i]; }
                    if (nn + 3 < n_full) { const unsigned zc = zoff + (unsigned)(nn + 3) * (unsigned)(64 * 1024);
#pragma unroll
                        for (int i = 0; i < 2; ++i) { KV[b3][0][i] = *(const u32x4*)(wsb + (size_t)(unsigned)(zc + 256 + goff[i])); KV[b3][1][i] = *(const u32x4*)(wsb + (size_t)(unsigned)(zc + 512 + goff[i])); KV[b3][2][i] = *(const u32x4*)(wsb + (size_t)(unsigned)(zc + 768 + goff[i])); } }
                    LBAR();
                    { int lane = lane0; asm volatile("" : "+v"(lane)); LaneAddr LA; lane_addr(lane, LA);
                      const LAS unsigned char* Vimg = lds + 32768 + (wave >> 2) * 16384; const int vc = wave & 3;
                      bf16x8 Vf[4], Ka[2][4];
#pragma unroll
                      for (int ks = 0; ks < 4; ++ks) Vf[ks] = tr_frag(Vimg, TRA(LA, vc, ks, 0), TRA(LA, vc, ks, 1));
#pragma unroll
                      for (int ks = 0; ks < 4; ++ks) Ka[0][ks] = tr_frag(Kimg, TRA(LA, 0, ks, 0), TRA(LA, 0, ks, 1));
#pragma unroll
                      for (int db = 0; db < 4; ++db) {
                          if (db < 3) {
#pragma unroll
                              for (int ks = 0; ks < 4; ++ks) Ka[(db + 1) & 1][ks] = tr_frag(Kimg, TRA(LA, db + 1, ks, 0), TRA(LA, db + 1, ks, 1)); }
                          __builtin_amdgcn_sched_barrier(0);
#pragma unroll
                          for (int e = 0; e < 16; ++e) S[db][e] *= g64;
#pragma unroll
                          for (int ks = 0; ks < 4; ++ks) S[db] = MFMA32(Ka[db & 1][ks], Vf[ks], S[db]);
                          __builtin_amdgcn_sched_barrier(0); } }
                    LBAR();
                } }
        }
        n_lo = n_full;
    }
    RET_LOAD(n_lo); RET_WRITE(); if (n_lo + 1 < n_hi) RET_LOAD(n_lo + 1);
    __syncthreads();
#pragma unroll 1
    for (int n = n_lo; n < n_hi; ++n) {
        int lane = lane0; asm volatile("" : "+v"(lane));
        const int r = lane & 31, h5 = lane >> 5;
        const bool full = n >= n_full;
        LaneAddr LA; lane_addr(lane, LA);
        if (n > n_lo && n - 1 >= n_full) RET_LN(n - 1);
        if (full) { const int lt = wave >> 1, q4 = lane >> 4;
#pragma unroll
          for (int jj = 0; jj < 2; ++jj) { const int jt = 2 * (wave & 1) + jj; f32x4 acc = {0.f, 0.f, 0.f, 0.f};
#pragma unroll
              for (int s2 = 0; s2 < 4; ++s2) { const bf16x8 a = *(const LAS bf16x8*)(Kimg + LA.r16[s2] + 4096 * lt); const bf16x8 bq = *(const LAS bf16x8*)(Qimg + LA.r16[s2] + 4096 * jt); acc = MFMA16(a, bq, acc); }
              const int j = 16 * jt + (lane & 15); float pv[4];
#pragma unroll
              for (int e = 0; e < 4; ++e) { const int lq = 16 * lt + 4 * q4 + e; const int ex = j >= lq ? j - 63 : 2 * lq - j - 63; pv[e] = acc[e] * ex2(lg * (float)ex); }
              u32x2 w; w.x = cvt_pk_bf16(pv[0], pv[1]); w.y = cvt_pk_bf16(pv[2], pv[3]);
              *(LAS u32x2*)(Pimg + off_p(j, 2 * lt + (q4 >> 1)) + 8 * (q4 & 1)) = w; } }
        LBAR();
        const LAS unsigned char* Vimg = lds + 32768 + (wave >> 2) * 16384; const int vc = wave & 3;
#define SB0 __builtin_amdgcn_sched_barrier(0)
        bf16x8 Vf[4];
#pragma unroll
        for (int ks = 0; ks < 4; ++ks) Vf[ks] = tr_frag(Vimg, TRA(LA, vc, ks, 0), TRA(LA, vc, ks, 1));
        f32x16 O[2];
#pragma unroll
        for (int jb = 0; jb < 2; ++jb)
#pragma unroll
            for (int e = 0; e < 16; ++e) O[jb][e] = 0.f;
        bf16x8 Ka[2][4];
        if (full) {
        u32x2 qa[2][2][2];
#define RET_QLOAD(buf, st) do { _Pragma("unroll") for (int jb_ = 0; jb_ < 2; ++jb_) { qa[buf][jb_][0] = *(const LAS u32x2*)(Qimg + QBA(LA, jb_, (st) >> 1, 2 * ((st) & 1))); qa[buf][jb_][1] = *(const LAS u32x2*)(Qimg + QBA(LA, jb_, (st) >> 1, 2 * ((st) & 1) + 1)); } } while (0)
        RET_QLOAD(0, 0);
#pragma unroll
        for (int st = 0; st < 8; ++st) {
            if (st < 7) { if (st & 1) RET_QLOAD(0, st + 1); else RET_QLOAD(1, st + 1); }
            SB0;
            const bf16x8 sb = pack8(S[st >> 1], st & 1);
#pragma unroll
            for (int jb = 0; jb < 2; ++jb) O[jb] = MFMA32(cat8(qa[st & 1][jb][0], qa[st & 1][jb][1]), sb, O[jb]);
            SB0;
        }
        bf16x8 Pf[2][4];
#pragma unroll
        for (int jb = 0; jb < 2; ++jb)
#pragma unroll
            for (int ks = 0; ks < 4; ++ks) Pf[jb][ks] = *(const LAS bf16x8*)(Pimg + LA.pp[ks] + 4096 * jb);
#pragma unroll
        for (int ks = 0; ks < 4; ++ks) Ka[0][ks] = tr_frag(Kimg, TRA(LA, 0, ks, 0), TRA(LA, 0, ks, 1));
        SB0;
#pragma unroll
        for (int jb = 0; jb < 2; ++jb)
#pragma unroll
            for (int e = 0; e < 16; ++e) O[jb][e] *= ex2(lg * (float)(32 * jb + crow(e, h5) + 1));
#pragma unroll
        for (int jb = 0; jb < 2; ++jb)
#pragma unroll
            for (int ks = 0; ks < 4; ++ks) O[jb] = MFMA32(Pf[jb][ks], Vf[ks], O[jb]);
        } else {
#pragma unroll
            for (int ks = 0; ks < 4; ++ks) Ka[0][ks] = tr_frag(Kimg, TRA(LA, 0, ks, 0), TRA(LA, 0, ks, 1));
        }
        { const float g64 = ex2(lg * 64.f);
#pragma unroll
          for (int db = 0; db < 4; ++db) {
              if (db < 3) {
#pragma unroll
                  for (int ks = 0; ks < 4; ++ks) Ka[(db + 1) & 1][ks] = tr_frag(Kimg, TRA(LA, db + 1, ks, 0), TRA(LA, db + 1, ks, 1)); }
              SB0;
#pragma unroll
              for (int e = 0; e < 16; ++e) S[db][e] *= g64;
#pragma unroll
              for (int ks = 0; ks < 4; ++ks) S[db] = MFMA32(Ka[db & 1][ks], Vf[ks], S[db]);
              SB0; } }
#undef RET_QLOAD
        LBAR();
        if (full)
#pragma unroll
        for (int jb = 0; jb < 2; ++jb)
#pragma unroll
            for (int e = 0; e < 16; ++e) *(LAS bf16_t*)(stg + (32 * jb + crow(e, h5)) * 528 + (32 * wave + r) * 2) = (bf16_t)(cvt_pk_bf16(O[jb][e], 0.f) & 0xffff);
        if (n + 1 < n_hi) { RET_WRITE(); if (n + 2 < n_hi) RET_LOAD(n + 2); }
        LBAR();
    }
    RET_LN(n_hi - 1);
    __syncthreads();
#undef RET_LOAD
#undef RET_WRITE
#undef RET_LN
}

DI void hgrn_chain(const Params& p, int l, int chain, LAS unsigned char* lds, int n_lo, int n_hi, int n_full, int W) {
    const int tid = ltid(W), wave = __builtin_amdgcn_readfirstlane(tid >> 6), lane0 = tid & 63;
    const int b = chain >> 2, hd = chain & 3;
    const char* wsb = (const char*)p.ws; const unsigned zoff = (unsigned)(WS_Z + HZ_OFF) + (unsigned)chain * (unsigned)(SEQ * 768);
    bf16_t* ABb = (bf16_t*)(p.ws + WS_AB) + (size_t)b * SEQ * KAB + hd * 128;
    LAS unsigned char* Vimg = lds; LAS unsigned char* Qimg = lds + 16384; LAS unsigned char* Kimg = lds + 32768; LAS unsigned char* Pimg = lds + 49152; LAS unsigned char* stg = Qimg;
    LAS float* tot = (LAS float*)(lds + 57344);
    LAS float* eref = (LAS float*)(lds + 61440); LAS float* e2t = (LAS float*)(lds + 61952); LAS float* gl = (LAS float*)(lds + 62464);
    if (tid < 128) gl[tid] = p.g_hgrn[(size_t)l * 512 + hd * 128 + tid];
    const int vb = wave & 3, jb = wave >> 2;
    unsigned gq, gv[2];
    gq = (unsigned)(8 * wave) * 768u + (unsigned)(4 * lane0);
#pragma unroll
    for (int i = 0; i < 2; ++i) { const unsigned idx = tid + 512 * i, row = idx >> 4, sl = idx & 15; gv[i] = row * 768u + 512u + (sl ^ xrow(row)) * 16; }
    f32x16 S[4];
#pragma unroll
    for (int d = 0; d < 4; ++d)
#pragma unroll
        for (int e = 0; e < 16; ++e) S[d][e] = 0.f;
    unsigned Qr[8], Gr[8]; u32x4 Vr[2];
#define HG_LOADQG(n_) do { const unsigned zc_ = zoff + (unsigned)(n_) * (unsigned)(64 * 768) + gq; \
        _Pragma("unroll") for (int i_ = 0; i_ < 8; ++i_) { Qr[i_] = *(const unsigned*)(wsb + (size_t)(unsigned)(zc_ + i_ * 768)); Gr[i_] = *(const unsigned*)(wsb + (size_t)(unsigned)(zc_ + i_ * 768 + 256)); } } while (0)
#define HG_LOADV(n_) do { const unsigned zc_ = zoff + (unsigned)(n_) * (unsigned)(64 * 768); \
        _Pragma("unroll") for (int i_ = 0; i_ < 2; ++i_) Vr[i_] = *(const u32x4*)(wsb + (size_t)(unsigned)(zc_ + gv[i_])); } while (0)
#define HG_WRITEV() do { _Pragma("unroll") for (int i_ = 0; i_ < 2; ++i_) *(LAS u32x4*)(Vimg + (tid + 512 * i_) * 16) = Vr[i_]; } while (0)
#define HG_LN(n_) do { const int row_ = tid >> 3, seg_ = tid & 7; const LAS u32x4* sp_ = (const LAS u32x4*)(stg + row_ * 272 + seg_ * 32); \
          float v_[16]; float ss_ = 0.f; \
          _Pragma("unroll") for (int k = 0; k < 2; ++k) { const u32x4 w = sp_[k]; v_[8 * k] = bf_lo(w.x); v_[8 * k + 1] = bf_hi(w.x); v_[8 * k + 2] = bf_lo(w.y); v_[8 * k + 3] = bf_hi(w.y); v_[8 * k + 4] = bf_lo(w.z); v_[8 * k + 5] = bf_hi(w.z); v_[8 * k + 6] = bf_lo(w.w); v_[8 * k + 7] = bf_hi(w.w); } \
          _Pragma("unroll") for (int k = 0; k < 16; ++k) ss_ += v_[k] * v_[k]; \
          ss_ += swz_xor<1>(ss_); ss_ += swz_xor<2>(ss_); ss_ += swz_xor<4>(ss_); \
          const float rs_ = rsqrtf(ss_ * (1.f / 128.f) + EPS); \
          bf16_t* op_ = ABb + (size_t)((n_) * 64 + row_) * KAB + seg_ * 16; const LAS float* gp_ = gl + seg_ * 16; \
          _Pragma("unroll") for (int k = 0; k < 2; ++k) { const f32x4 g0 = *(const LAS f32x4*)(gp_ + 8 * k), g1 = *(const LAS f32x4*)(gp_ + 8 * k + 4); u32x4 o; \
              o.x = cvt_pk_bf16(v_[8 * k] * rs_ * g0[0], v_[8 * k + 1] * rs_ * g0[1]); o.y = cvt_pk_bf16(v_[8 * k + 2] * rs_ * g0[2], v_[8 * k + 3] * rs_ * g0[3]); \
              o.z = cvt_pk_bf16(v_[8 * k + 4] * rs_ * g1[0], v_[8 * k + 5] * rs_ * g1[1]); o.w = cvt_pk_bf16(v_[8 * k + 6] * rs_ * g1[2], v_[8 * k + 7] * rs_ * g1[3]); \
              *(u32x4*)(op_ + 8 * k) = o; } } while (0)
    if (n_full > n_lo) {
        unsigned G3[2][8]; u32x4 V3[2][2];
#pragma unroll
        for (int b3 = 0; b3 < 2; ++b3) if (n_lo + b3 < n_full) { const unsigned zc = zoff + (unsigned)(n_lo + b3) * (unsigned)(64 * 768);
#pragma unroll
            for (int i = 0; i < 8; ++i) G3[b3][i] = *(const unsigned*)(wsb + (size_t)(unsigned)(zc + gq + i * 768 + 256));
#pragma unroll
            for (int i = 0; i < 2; ++i) V3[b3][i] = *(const u32x4*)(wsb + (size_t)(unsigned)(zc + gv[i])); }
#pragma unroll 1
        for (int n = n_lo; n < n_full; n += 2) {
#pragma unroll
            for (int b3 = 0; b3 < 2; ++b3) { const int nn = n + b3;
                if (nn < n_full) {
                    int lane = lane0; asm volatile("" : "+v"(lane)); const int h5 = lane >> 5, cp = lane;
                    LaneAddr LA; lane_addr(lane, LA);
                    float c0[8], c1[8];
                    { float a0 = 0.f, a1 = 0.f;
#pragma unroll
                      for (int i = 0; i < 8; ++i) { a0 += h2f((unsigned short)(G3[b3][i] & 0xffff)); a1 += h2f((unsigned short)(G3[b3][i] >> 16)); c0[i] = a0; c1[i] = a1; }
                      *(LAS f32x2*)(tot + wave * 128 + 2 * cp) = (f32x2){a0, a1}; }
#pragma unroll
                    for (int i = 0; i < 2; ++i) *(LAS u32x4*)(Vimg + (tid + 512 * i) * 16) = V3[b3][i];
                    LBAR();
                    { float o0 = 0.f, o1 = 0.f, rf0 = 0.f, rf1 = 0.f, t0 = 0.f, t1 = 0.f;
#pragma unroll
                      for (int t = 0; t < 8; ++t) { const f32x2 v = *(const LAS f32x2*)(tot + t * 128 + 2 * cp); if (t < wave) { o0 += v.x; o1 += v.y; } if (t < 4) { rf0 += v.x; rf1 += v.y; } t0 += v.x; t1 += v.y; }
                      if (wave == 0) { *(LAS f32x2*)(eref + 2 * cp) = (f32x2){ex2(rf0), ex2(rf1)}; *(LAS f32x2*)(e2t + 2 * cp) = (f32x2){ex2(t0 - rf0), ex2(t1 - rf1)}; }
#pragma unroll
                      for (int i = 0; i < 8; ++i) { const int tok = 8 * wave + i;
                          const float g0 = h2f((unsigned short)(G3[b3][i] & 0xffff)), g1 = h2f((unsigned short)(G3[b3][i] >> 16));
                          const float cu0 = o0 + c0[i], cu1 = o1 + c1[i];
                          const float k0 = (1.f - ex2(g0)) * ex2(fminf(rf0 - cu0, 120.f)), k1 = (1.f - ex2(g1)) * ex2(fminf(rf1 - cu1, 120.f));
                          *(LAS unsigned*)(Kimg + off_b(tok, cp >> 2) + (cp & 3) * 4) = cvt_pk_bf16(k0, k1); } }
                    if (nn + 2 < n_full) { const unsigned zc = zoff + (unsigned)(nn + 2) * (unsigned)(64 * 768);
#pragma unroll
                        for (int i = 0; i < 8; ++i) G3[b3][i] = *(const unsigned*)(wsb + (size_t)(unsigned)(zc + gq + i * 768 + 256));
#pragma unroll
                        for (int i = 0; i < 2; ++i) V3[b3][i] = *(const u32x4*)(wsb + (size_t)(unsigned)(zc + gv[i])); }
                    LBAR();
                    { bf16x8 Vf[4], Ka[2][4];
#pragma unroll
                      for (int ks = 0; ks < 4; ++ks) Vf[ks] = tr_frag(Vimg, TRA(LA, vb, ks, 0), TRA(LA, vb, ks, 1));
#pragma unroll
                      for (int ks = 0; ks < 4; ++ks) Ka[0][ks] = tr_frag(Kimg, TRA(LA, 0, ks, 0), TRA(LA, 0, ks, 1));
#pragma unroll
                      for (int db = 0; db < 4; ++db) {
                          f32x4 fe[4];
#pragma unroll
                          for (int g = 0; g < 4; ++g) fe[g] = *(const LAS f32x4*)(eref + 32 * db + 8 * g + 4 * h5);
                          if (db < 3) {
#pragma unroll
                              for (int ks = 0; ks < 4; ++ks) Ka[(db + 1) & 1][ks] = tr_frag(Kimg, TRA(LA, db + 1, ks, 0), TRA(LA, db + 1, ks, 1)); }
                          __builtin_amdgcn_sched_barrier(0);
#pragma unroll
                          for (int g = 0; g < 4; ++g)
#pragma unroll
                              for (int e = 0; e < 4; ++e) S[db][4 * g + e] *= fe[g][e];
#pragma unroll
                          for (int g = 0; g < 4; ++g) fe[g] = *(const LAS f32x4*)(e2t + 32 * db + 8 * g + 4 * h5);
#pragma unroll
                          for (int ks = 0; ks < 4; ++ks) S[db] = MFMA32(Ka[db & 1][ks], Vf[ks], S[db]);
#pragma unroll
                          for (int g = 0; g < 4; ++g)
#pragma unroll
                              for (int e = 0; e < 4; ++e) S[db][4 * g + e] *= fe[g][e];
                          __builtin_amdgcn_sched_barrier(0); } }
                    LBAR();
                } }
        }
        n_lo = n_full;
    }
    HG_LOADQG(n_lo); HG_LOADV(n_lo); HG_WRITEV(); if (n_lo + 1 < n_hi) HG_LOADV(n_lo + 1);
    __syncthreads();
#pragma unroll 1
    for (int n = n_lo; n < n_hi; ++n) {
        const bool full = n >= n_full;
        int lane = lane0; asm volatile("" : "+v"(lane));
        const int r = lane & 31, h5 = lane >> 5, cp = lane;
        LaneAddr LA; lane_addr(lane, LA);
        float c0[8], c1[8];
        { float a0 = 0.f, a1 = 0.f;
#pragma unroll
          for (int i = 0; i < 8; ++i) { a0 += h2f((unsigned short)(Gr[i] & 0xffff)); a1 += h2f((unsigned short)(Gr[i] >> 16)); c0[i] = a0; c1[i] = a1; }
          *(LAS f32x2*)(tot + wave * 128 + 2 * cp) = (f32x2){a0, a1}; }
        if (n > n_lo && n - 1 >= n_full) HG_LN(n - 1);
        LBAR();
        { float o0 = 0.f, o1 = 0.f, rf0 = 0.f, rf1 = 0.f, t0 = 0.f, t1 = 0.f;
#pragma unroll
          for (int t = 0; t < 8; ++t) { const f32x2 v = *(const LAS f32x2*)(tot + t * 128 + 2 * cp); if (t < wave) { o0 += v.x; o1 += v.y; } if (t < 4) { rf0 += v.x; rf1 += v.y; } t0 += v.x; t1 += v.y; }
          if (wave == 0) { *(LAS f32x2*)(eref + 2 * cp) = (f32x2){ex2(rf0), ex2(rf1)}; *(LAS f32x2*)(e2t + 2 * cp) = (f32x2){ex2(t0 - rf0), ex2(t1 - rf1)}; }
#pragma unroll
          for (int i = 0; i < 8; ++i) { const int tok = 8 * wave + i;
              const float g0 = h2f((unsigned short)(Gr[i] & 0xffff)), g1 = h2f((unsigned short)(Gr[i] >> 16));
              const float cu0 = o0 + c0[i], cu1 = o1 + c1[i];
              const float q0 = bf_lo(Qr[i]) * ex2(cu0 - rf0), q1 = bf_hi(Qr[i]) * ex2(cu1 - rf1);
              const float k0 = (1.f - ex2(g0)) * ex2(fminf(rf0 - cu0, 120.f)), k1 = (1.f - ex2(g1)) * ex2(fminf(rf1 - cu1, 120.f));
              const unsigned a = off_b(tok, cp >> 2) + (cp & 3) * 4;
              *(LAS unsigned*)(Qimg + a) = cvt_pk_bf16(q0, q1); *(LAS unsigned*)(Kimg + a) = cvt_pk_bf16(k0, k1); } }
        if (n + 1 < n_hi) HG_LOADQG(n + 1);
        LBAR();
        if (full) { const int lt = wave >> 1, q4 = lane >> 4;
#pragma unroll
          for (int jj = 0; jj < 2; ++jj) { const int jt = 2 * (wave & 1) + jj; f32x4 acc = {0.f, 0.f, 0.f, 0.f};
#pragma unroll
              for (int s2 = 0; s2 < 4; ++s2) { const bf16x8 a = *(const LAS bf16x8*)(Kimg + LA.r16[s2] + 4096 * lt); const bf16x8 bq = *(const LAS bf16x8*)(Qimg + LA.r16[s2] + 4096 * jt); acc = MFMA16(a, bq, acc); }
              const int j = 16 * jt + (lane & 15); float pv[4];
#pragma unroll
              for (int e = 0; e < 4; ++e) { const int lq = 16 * lt + 4 * q4 + e; pv[e] = (lq <= j) ? acc[e] : 0.f; }
              u32x2 w; w.x = cvt_pk_bf16(pv[0], pv[1]); w.y = cvt_pk_bf16(pv[2], pv[3]);
              *(LAS u32x2*)(Pimg + off_p(j, 2 * lt + (q4 >> 1)) + 8 * (q4 & 1)) = w; } }
        LBAR();
        bf16x8 Vf[4];
#pragma unroll
        for (int ks = 0; ks < 4; ++ks) Vf[ks] = tr_frag(Vimg, TRA(LA, vb, ks, 0), TRA(LA, vb, ks, 1));
        f32x16 O;
#pragma unroll
        for (int e = 0; e < 16; ++e) O[e] = 0.f;
        bf16x8 Pf[4];
#pragma unroll
        for (int ks = 0; ks < 4; ++ks) Pf[ks] = *(const LAS bf16x8*)(Pimg + LA.pp[ks] + 4096 * jb);
        u32x2 qa[2][2][2]; bf16x8 Ka[2][4];
#define HG_DLOAD(buf, db_) do { _Pragma("unroll") for (int s_ = 0; s_ < 2; ++s_) { qa[buf][s_][0] = *(const LAS u32x2*)(Qimg + QBA(LA, jb, db_, 2 * s_)); qa[buf][s_][1] = *(const LAS u32x2*)(Qimg + QBA(LA, jb, db_, 2 * s_ + 1)); } \
            _Pragma("unroll") for (int ks_ = 0; ks_ < 4; ++ks_) Ka[buf][ks_] = tr_frag(Kimg, TRA(LA, db_, ks_, 0), TRA(LA, db_, ks_, 1)); } while (0)
        HG_DLOAD(0, 0);
        __builtin_amdgcn_sched_barrier(0);
        if (full) {
#pragma unroll
            for (int ks = 0; ks < 4; ++ks) O = MFMA32(Pf[ks], Vf[ks], O); }
#pragma unroll
        for (int db = 0; db < 4; ++db) {
            f32x4 fe[4];
#pragma unroll
            for (int g = 0; g < 4; ++g) fe[g] = *(const LAS f32x4*)(eref + 32 * db + 8 * g + 4 * h5);
            if (db < 3) { if (db & 1) HG_DLOAD(0, db + 1); else HG_DLOAD(1, db + 1); }
            __builtin_amdgcn_sched_barrier(0);
#pragma unroll
            for (int g = 0; g < 4; ++g)
#pragma unroll
                for (int e = 0; e < 4; ++e) S[db][4 * g + e] *= fe[g][e];
#pragma unroll
            for (int g = 0; g < 4; ++g) fe[g] = *(const LAS f32x4*)(e2t + 32 * db + 8 * g + 4 * h5);
            if (full) {
#pragma unroll
                for (int s2 = 0; s2 < 2; ++s2) O = MFMA32(cat8(qa[db & 1][s2][0], qa[db & 1][s2][1]), pack8(S[db], s2), O); }
#pragma unroll
            for (int ks = 0; ks < 4; ++ks) S[db] = MFMA32(Ka[db & 1][ks], Vf[ks], S[db]);
#pragma unroll
            for (int g = 0; g < 4; ++g)
#pragma unroll
                for (int e = 0; e < 4; ++e) S[db][4 * g + e] *= fe[g][e];
            __builtin_amdgcn_sched_barrier(0);
        }
#undef HG_DLOAD
        LBAR();
        if (full)
#pragma unroll
        for (int e = 0; e < 16; ++e) *(LAS bf16_t*)(stg + (32 * jb + crow(e, h5)) * 272 + (32 * vb + r) * 2) = (bf16_t)(cvt_pk_bf16(O[e], 0.f) & 0xffff);
        if (n + 1 < n_hi) { HG_WRITEV(); if (n + 2 < n_hi) HG_LOADV(n + 2); }
        LBAR();
    }
    HG_LN(n_hi - 1);
    __syncthreads();
#undef HG_LOADQG
#undef HG_LOADV
#undef HG_WRITEV
#undef HG_LN
}
#ifndef SPLIT_RET
#define SPLIT_RET 36
#endif
#ifndef SPLIT_HG
#define SPLIT_HG 41
#endif
DI void phase_scan(const Params& p, int l, LAS unsigned char* lds, int W) {
    for (int it = lbid(); it < 256; it += lgrid()) {
        const int j = it >> 3, bsel = 2 * (it & 7) + (j >> 4), jj = j & 15, chain = (jj >> 3) * 64 + bsel * 4 + ((jj >> 1) & 3), part = jj & 1;
        if (chain < 64) { if (part == 0) ret_chain(p, l, chain, lds, 0, SPLIT_RET, 0, W); else ret_chain(p, l, chain, lds, 0, SEQ / 64, SPLIT_RET, W); }
        else { if (part == 0) hgrn_chain(p, l, chain - 64, lds, 0, SPLIT_HG, 0, W); else hgrn_chain(p, l, chain - 64, lds, 0, SEQ / 64, SPLIT_HG, W); }
    }
}

#define XB_TMO      128
#define XB_XCNT(j)  (256  + 64 * (j))
#define XB_XSUB(j)  (1280 + 64 * (j))
#define XB_XGEN(j)  (2304 + 64 * (j))
#define XB_TOP      3328
#define XB_TOPGEN   3392
#define XB_LSUB(j)  (3456 + 64 * (j))
#define XB_LGEN(j)  (4480 + 64 * (j))
#define XCD_BAR_WORDS 5504
#define XB_SPIN_CAP (1u << 18)
DI unsigned xb_ld(unsigned* p)              { return __hip_atomic_load(p, __ATOMIC_RELAXED, __HIP_MEMORY_SCOPE_AGENT); }
DI unsigned xb_add(unsigned* p, unsigned v) { return __hip_atomic_fetch_add(p, v, __ATOMIC_RELAXED, __HIP_MEMORY_SCOPE_AGENT); }
DI unsigned xb_xcc_id() { return (unsigned)__builtin_amdgcn_s_getreg((3 << 11) | 20) & 0xFu; }
#define XB_SPIN(cond, bar) do { unsigned _sp = 0; while (cond) { __builtin_amdgcn_s_sleep(1); \
    if ((++_sp & 255u) == 0u) { if (xb_ld(&(bar)[XB_TMO])) break; if (_sp > XB_SPIN_CAP) { atomicAdd(&(bar)[XB_TMO], 1u); break; } } } } while (0)
DI void xcd_barrier_post(unsigned* bar, int W) { if (ltid(W) == 0) (void)xb_add(&bar[XB_XCNT(xb_xcc_id())], 1u); }
DI void xcd_barrier_complete(unsigned* bar, unsigned x, unsigned& nloc, unsigned& nx) {
    const unsigned G = (unsigned)lgrid();
    unsigned sum, cnt, mine, sp = 0u;
    for (;;) {
        sum = 0u; cnt = 0u; mine = 0u;
#pragma unroll
        for (unsigned j = 0; j < 16; ++j) { const unsigned c = xb_ld(&bar[XB_XCNT(j)]); sum += c; cnt += (c > 0u) ? 1u : 0u; mine = (j == x) ? c : mine; }
        if (sum == G) break;
        __builtin_amdgcn_s_sleep(1);
        if ((++sp & 255u) == 0u) { if (xb_ld(&bar[XB_TMO])) break; if (sp > XB_SPIN_CAP) { atomicAdd(&bar[XB_TMO], 1u); break; } }
    }
    nloc = mine > 0u ? mine : 1u; nx = cnt > 0u ? cnt : 1u;
}
DI void xcd_barrier(unsigned* bar, volatile LAS unsigned* st, int W) {
    asm volatile("s_waitcnt vmcnt(0)" ::: "memory");
    __syncthreads();
    if (ltid(W) == 0) {
        const unsigned x = xb_xcc_id();
        __builtin_amdgcn_s_waitcnt(0);
        unsigned nloc = st[0], nx = st[1];
        if (nloc == 0u) { xcd_barrier_complete(bar, x, nloc, nx); st[0] = nloc; st[1] = nx; }
        const unsigned old = xb_add(&bar[XB_XSUB(x)], 1u);
        const unsigned gen = old / nloc;
        if (old + 1u == (gen + 1u) * nloc) {
            __builtin_amdgcn_fence(__ATOMIC_RELEASE, "agent");
            asm volatile("s_waitcnt vmcnt(0)" ::: "memory");
            const unsigned og = xb_add(&bar[XB_TOP], 1u);
            const unsigned tg = og / nx;
            if (og + 1u == (tg + 1u) * nx) xb_add(&bar[XB_TOPGEN], 1u);
            else XB_SPIN(xb_ld(&bar[XB_TOPGEN]) == tg, bar);
            __builtin_amdgcn_fence(__ATOMIC_ACQUIRE, "agent");
            xb_add(&bar[XB_XGEN(x)], 1u);
            asm volatile("s_waitcnt vmcnt(0)" ::: "memory");
        } else {
            XB_SPIN(xb_ld(&bar[XB_XGEN(x)]) == gen, bar);
            __builtin_amdgcn_fence(__ATOMIC_ACQUIRE, "agent");
            asm volatile("s_waitcnt vmcnt(0)" ::: "memory");
        }
    }
    __syncthreads();
}

DI void local_barrier(unsigned* bar, int W) {
    asm volatile("s_waitcnt vmcnt(0)" ::: "memory");
    __syncthreads();
    if (ltid(W) == 0) {
        const unsigned x = (unsigned)lbid() & 7u;
        const unsigned old = xb_add(&bar[XB_LSUB(x)], 1u), gen = old >> 5;
        if ((old & 31u) == 31u) xb_add(&bar[XB_LGEN(x)], 1u);
        else XB_SPIN(xb_ld(&bar[XB_LGEN(x)]) == gen, bar);
        asm volatile("buffer_inv sc0\n\ts_waitcnt vmcnt(0)" ::: "memory");
    }
    __syncthreads();
}

#ifndef PROBE_REP_A
#define PROBE_REP_A 0
#endif
#ifndef PROBE_WHICH
#define PROBE_WHICH 0
#endif
#ifndef PROBE_REP_S
#define PROBE_REP_S 0
#endif
#ifndef PROBE_N1
#define PROBE_N1 0
#endif
#ifndef PROBE_PRO
#define PROBE_PRO 0
#endif
#ifndef PROBE_SYNC
#define PROBE_SYNC 0
#endif
#ifndef PROBE_RET2
#define PROBE_RET2 0
#endif
#ifndef PROBE_HG2
#define PROBE_HG2 0
#endif
#ifndef DBG_STOP
#define DBG_STOP 0
#endif
DI void dbg_dump(const Params& p, size_t ws_off, int W) {
    const bf16_t* b = (const bf16_t*)(p.ws + ws_off); const size_t n = (size_t)M * D; const size_t g = (size_t)lbid() * 512 + ltid(W), ng = (size_t)lgrid() * 512;
    for (size_t base = 0; base < n; base += ng) { const size_t i = base + g; if (i < n) p.out[i] = bf2f(b[i]); }
}
#define DBG_AT(k, off) do { if (DBG_STOP == (k)) { if ((off) != ~(size_t)0) dbg_dump(PP, (off), W); return; } } while (0)
typedef const __attribute__((address_space(4))) Params* KP;
DI KP launder(KP k) { asm volatile("" : "+s"(k)); return k; }
#define PP (*(const Params*)launder(kp))
#define CGSYNC() do { asm volatile("s_waitcnt vmcnt(0) lgkmcnt(0)" ::: "memory"); grid.sync(); __builtin_amdgcn_fence(__ATOMIC_ACQUIRE, "agent"); asm volatile("s_waitcnt vmcnt(0)" ::: "memory"); __syncthreads(); } while (0)
#define GSYNC() xcd_barrier((unsigned*)WSP(WS_CTL) + CW_BAR, (volatile LAS unsigned*)(lds + 147392), W)
#define WSP(off) (PP.ws + (off))
#ifndef LS_MASK
#define LS_MASK 127
#endif
#define LSYNC(k) do { if (((LS_MASK >> (k)) & 1) && ((volatile LAS unsigned*)(lds + 147392))[2] != 0u) local_barrier((unsigned*)WSP(WS_CTL) + CW_BAR, W); else GSYNC(); } while (0)
template <int l> DI void run_layer(KP kp, LAS unsigned char* lds, int W) {
#if PROBE_N1
        for (int rep = 0; rep < PROBE_N1; ++rep) { if (l == 0) { const Params& p = PP; phase_norm1(p, p.x, l, W); GSYNC(); } }
#endif
        { const Params& p = PP; phase_norm1(p, l == 0 ? p.x : (const float*)nullptr, l, W);
          if (l == 1) { const int tid = ltid(W), wave = __builtin_amdgcn_readfirstlane(tid >> 6), lane = tid & 63; LAS float* scr = (LAS float*)(lds + wave * 16384);
              for (int it = IT_LAYER + IT_NE + lbid() * 8 + wave; it < IT_ALL; it += lgrid() * 8) t_dispatch(p, it, scr, lane); } }
        LSYNC(0);
#if PROBE_REP_A
        for (int rep = 0; rep < PROBE_REP_A; ++rep) { if (l == 0) { PInA_bare P; P.wsb = (const char*)WSP(0); P.aoff0 = (unsigned)WS_H; P.boff0 = (unsigned)(WS_WIN + (size_t)l * NIN * D); P.l = l;
          P.so.init(lgrid(), lbid()); pg::gemm_phase(lds, P, W); GSYNC(); } }
#endif
        { PInA P; P.wsb = (const char*)WSP(0); P.aoff0 = (unsigned)WS_H; P.boff0 = (unsigned)(WS_WIN + (size_t)l * NIN * D); P.l = l;
          P.so.init(lgrid(), lbid()); pg::gemm_phase(lds, P, W); }
        LSYNC(1);
        DBG_AT(1, WS_Z);
#if SCAN_V0
        phase_scan_v0(PP, lds, W);
        GSYNC();
        phase_headnorm(PP, l, W);
        GSYNC();
#else
#if PROBE_REP_S
        for (int rep = 0; rep < PROBE_REP_S; ++rep) { if (l == 0) { phase_scan(PP, l, lds, W); GSYNC(); } }
#endif
        phase_scan(PP, l, lds, W);
        LSYNC(2);
#endif
        DBG_AT(2, WS_AB);
        { PInC P; P.wsb = (const char*)WSP(0); P.aoff0 = (unsigned)WS_H; P.boff0 = (unsigned)(WS_WIN + ((size_t)l * NIN + NZA) * D);
          P.so.init(lgrid(), lbid()); pg::gemm_phase(lds, P, W); }
        LSYNC(3);
        DBG_AT(3, WS_Z);
        { PMerge P; P.wsb = (const char*)WSP(0); P.aoff0 = (unsigned)(FP8_DE ? WS_Z + AB8_OFF : WS_AB); P.boff0 = (unsigned)(WS_WAB + (size_t)l * D * KAB * (FP8_DE ? 1 : 2));
          P.so.init(lgrid(), lbid()); pg::gemm_phase(lds, P, W); }
        LSYNC(4);
        DBG_AT(4, WS_H);
        { const Params& p = PP; PWout P; P.wsb = (const char*)p.ws; P.aoff0 = (unsigned)WS_H; P.boff0 = (unsigned)(WS_WOUT + (size_t)l * D * D * (FP8_DE ? 1 : 2)); P.xin32 = p.x; P.l = l;
          P.so.init(lgrid(), lbid()); pg::gemm_phase(lds, P, W); }
        LSYNC(5);
        DBG_AT(5, ~(size_t)0);
        phase_norm2(PP, l, lds, W);
        GSYNC();
        LAS int* lcnt = (LAS int*)(lds + LDS_AUX); LAS int* ltoff = lcnt + 32;
        { const int t = ltid(W);
          if (t < 32) { const unsigned* gcnt = (const unsigned*)WSP(WS_CTL) + CW_CNT + l * 32; lcnt[t] = t < NCLS ? (int)__hip_atomic_load(gcnt + t, __ATOMIC_RELAXED, __HIP_MEMORY_SCOPE_AGENT) : 0; }
          if (t == 0) { int off = 0;
            for (int c = 0; c < NCLS; ++c) { ltoff[c] = off; off += (lcnt[c] + 255) >> 8; }
            ltoff[NCLS] = off; } }
        __syncthreads();
        const int mx = lbid() & 7, mj = lbid() >> 3, mtot = __builtin_amdgcn_readfirstlane(ltoff[NCLS]);
        const int Tl = mtot > mx ? (mtot - mx + 7) >> 3 : 0;
        unsigned* mctr = (unsigned*)WSP(WS_CTL) + CW_MOE + (l * 8 + mx) * 64;
        int hstart = 0, nH = 0; const int nL = 4 * (Tl > 32 ? Tl - 32 : 0);
        { const int tot12 = 12 * Tl, q = tot12 >> 5, rem = tot12 & 31;
          for (int jj = 0; jj <= mj; ++jj) { const int g8 = 8 * Tl - jj, nG = g8 > 0 ? (g8 + 31) >> 5 : 0; int h = q + (jj < rem ? 1 : 0) - nG; h = h < 0 ? 0 : h; if (jj < mj) hstart += h; else nH = h; } }
        { PMoe1 P; P.wsb = (const char*)WSP(0); P.l = l; P.T.lcnt = lcnt; P.T.ltoff = ltoff; P.G = lgrid(); P.c = lbid(); P.W = W; P.lds = lds; P.ctr = mctr; P.Tl = Tl;
          pg::gemm_phase(lds, P, W); }
        if (((LS_MASK >> 6) & 1) && ((volatile LAS unsigned*)(lds + 147392))[2] != 0u) {
            if (ltid(W) == 0) { unsigned* bar = (unsigned*)WSP(WS_CTL) + CW_BAR;
                const unsigned nA = (unsigned)(64 * (Tl < 32 ? Tl : 32)), nB = (unsigned)(64 * (Tl > 32 ? Tl - 32 : 0));
                XB_SPIN(xb_ld(mctr) < nA, bar);
                if (hstart < nL) XB_SPIN(xb_ld(mctr + 1) < nB, bar);
                asm volatile("buffer_inv sc0\n\ts_waitcnt vmcnt(0)" ::: "memory"); }
            __syncthreads();
        } else GSYNC();
        DBG_AT(6, WS_Z);
        { PMoe2 P; P.wsb = (const char*)WSP(0); P.l = l; P.T.lcnt = lcnt; P.T.ltoff = ltoff; P.G = lgrid(); P.c = lbid(); P.hstart = hstart; P.nH = nH; P.nL = nL;
          pg::gemm_phase(lds, P, W); }
        GSYNC();
        DBG_AT(7, ~(size_t)0);
    }
__global__ void __launch_bounds__(512, 2) fwd_mega(Params p_unused) {
    extern __shared__ __attribute__((aligned(16))) unsigned char lds_raw[];
    LAS unsigned char* lds = (LAS unsigned char*)lds_raw;
    int W = __builtin_amdgcn_readfirstlane((int)threadIdx.x >> 6); asm volatile("" : "+s"(W));
    cg::grid_group grid = cg::this_grid();
    KP kp = (KP)__builtin_amdgcn_kernarg_segment_ptr();

    { const int t0 = ltid(W); if (t0 < 4) ((volatile LAS unsigned*)(lds + 147392))[t0] = 0u;
      if (t0 == 0) { unsigned* lab = (unsigned*)WSP(WS_CTL) + CW_LAB + 2 * (lbid() & 7); const unsigned xcc = xb_xcc_id();
          atomicMax(lab, xcc + 1u); atomicMax(lab + 1, 16u - xcc); } }
    __syncthreads();
    xcd_barrier_post((unsigned*)WSP(WS_CTL) + CW_BAR, W);
#if PROBE_PRO
    for (int rep = 0; rep < PROBE_PRO; ++rep) { phase_prologue(PP, lds, W); GSYNC(); }
#endif
    phase_prologue(PP, lds, W);
    CGSYNC();
    if (ltid(W) == 0) {
        const unsigned* lab = (const unsigned*)WSP(WS_CTL) + CW_LAB; unsigned ok = (lgrid() == 256) ? 1u : 0u;
        for (int x = 0; x < 8; ++x) { const unsigned a = xb_ld((unsigned*)lab + 2 * x), b = xb_ld((unsigned*)lab + 2 * x + 1); ok &= (a + b == 17u) ? 1u : 0u; }
        ((volatile LAS unsigned*)(lds + 147392))[2] = ok; }
    __syncthreads();
#if PROBE_SYNC
    for (int rep = 0; rep < PROBE_SYNC; ++rep) GSYNC();
#endif
    run_layer<0>(kp, lds, W);
    run_layer<1>(kp, lds, W);
    phase_final(PP, W);
#undef PP
#undef GSYNC
#undef CGSYNC
#undef WSP
}

extern "C" void kernel_launch(void* const* d_in, const int* in_sizes, int n_in, void* d_out, int out_size, void* d_ws, size_t ws_size, hipStream_t stream) {
    static int grid_blocks = 0;
    if (grid_blocks == 0) {
        if (n_in != 19 || out_size != M * D || ws_size < WS_END) { fprintf(stderr, "kernel_launch: unexpected shapes (n_in %d, out %d, ws %zu; need ws >= %zu)\n", n_in, out_size, ws_size, (size_t)WS_END); grid_blocks = -1; return; }
        int dev = 0, cus = 0, per_cu = 0;
        (void)hipGetDevice(&dev);
        (void)hipDeviceGetAttribute(&cus, hipDeviceAttributeMultiprocessorCount, dev);
        (void)hipFuncSetAttribute((const void*)fwd_mega, hipFuncAttributeMaxDynamicSharedMemorySize, LDS_BYTES);
        (void)hipOccupancyMaxActiveBlocksPerMultiprocessor(&per_cu, (const void*)fwd_mega, 512, LDS_BYTES);
        if (per_cu < 1) { fprintf(stderr, "kernel_launch: occupancy query says %d blocks per CU\n", per_cu); per_cu = 1; }
        grid_blocks = cus * 1;
        fprintf(stderr, "kernel_launch: cus %d per_cu %d grid %d ws %zu\n", cus, per_cu, grid_blocks, ws_size);
    }
    if (grid_blocks < 0) return;
    (void)hipMemsetAsync((char*)d_ws + WS_CTL, 0, CTL_BYTES, stream);
    Params p{};
    const float** pp = (const float**)&p;
    for (int i = 0; i < 19; ++i) pp[i] = (const float*)d_in[i];
    p.out = (float*)d_out; p.ws = (unsigned char*)d_ws;
    void* args[] = {&p};
    hipError_t e = hipLaunchCooperativeKernel((const void*)fwd_mega, dim3(grid_blocks), dim3(512), args, LDS_BYTES, stream);
    if (e != hipSuccess) fprintf(stderr, "cooperative launch failed: %s (grid %d)\n", hipGetErrorString(e), grid_blocks);
}
```

```cpp
#include <hip/hip_runtime.h>
#include <hip/hip_cooperative_groups.h>
#include <cstdio>
#include <cstdint>
namespace cg = cooperative_groups;
#ifndef SCAN_V0
#define SCAN_V0 0
#endif

#define LAS __attribute__((address_space(3)))
typedef unsigned short bf16_t;
typedef short bf16x8 __attribute__((ext_vector_type(8)));
typedef float f32x4 __attribute__((ext_vector_type(4)));
typedef float f32x2 __attribute__((ext_vector_type(2)));
typedef unsigned u32x4 __attribute__((ext_vector_type(4)));
typedef unsigned u32x2 __attribute__((ext_vector_type(2)));
#define DI __device__ __forceinline__

constexpr int D = 1024, NB = 16, SEQ = 4096, M = NB * SEQ, DEPTH = 2;
constexpr int NZA = 3584, NZC = 3584, NIN = 7168;
constexpr int KAB = 1536;
constexpr int NE = 16, DE = 512, NCLS = 24;
constexpr float EPS = 1e-6f;
constexpr int ZQ = 0, ZG2 = 512, ZI = 1024, ZQR = 1536, ZKR = 2048, ZV = 2560;
constexpr size_t HZ_OFF = 256u << 20;

constexpr size_t MiB = 1u << 20;
constexpr size_t WS_CTL = 0, CTL_BYTES = 1 * MiB;
constexpr size_t WS_ROT = 1 * MiB;
constexpr size_t WS_MOD = 3 * MiB;
constexpr size_t WS_LBT = 3 * MiB + 768 * 1024;
constexpr size_t WS_WIN = 4 * MiB;
constexpr size_t WS_WAB = 32 * MiB;
constexpr size_t WS_WOUT = 38 * MiB;
constexpr size_t WS_WG = 42 * MiB;
constexpr size_t WS_WU = 58 * MiB;
constexpr size_t WS_WD = 74 * MiB;
constexpr size_t WS_LIST = 90 * MiB;
constexpr size_t WS_WL = 96 * MiB;
constexpr size_t WS_TOKI = 108 * MiB;
constexpr size_t WS_X16 = 110 * MiB;
constexpr size_t WS_H = 238 * MiB;
constexpr size_t WS_AB = 366 * MiB;
constexpr size_t WS_Z = 558 * MiB;
constexpr size_t WS_END = 1006 * MiB;
constexpr int CW_BAR = 16384;
constexpr int CW_CNT = 1024;

constexpr int LDS_BYTES = 163840;
constexpr int LDS_IDT = 147456;
constexpr int LDS_AUX = 131072;

typedef __bf16 bf16x2_t __attribute__((ext_vector_type(2)));
DI unsigned cvt_pk_bf16(float lo, float hi) { const bf16x2_t r = __builtin_convertvector((f32x2){lo, hi}, bf16x2_t); return __builtin_bit_cast(unsigned, r); }
typedef int i32x4 __attribute__((ext_vector_type(4)));
typedef int i32x8 __attribute__((ext_vector_type(8)));
DI unsigned pk_fp8x4(float a, float b, float c, float d, float S) {
    a = __builtin_amdgcn_fmed3f(a * S, -448.f, 448.f); b = __builtin_amdgcn_fmed3f(b * S, -448.f, 448.f); c = __builtin_amdgcn_fmed3f(c * S, -448.f, 448.f); d = __builtin_amdgcn_fmed3f(d * S, -448.f, 448.f);
    int pk = __builtin_amdgcn_cvt_pk_fp8_f32(a, b, 0, false); pk = __builtin_amdgcn_cvt_pk_fp8_f32(c, d, pk, true); return (unsigned)pk; }
constexpr float S8_ACT = 4.f, S8_W = 64.f, S8_ACT2 = 8.f;
#ifndef FP8_DE
#define FP8_DE 1
#endif
constexpr size_t AB8_BX = (size_t)6 << 20;
constexpr size_t H2_BX = (size_t)8 << 20;
constexpr int CW_MOE = 3072;
constexpr int CW_LAB = 2048;
constexpr size_t AB8_OFF = (size_t)256 << 20;
DI float bf_lo(unsigned u) { return __uint_as_float(u << 16); }
DI float bf_hi(unsigned u) { return __uint_as_float(u & 0xffff0000u); }
DI float bf2f(bf16_t b) { return __uint_as_float(((unsigned)b) << 16); }
DI float sigm(float x) { return __builtin_amdgcn_rcpf(1.f + __expf(-x)); }
DI float silu(float x) { return x * sigm(x); }
DI unsigned pk_f16(float a, float b) { _Float16 ha = (_Float16)a, hb = (_Float16)b; return (unsigned)__builtin_bit_cast(unsigned short, ha) | ((unsigned)__builtin_bit_cast(unsigned short, hb) << 16); }
DI float h2f(unsigned short u) { return (float)__builtin_bit_cast(_Float16, u); }
template <int X> DI float swz_xor(float v) { return __int_as_float(__builtin_amdgcn_ds_swizzle(__float_as_int(v), (X << 10) | 0x1f)); }
DI float sum16(float v) { v += swz_xor<1>(v); v += swz_xor<2>(v); v += swz_xor<4>(v); v += swz_xor<8>(v); return v; }
DI float wave_sum(float v) {
    v = sum16(v); v += swz_xor<16>(v);
    const auto r = __builtin_amdgcn_permlane32_swap(__float_as_uint(v), __float_as_uint(v), false, false);
    return __uint_as_float(r[0]) + __uint_as_float(r[1]);
}
template <int CTRL> DI float dppf(float x) { return __int_as_float(__builtin_amdgcn_update_dpp(0, __float_as_int(x), CTRL, 0xf, 0xf, false)); }
DI float reduce16(const float (&p)[16], int lane) {
    float q[8], r4[4], t[2];
#pragma unroll
    for (int e = 0; e < 8; ++e) { const auto r = __builtin_amdgcn_permlane32_swap(__float_as_uint(p[e]), __float_as_uint(p[e + 8]), false, false); q[e] = __uint_as_float(r[0]) + __uint_as_float(r[1]); }
#pragma unroll
    for (int e = 0; e < 4; ++e) { const auto r = __builtin_amdgcn_permlane16_swap(__float_as_uint(q[e]), __float_as_uint(q[e + 4]), false, false); r4[e] = __uint_as_float(r[0]) + __uint_as_float(r[1]); }
    const bool b3 = (lane & 8) != 0, b2 = (lane & 4) != 0;
#pragma unroll
    for (int e = 0; e < 2; ++e) { const float sel = b3 ? r4[e + 2] : r4[e], oth = b3 ? r4[e] : r4[e + 2]; t[e] = sel + dppf<0x140>(oth); }
    const float sel = b2 ? t[1] : t[0], oth = b2 ? t[0] : t[1];
    float u = sel + dppf<0x141>(oth);
    u += dppf<0xB1>(u); u += dppf<0x4E>(u);
    return u;
}
#define LDS_WAIT() asm volatile("s_waitcnt lgkmcnt(0)" ::: "memory")
DI int ltid(int W) { int t; asm volatile("v_mbcnt_lo_u32_b32 %0, -1, 0\n\tv_mbcnt_hi_u32_b32 %0, -1, %0\n\tv_lshl_add_u32 %0, %1, 6, %0" : "=&v"(t) : "s"(W)); return t; }
DI int lbid() { int b = blockIdx.x; asm volatile("" : "+s"(b)); return b; }
DI int lgrid() { int g = gridDim.x; asm volatile("" : "+s"(g)); return g; }

DI int src_col_in(int r) {
    if (r < NZA) {
        if (r < 1536) return r;
        if (r < 2560) { const int seg = (r - 1536) >> 9, w = (r - 1536) & 511, head = w >> 7, p = w & 127, i = p >> 1, half = p & 1;
            return 2048 + seg * 512 + head * 128 + half * 64 + i; }
        return 3072 + (r - 2560);
    }
    const int q = r - NZA;
    if (q < 512) return 1536 + q;
    if (q < 1536) return 4096 + (q - 512);
    { const int qq = q - 1536, k = qq >> 8, w = qq & 255; return 5120 + (w >> 7) * 1024 + k * 128 + (w & 127); }
}

namespace pg {
constexpr int BM = 256, BK = 64, HALF = 128, HTB = HALF * BK * 2, STAGE_BYTES = 8 * HTB;
DI int lds_byte(int r, int c) { const int st = (r >> 4) * 2 + (c >> 5), rr = r & 15, cc = c & 31, ob = rr * 64 + cc * 2; return st * 1024 + (ob ^ (((ob >> 9) & 1) << 5)); }
DI void stage_rc(int b, int& R, int& C) { const int st = b / 1024, sb = b % 1024, swz = sb ^ (((sb >> 9) & 1) << 5); R = (st >> 1) * 16 + swz / 64; C = (st & 1) * 32 + (swz % 64) / 2; }
DI int perm32(int rho) { const int n = rho >> 4, i = rho & 15; return 8 * (i >> 2) + 4 * n + (i & 3); }

struct Unit { int pm, pn, cls, cnt, rowpos, seq; };
typedef f32x4 Acc[2][2][4][2];

template <int NM, int NN> struct StaticOrder {
    int G, c;
    DI void init(int G_, int c_) { G = G_; c = c_; }
    DI bool next(int i, Unit& u) const {
        constexpr int nwg = NM * NN; static_assert(nwg % 8 == 0 && NM % 8 == 0, "shape");
        const int L = i * G + c; if (L >= nwg) return false;
        const int wgid = (L % 8) * (nwg / 8) + L / 8;
        constexpr int nig = 8 * NN; const int gid = wgid / nig, fm = gid * 8;
        u.pm = fm + ((wgid % nig) % 8); u.pn = (wgid % nig) / 8; u.cls = 0; u.cnt = 0; u.rowpos = 0; u.seq = i; return true;
    }
};

template <class P, class = void> struct HasDone { static constexpr bool v = false; };
template <class P> struct HasDone<P, decltype((void)P::HAS_DONE)> { static constexpr bool v = P::HAS_DONE; };
template <class P, class = void> struct HasDmaAddr { static constexpr bool v = false; };
template <class P> struct HasDmaAddr<P, decltype((void)P::DMA_ADDR)> { static constexpr bool v = P::DMA_ADDR; };
template <class P>
DI void gemm_phase(LAS unsigned char* lds, const P& p, int W) {
    constexpr int NT = P::NT;
    typedef typename P::Adr Adr;
    const int tid = ltid(W), wid = __builtin_amdgcn_readfirstlane(tid >> 6), lane = tid & 63, wr = wid >> 2, wc = wid & 3, fr = lane & 15, fq = lane >> 4;
    unsigned voffA;
    { int R, C; stage_rc(tid * 16, R, C); voffA = (unsigned)(R * P::LDA + C * 2); }
#define voffB (P::LDA == P::LDB ? voffA : ((voffA / (unsigned)P::LDA) * (unsigned)P::LDB + (voffA & 127u)))
    const unsigned ldsw = (unsigned)wid * 1024u;
    int lfrag = lds_byte(fr, fq * 8); const int aU = wr * 8192, bU = wc * 4096;
#define aoff (aU + lfrag)
#define boff (bU + lfrag)
#define PG_SA(b, h) (((b) * 2 + (h)) * HTB)
#define PG_SB(b, h) ((4 + (b) * 2 + (h)) * HTB)
#define PG_GLDS(src, dstoff) __builtin_amdgcn_global_load_lds((const unsigned*)(src), (LAS unsigned*)(lds + (dstoff)), 16, 0, 0)
#define PG_STAGE_A(bufoff, adr, h, t) do { const unsigned _ab = p.abase(adr, h, t), _pre = p.apre(adr, h); _Pragma("unroll") for (int _i = 0; _i < 2; ++_i) PG_GLDS(p.wsb + (size_t)(unsigned)(_ab + p.avoff(adr, h, _i, voffA, _pre) + (unsigned)(_i * P::AIOFF)), (bufoff) + ldsw + _i * 8192); } while (0)
#define PG_STAGE_B(bufoff, adr, h, t) do { const unsigned _bb = p.bbase(adr, h, t); _Pragma("unroll") for (int _i = 0; _i < 2; ++_i) PG_GLDS(p.wsb + (size_t)(unsigned)(_bb + voffB + (unsigned)(_i * 64 * P::LDB)), (bufoff) + ldsw + _i * 8192); } while (0)
#define PG_LDA(dst, b, h) do { _Pragma("unroll") for (int m = 0; m < 4; ++m) _Pragma("unroll") for (int k = 0; k < 2; ++k) dst[m][k] = *(const LAS bf16x8*)(lds + PG_SA(b, h) + aoff + m * 2048 + k * 1024); } while (0)
#define PG_LDB(dst, b, h) do { _Pragma("unroll") for (int n = 0; n < 2; ++n) _Pragma("unroll") for (int k = 0; k < 2; ++k) dst[n][k] = *(const LAS bf16x8*)(lds + PG_SB(b, h) + boff + n * 2048 + k * 1024); } while (0)
#define PG_CAT8(x) __builtin_shufflevector(__builtin_bit_cast(i32x4, x[0]), __builtin_bit_cast(i32x4, x[1]), 0, 1, 2, 3, 4, 5, 6, 7)
#define PG_MMA(ai, bj, At, Bt) do { __builtin_amdgcn_s_setprio(1); \
        if constexpr (P::FP8) { _Pragma("unroll") for (int m = 0; m < 4; ++m) _Pragma("unroll") for (int n = 0; n < 2; ++n) \
            acc[ai][bj][m][n] = __builtin_amdgcn_mfma_scale_f32_16x16x128_f8f6f4(PG_CAT8(Bt[n]), PG_CAT8(At[m]), acc[ai][bj][m][n], 0, 0, 0, 0, 0, 0); } \
        else { _Pragma("unroll") for (int m = 0; m < 4; ++m) _Pragma("unroll") for (int n = 0; n < 2; ++n) _Pragma("unroll") for (int k = 0; k < 2; ++k) \
            acc[ai][bj][m][n] = __builtin_amdgcn_mfma_f32_16x16x32_bf16(Bt[n][k], At[m][k], acc[ai][bj][m][n], 0, 0, 0); } \
        __builtin_amdgcn_s_setprio(0); } while (0)
#define PG_WAIT_V(n) asm volatile("s_waitcnt vmcnt(" #n ")" ::: "memory")
#define PG_WAIT_L(n) asm volatile("s_waitcnt lgkmcnt(" #n ")" ::: "memory")
#define PG_BAR __builtin_amdgcn_s_barrier()
#define PG_SCHED __builtin_amdgcn_sched_barrier(0)
    Unit cur, nxt; int ui = 0;
    if (!p.next(0, cur)) return;
    Adr ca, na;
    p.addr(cur, ca);
    if constexpr (HasDmaAddr<P>::v) asm volatile("s_waitcnt vmcnt(0)" ::: "memory");
    Acc acc;
#pragma unroll
    for (int a = 0; a < 2; ++a)
#pragma unroll
        for (int b = 0; b < 2; ++b)
#pragma unroll
            for (int m = 0; m < 4; ++m)
#pragma unroll
                for (int n = 0; n < 2; ++n) acc[a][b][m][n] = (f32x4){0.f, 0.f, 0.f, 0.f};
    bf16x8 At[4][2], B0[2][2], B1[2][2];
    PG_STAGE_B(PG_SB(0, 0), ca, 0, 0); PG_STAGE_B(PG_SB(0, 1), ca, 1, 0); PG_STAGE_A(PG_SA(0, 0), ca, 0, 0); PG_STAGE_A(PG_SA(0, 1), ca, 1, 0);
    if (wr == 1) PG_BAR;
    PG_WAIT_V(2); PG_BAR;
    PG_STAGE_B(PG_SB(1, 0), ca, 0, 1); PG_STAGE_A(PG_SA(1, 0), ca, 0, 1); PG_STAGE_B(PG_SB(1, 1), ca, 1, 1);
    PG_WAIT_V(6); PG_BAR;
    for (;;) {
        const bool has_next = p.next(ui + 1, nxt);
        if (has_next) p.addr(nxt, na); else na = ca;
        for (int t = 0; t < NT; t += 2) {
            asm volatile("" : "+v"(voffA), "+v"(lfrag));
            const bool last = (t == NT - 2);
            if constexpr (P::HAS_MID) { if (t == P::TMID) { const int l2 = ltid(W) & 63; p.mid(acc, cur, wr, wc, l2 & 15, l2 >> 4); } }
            const Adr xa = last ? na : ca;
            const int t1 = t + 1, t2 = last ? 0 : t + 2, t3 = t2 + 1;
            PG_LDB(B0, 0, 0); PG_LDB(B1, 0, 1); PG_SCHED; PG_LDA(At, 0, 0); PG_STAGE_A(PG_SA(1, 1), ca, 1, t1);
            PG_WAIT_V(8); PG_WAIT_L(0); PG_BAR; PG_MMA(0, 0, At, B0); PG_MMA(0, 1, At, B1); PG_BAR; PG_SCHED;
            PG_LDA(At, 0, 1); PG_STAGE_B(PG_SB(0, 0), xa, 0, t2); PG_STAGE_B(PG_SB(0, 1), xa, 1, t2); PG_STAGE_A(PG_SA(0, 0), xa, 0, t2);
            PG_WAIT_V(8); PG_WAIT_L(0); PG_BAR; PG_MMA(1, 0, At, B0); PG_MMA(1, 1, At, B1); PG_BAR; PG_SCHED;
            PG_LDB(B0, 1, 0); PG_LDB(B1, 1, 1); PG_SCHED; PG_LDA(At, 1, 0); PG_STAGE_A(PG_SA(0, 1), xa, 1, t2);
            PG_WAIT_V(8); PG_WAIT_L(0); PG_BAR; PG_MMA(0, 0, At, B0); PG_MMA(0, 1, At, B1); PG_BAR; PG_SCHED;
            PG_LDA(At, 1, 1); PG_STAGE_B(PG_SB(1, 0), xa, 0, t3); PG_STAGE_B(PG_SB(1, 1), xa, 1, t3); PG_STAGE_A(PG_SA(1, 0), xa, 0, t3);
            PG_WAIT_V(8); PG_WAIT_L(0); PG_BAR; PG_MMA(1, 0, At, B0); PG_MMA(1, 1, At, B1); PG_BAR; PG_SCHED;
        }
        if (wr == 0) PG_BAR;
        { const int l2 = ltid(W) & 63; p.epi(acc, cur, wr, wc, l2 & 15, l2 >> 4); }
        if constexpr (HasDone<P>::v) p.done(cur);
        if (!has_next) break;
#pragma unroll
        for (int a = 0; a < 2; ++a)
#pragma unroll
            for (int b = 0; b < 2; ++b)
#pragma unroll
                for (int m = 0; m < 4; ++m)
#pragma unroll
                    for (int n = 0; n < 2; ++n) acc[a][b][m][n] = (f32x4){0.f, 0.f, 0.f, 0.f};
        cur = nxt; ca = na; ++ui;
        if (wr == 1) PG_BAR;
    }
    PG_WAIT_V(0);
    PG_BAR;
#undef PG_SA
#undef PG_SB
#undef PG_GLDS
#undef PG_STAGE_A
#undef PG_STAGE_B
#undef PG_LDA
#undef PG_LDB
#undef PG_MMA
#undef aoff
#undef boff
#undef voffB
#undef PG_CAT8
#undef PG_WAIT_V
#undef PG_WAIT_L
#undef PG_BAR
#undef PG_SCHED
}
}

using pg::Unit; using pg::Acc;

struct AdrReg { unsigned a, b; };
#define REGULAR_ADDR(LDA_, LDB_) REGULAR_ADDR3(LDA_, LDB_, 0)
#define REGULAR_ADDR3(LDA_, LDB_, ABX_) \
    typedef AdrReg Adr; static constexpr int LDA = LDA_, LDB = LDB_, AIOFF = 64 * LDA_; \
    DI void addr(const Unit& u, Adr& r) const { r.a = aoff0 + (unsigned)u.pm * (256u * LDA_) + (unsigned)(u.pm >> 4) * (unsigned)(ABX_); r.b = boff0 + (unsigned)u.pn * (256u * LDB_); } \
    DI unsigned abase(const Adr& r, int h, int t) const { return r.a + (unsigned)(h * 128 * LDA_) + (unsigned)t * 128u; } \
    DI unsigned apre(const Adr&, int) const { return 0u; } \
    DI unsigned avoff(const Adr&, int, int, unsigned v, unsigned) const { return v; } \
    DI unsigned bbase(const Adr& r, int h, int t) const { return r.b + (unsigned)(h * 128 * LDB_) + (unsigned)t * 128u; }

struct PInA {
    static constexpr int NT = 8, TMID = -1; static constexpr bool PERM = true, HAS_MID = false, FP8 = true;
    const char* wsb; unsigned aoff0, boff0; int l; pg::StaticOrder<M / 256, NZA / 256> so;
    DI bool next(int i, Unit& u) const { return so.next(i, u); }
    REGULAR_ADDR(1024, 1024)
    DI void epi(const Acc& acc, const Unit& u, int wr, int wc, int fr, int fq) const {
        bf16_t* Z = (bf16_t*)(wsb + WS_Z); const float* lbt = (const float*)(wsb + WS_LBT) + l * 512;
        asm volatile("" : "+v"(fr), "+v"(fq));
        const int seg = u.pn >> 1;
        const int row0 = u.pm * 256 + wr * 64 + fr, colw = wc * 32 + 8 * fq;
        f32x4 lbv[2][2];
        if (seg == 1) {
#pragma unroll
            for (int bj = 0; bj < 2; ++bj) { const int c = u.pn * 256 - 512 + bj * 128 + colw; lbv[bj][0] = *(const f32x4*)(lbt + c); lbv[bj][1] = *(const f32x4*)(lbt + c + 4); }
        }
        float invf[4] = {0.f, 0.f, 0.f, 0.f};
        if (seg == 3 || seg == 4) {
#pragma unroll
            for (int i = 0; i < 4; ++i) invf[i] = exp2f(-(float)((colw >> 1) + i) * (13.287712379549449f / 64.f));
        }
#pragma unroll
        for (int ai = 0; ai < 2; ++ai)
#pragma unroll
            for (int m = 0; m < 4; ++m) {
                const int row = row0 + ai * 128 + m * 16;
#if SCAN_V0
                bf16_t* rowp = Z + (size_t)row * NZA + u.pn * 256 + colw; const size_t bjstep = 128;
#else
                const size_t tok = (size_t)(row & (SEQ - 1)), bh0 = (size_t)(row >> 12) * 4;
                bf16_t* rowp; size_t bjstep;
                if (seg < 3)      { rowp = Z + (HZ_OFF >> 1) + ((bh0 + 2 * (u.pn & 1)) * SEQ + tok) * 384 + seg * 128 + colw; bjstep = (size_t)SEQ * 384; }
                else if (seg < 5) { rowp = Z + ((bh0 + 2 * (u.pn & 1)) * SEQ + tok) * 512 + (seg - 3) * 128 + colw; bjstep = (size_t)SEQ * 512; }
                else              { rowp = Z + ((bh0 + (u.pn - 10)) * SEQ + tok) * 512 + 256 + colw; bjstep = 128; }
#endif
                f32x4 cs0 = {1.f, 0.f, 1.f, 0.f}, cs1 = {1.f, 0.f, 1.f, 0.f};
                if (seg == 3 || seg == 4) { const float pos = (float)(row & (SEQ - 1)); float cc[4], ss[4];
#pragma unroll
                    for (int i = 0; i < 4; ++i) { const float ang = pos * invf[i];
                        const float pr = ang * 0.15915494f, er = fmaf(ang, 0.15915494f, -pr); const float rv = (pr - floorf(pr)) + (er + ang * 6.4206383e-9f);
                        cc[i] = __builtin_amdgcn_cosf(rv); ss[i] = __builtin_amdgcn_sinf(rv); }
                    cs0 = (f32x4){cc[0], ss[0], cc[1], ss[1]}; cs1 = (f32x4){cc[2], ss[2], cc[3], ss[3]}; }
#pragma unroll
                for (int bj = 0; bj < 2; ++bj) {
                    f32x4 v0 = acc[ai][bj][m][0] * (1.f / (S8_ACT * S8_W)), v1 = acc[ai][bj][m][1] * (1.f / (S8_ACT * S8_W));
                    u32x4 w;
                    if (seg == 1) {
#pragma unroll
                        for (int j = 0; j < 4; ++j) { const float l0 = lbv[bj][0][j], l1 = lbv[bj][1][j];
                            v0[j] = __log2f(l0 + (1.f - l0) * sigm(v0[j])); v1[j] = __log2f(l1 + (1.f - l1) * sigm(v1[j])); }
                        w.x = pk_f16(v0[0], v0[1]); w.y = pk_f16(v0[2], v0[3]); w.z = pk_f16(v1[0], v1[1]); w.w = pk_f16(v1[2], v1[3]);
                    } else {
                        if (seg == 0) {
#pragma unroll
                            for (int j = 0; j < 4; ++j) { v0[j] = silu(v0[j]); v1[j] = silu(v1[j]); }
                        } else if (seg == 3 || seg == 4) {
                            const float sc = (seg == 3) ? 0.08838834764831845f : 1.f;
                            f32x4 o0, o1;
                            o0[0] = (v0[0] * cs0[0] - v0[1] * cs0[1]) * sc; o0[1] = (v0[0] * cs0[1] + v0[1] * cs0[0]) * sc;
                            o0[2] = (v0[2] * cs0[2] - v0[3] * cs0[3]) * sc; o0[3] = (v0[2] * cs0[3] + v0[3] * cs0[2]) * sc;
                            o1[0] = (v1[0] * cs1[0] - v1[1] * cs1[1]) * sc; o1[1] = (v1[0] * cs1[1] + v1[1] * cs1[0]) * sc;
                            o1[2] = (v1[2] * cs1[2] - v1[3] * cs1[3]) * sc; o1[3] = (v1[2] * cs1[3] + v1[3] * cs1[2]) * sc;
                            v0 = o0; v1 = o1;
                        }
                        w.x = cvt_pk_bf16(v0[0], v0[1]); w.y = cvt_pk_bf16(v0[2], v0[3]); w.z = cvt_pk_bf16(v1[0], v1[1]); w.w = cvt_pk_bf16(v1[2], v1[3]);
                    }
                    *(u32x4*)(rowp + bj * bjstep) = w;
                }
            }
    }
};

struct PInA_bare {
    static constexpr int NT = 8, TMID = -1; static constexpr bool PERM = true, HAS_MID = false, FP8 = true;
    const char* wsb; unsigned aoff0, boff0; int l; pg::StaticOrder<M / 256, NZA / 256> so;
    DI bool next(int i, Unit& u) const { return so.next(i, u); }
    REGULAR_ADDR(1024, 1024)
    DI void epi(const Acc& acc, const Unit& u, int wr, int wc, int fr, int fq) const {
        bf16_t* Z = (bf16_t*)(wsb + WS_Z); const int row0 = u.pm * 256 + wr * 64 + fr, colw = wc * 32 + 8 * fq;
#pragma unroll
        for (int ai = 0; ai < 2; ++ai)
#pragma unroll
            for (int m = 0; m < 4; ++m) { bf16_t* rowp = Z + (size_t)(row0 + ai * 128 + m * 16) * NZA + u.pn * 256 + colw;
#pragma unroll
                for (int bj = 0; bj < 2; ++bj) { const f32x4 v0 = acc[ai][bj][m][0], v1 = acc[ai][bj][m][1]; u32x4 w;
                    w.x = cvt_pk_bf16(v0[0], v0[1]); w.y = cvt_pk_bf16(v0[2], v0[3]); w.z = cvt_pk_bf16(v1[0], v1[1]); w.w = cvt_pk_bf16(v1[2], v1[3]); *(u32x4*)(rowp + bj * 128) = w; } }
    }
};

struct PInC {
    static constexpr int NT = 8, TMID = -1; static constexpr bool PERM = true, HAS_MID = false, FP8 = true;
    const char* wsb; unsigned aoff0, boff0; pg::StaticOrder<M / 256, NZC / 256> so;
    DI bool next(int i, Unit& u) const { return so.next(i, u); }
    REGULAR_ADDR(1024, 1024)
    DI void epi(const Acc& acc, const Unit& u, int wr, int wc, int fr, int fq) const {
        bf16_t* AB = (bf16_t*)(wsb + WS_AB); bf16_t* ZG = (bf16_t*)(wsb + WS_Z);
        asm volatile("" : "+v"(fr), "+v"(fq));
        const int row0 = u.pm * 256 + wr * 64 + fr, col0 = u.pn * 256 + wc * 32 + 8 * fq;
        const bool gate = u.pn < 6;
        u32x4 ob[2][4][2];
        if (gate) {
#pragma unroll
            for (int ai = 0; ai < 2; ++ai)
#pragma unroll
                for (int m = 0; m < 4; ++m)
#pragma unroll
                    for (int bj = 0; bj < 2; ++bj) ob[ai][m][bj] = *(const u32x4*)(AB + (size_t)(row0 + ai * 128 + m * 16) * KAB + col0 + bj * 128);
        }
#pragma unroll
        for (int ai = 0; ai < 2; ++ai)
#pragma unroll
            for (int m = 0; m < 4; ++m) {
                const int row = row0 + ai * 128 + m * 16;
#pragma unroll
                for (int bj = 0; bj < 2; ++bj) {
                    f32x4 v0 = acc[ai][bj][m][0] * (1.f / (S8_ACT * S8_W)), v1 = acc[ai][bj][m][1] * (1.f / (S8_ACT * S8_W));
                    u32x4 w;
                    if (gate) {
                        bf16_t* pab = AB + (size_t)row * KAB + col0 + bj * 128;
                        const u32x4 o = ob[ai][m][bj];
#if FP8_DE
                        u32x2 w8; (void)pab;
                        w8.x = pk_fp8x4(bf_lo(o.x) * silu(v0[0]), bf_hi(o.x) * silu(v0[1]), bf_lo(o.y) * silu(v0[2]), bf_hi(o.y) * silu(v0[3]), S8_ACT);
                        w8.y = pk_fp8x4(bf_lo(o.z) * silu(v1[0]), bf_hi(o.z) * silu(v1[1]), bf_lo(o.w) * silu(v1[2]), bf_hi(o.w) * silu(v1[3]), S8_ACT);
                        *(u32x2*)((unsigned char*)ZG + AB8_OFF + (size_t)row * KAB + (size_t)(row >> 12) * AB8_BX + col0 + bj * 128) = w8;
#else
                        w.x = cvt_pk_bf16(bf_lo(o.x) * silu(v0[0]), bf_hi(o.x) * silu(v0[1])); w.y = cvt_pk_bf16(bf_lo(o.y) * silu(v0[2]), bf_hi(o.y) * silu(v0[3]));
                        w.z = cvt_pk_bf16(bf_lo(o.z) * silu(v1[0]), bf_hi(o.z) * silu(v1[1])); w.w = cvt_pk_bf16(bf_lo(o.w) * silu(v1[2]), bf_hi(o.w) * silu(v1[3]));
                        *(u32x4*)pab = w;
#endif
                    } else if (bj == 0) {
                        const f32x4 b0 = acc[ai][1][m][0] * (1.f / (S8_ACT * S8_W)), b1 = acc[ai][1][m][1] * (1.f / (S8_ACT * S8_W));
                        float sa[8], sb[8];
#pragma unroll
                        for (int e = 0; e < 4; ++e) { sa[e] = sigm(v0[e]); sa[4 + e] = sigm(v1[e]); sb[e] = sigm(b0[e]); sb[4 + e] = sigm(b1[e]); }
                        u32x4 wr_, ws_;
                        wr_.x = cvt_pk_bf16(sa[0] * __builtin_amdgcn_rcpf(sb[0]), sa[1] * __builtin_amdgcn_rcpf(sb[1])); wr_.y = cvt_pk_bf16(sa[2] * __builtin_amdgcn_rcpf(sb[2]), sa[3] * __builtin_amdgcn_rcpf(sb[3]));
                        wr_.z = cvt_pk_bf16(sa[4] * __builtin_amdgcn_rcpf(sb[4]), sa[5] * __builtin_amdgcn_rcpf(sb[5])); wr_.w = cvt_pk_bf16(sa[6] * __builtin_amdgcn_rcpf(sb[6]), sa[7] * __builtin_amdgcn_rcpf(sb[7]));
                        ws_.x = cvt_pk_bf16(sb[0], sb[1]); ws_.y = cvt_pk_bf16(sb[2], sb[3]); ws_.z = cvt_pk_bf16(sb[4], sb[5]); ws_.w = cvt_pk_bf16(sb[6], sb[7]);
                        bf16_t* zp = ZG + (size_t)row * 2048 + (u.pn - 6) * 128 + wc * 32 + 8 * fq;
                        *(u32x4*)zp = wr_; *(u32x4*)(zp + 1024) = ws_;
                    }
                }
            }
    }
};

struct PMerge {
    static constexpr int NT = FP8_DE ? 12 : 24, TMID = FP8_DE ? 4 : 8; static constexpr bool PERM = true, HAS_MID = true, FP8 = FP8_DE != 0;
    const char* wsb; unsigned aoff0, boff0; pg::StaticOrder<M / 256, D / 256> so;
    DI bool next(int i, Unit& u) const { return i < 4 ? so.next(3 - i, u) : false; }
    REGULAR_ADDR3((FP8_DE ? 1536 : 3072), (FP8_DE ? 1536 : 3072), (FP8_DE ? AB8_BX : 0))
    DI void mid(Acc& acc, const Unit& u, int wr, int wc, int fr, int fq) const {
        const bf16_t* ZG = (const bf16_t*)(wsb + WS_Z);
        asm volatile("" : "+v"(fr), "+v"(fq));
        const int row0 = u.pm * 256 + wr * 64 + fr, col0 = u.pn * 256 + wc * 32 + 8 * fq;
        u32x4 ga[2][4][2];
#pragma unroll
        for (int ai = 0; ai < 2; ++ai)
#pragma unroll
            for (int m = 0; m < 4; ++m) { const bf16_t* zp = ZG + (size_t)(row0 + ai * 128 + m * 16) * 2048 + col0;
#pragma unroll
                for (int bj = 0; bj < 2; ++bj) ga[ai][m][bj] = *(const u32x4*)(zp + bj * 128); }
#pragma unroll
        for (int ai = 0; ai < 2; ++ai)
#pragma unroll
            for (int m = 0; m < 4; ++m)
#pragma unroll
                for (int bj = 0; bj < 2; ++bj) { const u32x4 a = ga[ai][m][bj];
                    f32x4& v0 = acc[ai][bj][m][0]; f32x4& v1 = acc[ai][bj][m][1];
                    v0[0] *= bf_lo(a.x); v0[1] *= bf_hi(a.x); v0[2] *= bf_lo(a.y); v0[3] *= bf_hi(a.y);
                    v1[0] *= bf_lo(a.z); v1[1] *= bf_hi(a.z); v1[2] *= bf_lo(a.w); v1[3] *= bf_hi(a.w); }
        asm volatile("" ::: "memory");
    }
    DI void epi(const Acc& acc, const Unit& u, int wr, int wc, int fr, int fq) const {
        const bf16_t* ZG = (const bf16_t*)(wsb + WS_Z); bf16_t* Y = (bf16_t*)(wsb + WS_H);
        const int row0 = u.pm * 256 + wr * 64 + fr, col0 = u.pn * 256 + wc * 32 + 8 * fq;
        u32x4 gbb[2][4][2];
#pragma unroll
        for (int ai = 0; ai < 2; ++ai)
#pragma unroll
            for (int m = 0; m < 4; ++m)
#pragma unroll
                for (int bj = 0; bj < 2; ++bj) gbb[ai][m][bj] = *(const u32x4*)(ZG + (size_t)(row0 + ai * 128 + m * 16) * 2048 + 1024 + col0 + bj * 128);
#pragma unroll
        for (int ai = 0; ai < 2; ++ai)
#pragma unroll
            for (int m = 0; m < 4; ++m) {
                const int row = row0 + ai * 128 + m * 16;
#pragma unroll
                for (int bj = 0; bj < 2; ++bj) {
                    const u32x4 gb = gbb[ai][m][bj];
                    const f32x4 v0 = acc[ai][bj][m][0], v1 = acc[ai][bj][m][1];
                    u32x4 w;
#if FP8_DE
                    constexpr float qs = 1.f / S8_W;
                    u32x2 w8; (void)w;
                    w8.x = pk_fp8x4(v0[0] * bf_lo(gb.x), v0[1] * bf_hi(gb.x), v0[2] * bf_lo(gb.y), v0[3] * bf_hi(gb.y), qs);
                    w8.y = pk_fp8x4(v1[0] * bf_lo(gb.z), v1[1] * bf_hi(gb.z), v1[2] * bf_lo(gb.w), v1[3] * bf_hi(gb.w), qs);
                    *(u32x2*)((unsigned char*)Y + (size_t)row * D + col0 + bj * 128) = w8;
#else
                    w.x = cvt_pk_bf16(v0[0] * bf_lo(gb.x), v0[1] * bf_hi(gb.x)); w.y = cvt_pk_bf16(v0[2] * bf_lo(gb.y), v0[3] * bf_hi(gb.y));
                    w.z = cvt_pk_bf16(v1[0] * bf_lo(gb.z), v1[1] * bf_hi(gb.z)); w.w = cvt_pk_bf16(v1[2] * bf_lo(gb.w), v1[3] * bf_hi(gb.w));
                    *(u32x4*)(Y + (size_t)row * D + col0 + bj * 128) = w;
#endif
                }
            }
    }
};

struct PWout {
    static constexpr int NT = FP8_DE ? 8 : 16, TMID = -1; static constexpr bool PERM = true, HAS_MID = false, FP8 = FP8_DE != 0;
    const char* wsb; unsigned aoff0, boff0; const float* xin32; int l; pg::StaticOrder<M / 256, D / 256> so;
    DI bool next(int i, Unit& u) const { return so.next(i, u); }
    REGULAR_ADDR((FP8_DE ? 1024 : 2048), (FP8_DE ? 1024 : 2048))
    DI void epi(const Acc& acc, const Unit& u, int wr, int wc, int fr, int fq) const {
        bf16_t* X = (bf16_t*)(wsb + WS_X16);
        const int row0 = u.pm * 256 + wr * 64 + fr, col0 = u.pn * 256 + wc * 32 + 8 * fq;
        const float* gtb = (const float*)(wsb + WS_MOD) + (size_t)(l * 16 + (u.pm >> 4)) * 6144 + 2048 + col0;
        f32x4 g[2][2];
#pragma unroll
        for (int bj = 0; bj < 2; ++bj)
#pragma unroll
            for (int n = 0; n < 2; ++n) g[bj][n] = *(const f32x4*)(gtb + bj * 128 + n * 4) * (FP8_DE ? 1.f / (S8_ACT * S8_W) : 1.f);
#pragma unroll
        for (int bt = 0; bt < 8; bt += 2) {
            if (l == 0) {
#pragma unroll
                for (int h2 = 0; h2 < 2; ++h2) { const int rg = bt + h2, ai = rg >> 2, m = rg & 3; const size_t off = (size_t)(row0 + ai * 128 + m * 16) * D + col0;
                    f32x4 xa[2][2];
#pragma unroll
                    for (int bj = 0; bj < 2; ++bj) { xa[bj][0] = *(const f32x4*)(xin32 + off + bj * 128); xa[bj][1] = *(const f32x4*)(xin32 + off + bj * 128 + 4); }
#pragma unroll
                    for (int bj = 0; bj < 2; ++bj) { const f32x4 x0 = xa[bj][0] + g[bj][0] * acc[ai][bj][m][0], x1 = xa[bj][1] + g[bj][1] * acc[ai][bj][m][1];
                        u32x4 o; o.x = cvt_pk_bf16(x0[0], x0[1]); o.y = cvt_pk_bf16(x0[2], x0[3]); o.z = cvt_pk_bf16(x1[0], x1[1]); o.w = cvt_pk_bf16(x1[2], x1[3]);
                        *(u32x4*)(X + off + bj * 128) = o; }
                    asm volatile("" ::: "memory"); }
            } else {
                u32x4 xh[2][2];
#pragma unroll
                for (int mm = 0; mm < 2; ++mm) { const int rg = bt + mm, ai = rg >> 2, m = rg & 3; const size_t off = (size_t)(row0 + ai * 128 + m * 16) * D + col0;
#pragma unroll
                    for (int bj = 0; bj < 2; ++bj) xh[mm][bj] = *(const u32x4*)(X + off + bj * 128); }
#pragma unroll
                for (int mm = 0; mm < 2; ++mm) { const int rg = bt + mm, ai = rg >> 2, m = rg & 3; const size_t off = (size_t)(row0 + ai * 128 + m * 16) * D + col0;
#pragma unroll
                    for (int bj = 0; bj < 2; ++bj) { const u32x4 w = xh[mm][bj];
                        f32x4 x0 = (f32x4){bf_lo(w.x), bf_hi(w.x), bf_lo(w.y), bf_hi(w.y)}, x1 = (f32x4){bf_lo(w.z), bf_hi(w.z), bf_lo(w.w), bf_hi(w.w)};
                        x0 = x0 + g[bj][0] * acc[ai][bj][m][0]; x1 = x1 + g[bj][1] * acc[ai][bj][m][1];
                        u32x4 o; o.x = cvt_pk_bf16(x0[0], x0[1]); o.y = cvt_pk_bf16(x0[2], x0[3]); o.z = cvt_pk_bf16(x1[0], x1[1]); o.w = cvt_pk_bf16(x1[2], x1[3]);
                        *(u32x4*)(X + off + bj * 128) = o; } }
                asm volatile("" ::: "memory");
            }
        }
    }
};

struct MoeTab { const LAS int* lcnt; const LAS int* ltoff; };
DI bool moe_decode(const MoeTab& T, int tile, Unit& u) {
    int itot = NCLS; asm volatile("" : "+v"(itot));
    const int tot = __builtin_amdgcn_readfirstlane(T.ltoff[itot]); if (tile >= tot) return false;
    int ln; asm volatile("v_mbcnt_lo_u32_b32 %0, -1, 0\n\tv_mbcnt_hi_u32_b32 %0, -1, %0" : "=v"(ln));
    const int lo = T.ltoff[ln < NCLS ? ln : 0];
    const int c = __builtin_popcountll(__ballot(ln >= 1 && ln < NCLS && tile >= lo));
    u.cls = c; u.pm = __builtin_amdgcn_readfirstlane(tile - T.ltoff[c]); u.cnt = __builtin_amdgcn_readfirstlane(T.lcnt[c]); u.rowpos = tile * 256; return true;
}
DI void cls_experts(int cls, int& eA, int& eB) { const int g = cls / 6, p = cls % 6; const int lo = p < 3 ? 0 : (p < 5 ? 1 : 2), hi = p < 3 ? p + 1 : (p < 5 ? p - 1 : 3); eA = 4 * g + lo; eB = 4 * g + hi; }

struct PMoe1 {
    static constexpr int NT = 8, LDA = 1024, LDB = 1024, AIOFF = 0, TMID = -1; static constexpr bool PERM = true, HAS_MID = false, FP8 = true;
    struct Adr { unsigned tb; unsigned b; };
    static constexpr bool HAS_DONE = true, DMA_ADDR = true;
    const char* wsb; LAS unsigned char* lds; int l; MoeTab T; int G, c, W; unsigned* ctr; int Tl;
    DI bool next(int i, Unit& u) const { const int x = c & 7, j = c >> 3;
        u.seq = i;
        if (G != 256) { const int L0 = i * G + c; if (!moe_decode(T, L0 >> 3, u)) return false; u.pn = L0 & 7; return true; }
        const int U = i * 32 + j, tau = U >> 3; if (tau >= Tl) return false;
        if (!moe_decode(T, tau * 8 + x, u)) return false; u.pn = U & 7; return true; }
    DI void done(const Unit& u) const { asm volatile("s_waitcnt vmcnt(0)" ::: "memory");
        if ((ltid(W) & 63) == 0) (void)__hip_atomic_fetch_add(ctr + (u.seq < 8 ? 0 : 1), 1u, __ATOMIC_RELAXED, __HIP_MEMORY_SCOPE_AGENT); }
    DI void addr(const Unit& u, Adr& r) const {
        const int* list = (const int*)(wsb + WS_LIST); const int tid = ltid(W), wv_ = __builtin_amdgcn_readfirstlane(tid >> 6);
        int R, C; pg::stage_rc(tid * 16, R, C); (void)C;
        r.tb = (unsigned)(LDS_IDT + (u.seq & 1) * 8192);
        const int* lp = list + (size_t)u.cls * M + u.pm * 256 + R;
#pragma unroll
        for (int k = 0; k < 4; ++k) __builtin_amdgcn_global_load_lds((const unsigned*)(lp + 64 * k), (LAS unsigned*)(lds + r.tb + k * 2048 + wv_ * 256), 4, 0, 0);
        if (wv_ < 4) { const float* wp = (const float*)(wsb + WS_WL) + ((size_t)u.cls * M + u.pm * 256 + tid) * 2;
            LAS unsigned char* wt = lds + LDS_AUX + 9216 + (u.seq % 3) * 2048;
            __builtin_amdgcn_global_load_lds((const unsigned*)wp, (LAS unsigned*)(wt + wv_ * 256), 4, 0, 0);
            __builtin_amdgcn_global_load_lds((const unsigned*)(wp + 1), (LAS unsigned*)(wt + 1024 + wv_ * 256), 4, 0, 0); }
        int eA, eB; cls_experts(u.cls, eA, eB); const int e = (u.pn >> 2) ? eB : eA, q = u.pn & 3;
        r.b = (unsigned)WS_WG + (unsigned)((e * DE + 128 * q) * 1024);
    }
    DI unsigned abase(const Adr&, int, int t) const { return (unsigned)t * 128u; }
    DI unsigned apre(const Adr& r, int h) const { const LAS unsigned* tp = (const LAS unsigned*)(lds + r.tb + h * 4096 + ltid(W) * 4); return (tp[0] & 0xffffu) | (tp[512] << 16); }
    DI unsigned avoff(const Adr&, int, int i, unsigned v, unsigned pk) const { const unsigned tok = (pk >> (16 * i)) & 0xffffu; return (unsigned)WS_AB + tok * 1024u + (tok >> 12) * (unsigned)H2_BX + (v & 127u); }
    DI unsigned bbase(const Adr& r, int h, int t) const { return r.b + (unsigned)h * (unsigned)(WS_WU - WS_WG) + (unsigned)t * 128u; }
    DI void epi(const Acc& acc, const Unit& u, int wr, int wc, int fr, int fq) const {
        unsigned char* ACT = (unsigned char*)(wsb + WS_Z); const LAS float* wt = (const LAS float*)(lds + LDS_AUX + 9216 + (u.seq % 3) * 2048);
        const int k = u.pn >> 2, q = u.pn & 3;
        const int r0 = wr * 64 + fr, colw = k * 512 + 128 * q + wc * 32 + 8 * fq;
        float wv[2][4];
#pragma unroll
        for (int ai = 0; ai < 2; ++ai)
#pragma unroll
            for (int m = 0; m < 4; ++m) { const int rr_ = r0 + ai * 128 + m * 16; const float w_ = wt[k * 256 + rr_]; wv[ai][m] = (u.pm * 256 + rr_ < u.cnt) ? w_ : 0.f; }
#pragma unroll
        for (int ai = 0; ai < 2; ++ai)
#pragma unroll
            for (int m = 0; m < 4; ++m) {
                const int rit = r0 + ai * 128 + m * 16; const float w = wv[ai][m];
                constexpr float qs = 1.f / (S8_ACT * S8_W);
                const f32x4 g0 = acc[ai][0][m][0] * qs, g1 = acc[ai][0][m][1] * qs, u0 = acc[ai][1][m][0] * (qs * w), u1 = acc[ai][1][m][1] * (qs * w);
                u32x2 o;
                o.x = pk_fp8x4(silu(g0[0]) * u0[0], silu(g0[1]) * u0[1], silu(g0[2]) * u0[2], silu(g0[3]) * u0[3], S8_ACT2);
                o.y = pk_fp8x4(silu(g1[0]) * u1[0], silu(g1[1]) * u1[1], silu(g1[2]) * u1[2], silu(g1[3]) * u1[3], S8_ACT2);
                *(u32x2*)(ACT + (size_t)(u.rowpos + rit) * 1024 + colw) = o;
            }
    }
};
struct PMoe2 {
    static constexpr int NT = 8, LDA = 1024, LDB = 512, AIOFF = 64 * 1024, TMID = -1; static constexpr bool PERM = true, HAS_MID = false, FP8 = true;
    struct Adr { unsigned a, b; int b2off; };
    const char* wsb; int l; MoeTab T; int G, c; int hstart, nH, nL;
    DI bool next(int i, Unit& u) const { const int x = c & 7;
        if (G != 256) { const int L0 = i * G + c; if (!moe_decode(T, L0 >> 2, u)) return false; u.pn = L0 & 3; return true; }
        if (i >= nH) return false;
        const int e = hstart + i, V = e < nL ? 128 + e : e - nL;
        if (!moe_decode(T, (V >> 2) * 8 + x, u)) return false; u.pn = V & 3; return true; }
    DI void addr(const Unit& u, Adr& r) const {
        r.a = (unsigned)WS_Z + (unsigned)u.rowpos * 1024u;
        int eA, eB; cls_experts(u.cls, eA, eB);
        r.b = (unsigned)WS_WD + (unsigned)((eA * D + u.pn * 256) * 512); r.b2off = (eB - eA) * (D * 512) - 4 * 128;
    }
    DI unsigned abase(const Adr& r, int h, int t) const { return r.a + (unsigned)(h * 128 * 1024) + (unsigned)t * 128u; }
    DI unsigned apre(const Adr&, int) const { return 0u; }
    DI unsigned avoff(const Adr&, int, int, unsigned v, unsigned) const { return v; }
    DI unsigned bbase(const Adr& r, int h, int t) const { return r.b + (unsigned)(h * 128 * 512) + (unsigned)t * 128u + (t >= 4 ? (unsigned)r.b2off : 0u); }
    DI void epi(const Acc& acc, const Unit& u, int wr, int wc, int fr, int fq) const {
        const int* list = (const int*)(wsb + WS_LIST); const float* gt = (const float*)(wsb + WS_MOD) + (size_t)l * 16 * 6144 + 5120; bf16_t* X = (bf16_t*)(wsb + WS_X16);
        const int r0 = wr * 64 + fr, col0 = u.pn * 256 + wc * 32 + 8 * fq;
        int tk[2][4];
#pragma unroll
        for (int ai = 0; ai < 2; ++ai)
#pragma unroll
            for (int m = 0; m < 4; ++m) { const int slot = u.pm * 256 + r0 + ai * 128 + m * 16; tk[ai][m] = slot < u.cnt ? list[(size_t)u.cls * M + slot] : -1; }
#pragma unroll
        for (int am = 0; am < 4; ++am) {
            const int ai = am >> 1;
            u32x4 xw[2][2]; f32x4 gw[2][2][2];
#pragma unroll
            for (int mm = 0; mm < 2; ++mm) { const int tok = tk[ai][2 * (am & 1) + mm]; const int tks = tok < 0 ? 0 : tok;
                const bf16_t* xp = X + (size_t)tks * D + col0; const float* gp = gt + (size_t)(tks >> 12) * 6144 + col0;
#pragma unroll
                for (int bj = 0; bj < 2; ++bj) { xw[mm][bj] = *(const u32x4*)(xp + bj * 128); gw[mm][bj][0] = *(const f32x4*)(gp + bj * 128); gw[mm][bj][1] = *(const f32x4*)(gp + bj * 128 + 4); } }
#pragma unroll
            for (int mm = 0; mm < 2; ++mm) { const int m = 2 * (am & 1) + mm; const int tok = tk[ai][m];
                if (tok >= 0) { bf16_t* xp = X + (size_t)tok * D + col0;
#pragma unroll
                    for (int bj = 0; bj < 2; ++bj) { const u32x4 w = xw[mm][bj]; const f32x4 g0 = gw[mm][bj][0], g1 = gw[mm][bj][1];
                        const f32x4 a0 = acc[ai][bj][m][0] * (1.f / (S8_ACT2 * S8_W)), a1 = acc[ai][bj][m][1] * (1.f / (S8_ACT2 * S8_W)); u32x4 o;
                        o.x = cvt_pk_bf16(bf_lo(w.x) + g0[0] * a0[0], bf_hi(w.x) + g0[1] * a0[1]); o.y = cvt_pk_bf16(bf_lo(w.y) + g0[2] * a0[2], bf_hi(w.y) + g0[3] * a0[3]);
                        o.z = cvt_pk_bf16(bf_lo(w.z) + g1[0] * a1[0], bf_hi(w.z) + g1[1] * a1[1]); o.w = cvt_pk_bf16(bf_lo(w.w) + g1[2] * a1[2], bf_hi(w.w) + g1[3] * a1[3]);
                        *(u32x4*)(xp + bj * 128) = o; } } }
            asm volatile("" ::: "memory");
        }
    }
};

struct Params {
    const float *x, *c, *w_ada, *b_ada, *g_norm1, *g_norm2, *w_in, *lb_logits, *g_hgrn, *g_ret, *w_branch_a, *w_branch_b, *w_out, *w_router, *b_router, *w_exp_gate, *w_exp_up, *w_exp_down, *g_final;
    float* out; unsigned char* ws;
};

struct TDesc { const float* src; bf16_t* dst; int K, N, ldd, dcol0, map, f8; };
DI void t_item(const TDesc& d, int item, LAS float* scr, int lane) {
    const int nblk = d.N / 32, kb = item / nblk, nb = item % nblk, k0 = 64 * kb, n0 = 32 * nb;
    const int nsrc = d.map ? src_col_in(n0 + (lane & 31)) : n0 + (lane & 31);
#pragma unroll
    for (int hh = 0; hh < 2; ++hh) {
        float tv[16];
#pragma unroll
        for (int i = 0; i < 16; ++i) { const int kk = 2 * (16 * hh + i) + (lane >> 5); tv[i] = d.src[(size_t)(k0 + kk) * d.N + nsrc]; }
#pragma unroll
        for (int i = 0; i < 16; ++i) { const int kk = 2 * (16 * hh + i) + (lane >> 5); scr[kk * 33 + (lane & 31)] = tv[i]; }
        asm volatile("" ::: "memory"); }
    LDS_WAIT(); asm volatile("" ::: "memory");
    const int c = lane & 7;
#pragma unroll
    for (int j = 0; j < 4; ++j) { const int n = (lane >> 3) + 8 * j; const LAS float* s = scr + (8 * c) * 33 + n;
        const int nslot = ((n >> 2) & 1) * 16 + (n >> 3) * 4 + (n & 3);
        if (d.f8) { u32x2 o; o.x = pk_fp8x4(s[0 * 33], s[1 * 33], s[2 * 33], s[3 * 33], S8_W); o.y = pk_fp8x4(s[4 * 33], s[5 * 33], s[6 * 33], s[7 * 33], S8_W);
            *(u32x2*)((unsigned char*)d.dst + (size_t)(n0 + nslot) * d.ldd + d.dcol0 + k0 + 8 * c) = o; }
        else { u32x4 o; o.x = cvt_pk_bf16(s[0 * 33], s[1 * 33]); o.y = cvt_pk_bf16(s[2 * 33], s[3 * 33]); o.z = cvt_pk_bf16(s[4 * 33], s[5 * 33]); o.w = cvt_pk_bf16(s[6 * 33], s[7 * 33]);
            *(u32x4*)(d.dst + (size_t)(n0 + nslot) * d.ldd + d.dcol0 + k0 + 8 * c) = o; } }
    LDS_WAIT(); asm volatile("" ::: "memory");
}
constexpr int IT_WIN = 16 * 224, IT_WA = 8 * 32, IT_WB = 16 * 32, IT_WO = 16 * 32, IT_E = 256, IT_NE = IT_WIN + IT_WA + IT_WB + IT_WO, IT_LAYER = IT_NE + NE * 3 * IT_E, IT_ALL = DEPTH * IT_LAYER;
DI void t_dispatch(const Params& p, int it, LAS float* scr, int lane) {
    const int l = it / IT_LAYER; int r = it % IT_LAYER; unsigned char* ws = p.ws; TDesc d;
    if (r < IT_WIN) { d = TDesc{p.w_in + (size_t)l * D * NIN, (bf16_t*)(ws + WS_WIN + (size_t)l * NIN * D), D, NIN, D, 0, 1, 1}; t_item(d, r, scr, lane); return; } r -= IT_WIN;
    if (r < IT_WA) { d = TDesc{p.w_branch_a + (size_t)l * 512 * D, (bf16_t*)(ws + WS_WAB + (size_t)l * D * KAB * (FP8_DE ? 1 : 2)), 512, D, KAB, 0, 0, FP8_DE}; t_item(d, r, scr, lane); return; } r -= IT_WA;
    if (r < IT_WB) { d = TDesc{p.w_branch_b + (size_t)l * D * D, (bf16_t*)(ws + WS_WAB + (size_t)l * D * KAB * (FP8_DE ? 1 : 2)), D, D, KAB, 512, 0, FP8_DE}; t_item(d, r, scr, lane); return; } r -= IT_WB;
    if (r < IT_WO) { d = TDesc{p.w_out + (size_t)l * D * D, (bf16_t*)(ws + WS_WOUT + (size_t)l * D * D * (FP8_DE ? 1 : 2)), D, D, D, 0, 0, FP8_DE}; t_item(d, r, scr, lane); return; } r -= IT_WO;
    const int e = r / (3 * IT_E), k = (r % (3 * IT_E)) / IT_E, ii = r % IT_E; const size_t le = (size_t)l * NE + e;
    if (k == 0) d = TDesc{p.w_exp_gate + le * D * DE, (bf16_t*)(ws + WS_WG + (size_t)e * DE * D), D, DE, D, 0, 0, 1};
    else if (k == 1) d = TDesc{p.w_exp_up + le * D * DE, (bf16_t*)(ws + WS_WU + (size_t)e * DE * D), D, DE, D, 0, 0, 1};
    else d = TDesc{p.w_exp_down + le * DE * D, (bf16_t*)(ws + WS_WD + (size_t)e * D * DE), DE, D, DE, 0, 0, 1};
    t_item(d, ii, scr, lane);
}
DI void mod_item(const Params& p, int item, LAS unsigned char* lds, int W) {
    const int tid = ltid(W), wave = __builtin_amdgcn_readfirstlane(tid >> 6), lane = tid & 63;
    LAS float* cact = (LAS float*)lds;
    LAS float* red = (LAS float*)(lds + 65536);
    for (int i = tid; i < NB * D; i += 512) { const int b = i >> 10, k = i & 1023; cact[k * 16 + b] = silu(p.c[i]); }
    __syncthreads();
    const int l = item / 96, col = (item % 96) * 64 + lane;
    const float* w = p.w_ada + (size_t)l * D * 6144 + col;
    float acc[16];
#pragma unroll
    for (int b = 0; b < 16; ++b) acc[b] = 0.f;
    for (int k = wave * 128; k < wave * 128 + 128; ++k) {
        const float wv = w[(size_t)k * 6144];
        const LAS f32x4* cp = (const LAS f32x4*)(cact + k * 16);
#pragma unroll
        for (int q = 0; q < 4; ++q) { const f32x4 cv = cp[q];
#pragma unroll
            for (int j = 0; j < 4; ++j) acc[4 * q + j] += cv[j] * wv; }
    }
#pragma unroll
    for (int b = 0; b < 16; ++b) red[(wave * 16 + b) * 64 + lane] = acc[b];
    __syncthreads();
    float* mod = (float*)(p.ws + WS_MOD);
    for (int i = tid; i < 1024; i += 512) { const int b = i >> 6, ln = i & 63; float s = 0.f;
#pragma unroll
        for (int wv = 0; wv < 8; ++wv) s += red[(wv * 16 + b) * 64 + ln];
        const int cc = (item % 96) * 64 + ln; mod[((size_t)l * 16 + b) * 6144 + cc] = s + p.b_ada[(size_t)l * 6144 + cc]; }
    __syncthreads();
}
DI void phase_prologue(const Params& p, LAS unsigned char* lds, int W) {
    const int tid = ltid(W), wave = __builtin_amdgcn_readfirstlane(tid >> 6), lane = tid & 63, G = lgrid();
    const int gt = lbid() * 512 + tid, ngt = G * 512;
    float* lbt = (float*)(p.ws + WS_LBT);
    if (gt < 512) { const float a = p.lb_logits[gt], b = p.lb_logits[512 + gt], mx = fmaxf(a, b), ea = __expf(a - mx), eb = __expf(b - mx); lbt[gt] = 0.f; lbt[512 + gt] = eb / (ea + eb); }
    for (int item = lbid(); item < 192; item += G) mod_item(p, item, lds, W);
    LAS float* scr = (LAS float*)(lds + wave * 16384);
    for (int it = lbid() * 8 + wave; it < IT_LAYER + IT_NE; it += G * 8) t_dispatch(p, it, scr, lane);
}

DI void load_xrow(const float* x32, const bf16_t* x16, size_t r, int lane, f32x4 (&v)[4]) {
    if (x32) {
#pragma unroll
        for (int j = 0; j < 4; ++j) v[j] = *(const f32x4*)(x32 + r * D + 4 * lane + 256 * j);
    } else {
#pragma unroll
        for (int j = 0; j < 4; ++j) { const u32x2 w = *(const u32x2*)(x16 + r * D + 4 * lane + 256 * j); v[j] = (f32x4){bf_lo(w.x), bf_hi(w.x), bf_lo(w.y), bf_hi(w.y)}; }
    }
}
DI void phase_norm1(const Params& p, const float* x32, int l, int W) {
    const int tid = ltid(W), wave = __builtin_amdgcn_readfirstlane(tid >> 6), lane = tid & 63, gw = lbid() * 8 + wave, ngw = lgrid() * 8;
    const float* mod = (const float*)(p.ws + WS_MOD) + (size_t)l * 16 * 6144; bf16_t* H = (bf16_t*)(p.ws + WS_H); const bf16_t* X = (const bf16_t*)(p.ws + WS_X16);
    for (int blk = lbid(); blk < M / 256; blk += lgrid()) {
        const int r0 = (32 * (blk & 7) + (blk >> 3)) * 256 + wave * 32; (void)gw; (void)ngw;
        const int b = r0 >> 12; const float* mb = mod + (size_t)b * 6144;
        f32x4 gs[4], sh[4];
#pragma unroll
        for (int j = 0; j < 4; ++j) { const int c = 4 * lane + 256 * j; const f32x4 g = *(const f32x4*)(p.g_norm1 + (size_t)l * D + c), sc = *(const f32x4*)(mb + 1024 + c); gs[j] = g * (sc + 1.f); sh[j] = *(const f32x4*)(mb + c); }
        for (int r = r0; r < r0 + 32; r += 2) {
            f32x4 v[2][4];
            load_xrow(x32, X, (size_t)r, lane, v[0]); load_xrow(x32, X, (size_t)r + 1, lane, v[1]);
#pragma unroll
            for (int q = 0; q < 2; ++q) { float ss = 0.f;
#pragma unroll
                for (int j = 0; j < 4; ++j) ss += (v[q][j].x * v[q][j].x + v[q][j].y * v[q][j].y) + (v[q][j].z * v[q][j].z + v[q][j].w * v[q][j].w);
                const float rs = rsqrtf(wave_sum(ss) * (1.f / D) + EPS);
#pragma unroll
                for (int j = 0; j < 4; ++j) { const f32x4 h = v[q][j] * rs * gs[j] + sh[j]; *(unsigned*)((unsigned char*)H + (size_t)(r + q) * D + 4 * lane + 256 * j) = pk_fp8x4(h.x, h.y, h.z, h.w, S8_ACT); } }
        }
    }
}
DI void phase_norm2(const Params& p, int l, LAS unsigned char* lds, int W) {
    const int tid = ltid(W), wave = __builtin_amdgcn_readfirstlane(tid >> 6), lane = tid & 63;
    const float* mod = (const float*)(p.ws + WS_MOD) + (size_t)l * 16 * 6144; bf16_t* H2 = (bf16_t*)(p.ws + WS_AB);
    LAS float* wrl = (LAS float*)lds;
    LAS int* whist = (LAS int*)(lds + 65536);
    unsigned* gcnt = (unsigned*)(p.ws + WS_CTL) + CW_CNT + l * 32; int* list = (int*)(p.ws + WS_LIST); f32x2* wl = (f32x2*)(p.ws + WS_WL);
#pragma unroll 4
    for (int i0 = 0; i0 < D * NE; i0 += 512) { const int i = i0 + tid; wrl[(i & 15) * 1024 + (i >> 4)] = p.w_router[i]; }
    for (int blk = lbid(); blk < M / 256; blk += lgrid()) {
        __syncthreads();
        const int r0 = (32 * (blk & 7) + (blk >> 3)) * 256 + wave * 32, b = r0 >> 12; const float* mb = mod + (size_t)b * 6144;
        f32x4 gs[4], sh[4];
#pragma unroll
        for (int j = 0; j < 4; ++j) { const int c = 4 * lane + 256 * j; const f32x4 g = *(const f32x4*)(p.g_norm2 + (size_t)l * D + c), sc = *(const f32x4*)(mb + 4096 + c); gs[j] = g * (sc + 1.f); sh[j] = *(const f32x4*)(mb + 3072 + c); }
        const bf16_t* X = (const bf16_t*)(p.ws + WS_X16);
        LAS float* lg = (LAS float*)(lds + 65536 + 4096) + wave * 512;
        f32x4 vn[2][4];
        load_xrow(nullptr, X, (size_t)r0, lane, vn[0]); load_xrow(nullptr, X, (size_t)r0 + 1, lane, vn[1]);
        for (int rr = 0; rr < 32; rr += 2) {
            const int r = r0 + rr; f32x4 v[2][4]; float ss[2] = {0.f, 0.f};
#pragma unroll
            for (int q = 0; q < 2; ++q)
#pragma unroll
                for (int j = 0; j < 4; ++j) { v[q][j] = vn[q][j]; ss[q] += (v[q][j].x * v[q][j].x + v[q][j].y * v[q][j].y) + (v[q][j].z * v[q][j].z + v[q][j].w * v[q][j].w); }
            if (rr + 2 < 32) { load_xrow(nullptr, X, (size_t)r + 2, lane, vn[0]); load_xrow(nullptr, X, (size_t)r + 3, lane, vn[1]); }
#pragma unroll
            for (int q = 0; q < 2; ++q) { const float rs = rsqrtf(wave_sum(ss[q]) * (1.f / D) + EPS);
#pragma unroll
                for (int j = 0; j < 4; ++j) { v[q][j] = v[q][j] * rs * gs[j] + sh[j]; *(unsigned*)((unsigned char*)H2 + (size_t)(r + q) * D + (size_t)((r + q) >> 12) * H2_BX + 4 * lane + 256 * j) = pk_fp8x4(v[q][j].x, v[q][j].y, v[q][j].z, v[q][j].w, S8_ACT); } }
            float p0[16], p1[16];
#pragma unroll
            for (int e = 0; e < 16; ++e) { float s0 = 0.f, s1 = 0.f;
#pragma unroll
                for (int j = 0; j < 4; ++j) { const f32x4 w = *(const LAS f32x4*)(wrl + e * 1024 + 4 * lane + 256 * j);
                    s0 += (v[0][j].x * w.x + v[0][j].y * w.y) + (v[0][j].z * w.z + v[0][j].w * w.w); s1 += (v[1][j].x * w.x + v[1][j].y * w.y) + (v[1][j].z * w.z + v[1][j].w * w.w); }
                p0[e] = s0; p1[e] = s1; }
            const float t0 = reduce16(p0, lane), t1 = reduce16(p1, lane);
            if ((lane & 3) == 0) { lg[rr * 16 + (lane >> 2)] = t0; lg[(rr + 1) * 16 + (lane >> 2)] = t1; }
        }
        float keep[16];
#pragma unroll
        for (int e = 0; e < 16; ++e) keep[e] = 0.f;
        if (lane < 32) {
#pragma unroll
            for (int e4 = 0; e4 < 4; ++e4) { const f32x4 k4 = *(const LAS f32x4*)(lg + lane * 16 + 4 * e4); keep[4 * e4] = k4.x; keep[4 * e4 + 1] = k4.y; keep[4 * e4 + 2] = k4.z; keep[4 * e4 + 3] = k4.w; } }
        int cls = -1; float wA = 0.f, wB = 0.f;
        if (lane < 32) {
            float sc[16], bi[16];
#pragma unroll
            for (int e = 0; e < 16; ++e) { sc[e] = 1.f / (1.f + expf(-keep[e])); bi[e] = sc[e] + p.b_router[e]; }
            float best = -1e30f; int gsel = 0, i1s = 0, i2s = 1; float w1s = 0.f, w2s = 0.f;
#pragma unroll
            for (int g = 0; g < 4; ++g) {
                int i1 = 0; float m1 = bi[4 * g];
#pragma unroll
                for (int j = 1; j < 4; ++j) if (bi[4 * g + j] > m1) { m1 = bi[4 * g + j]; i1 = j; }
                int i2 = -1; float m2 = -1e30f;
#pragma unroll
                for (int j = 0; j < 4; ++j) if (j != i1 && bi[4 * g + j] > m2) { m2 = bi[4 * g + j]; i2 = j; }
                float s1 = 0.f, s2 = 0.f;
#pragma unroll
                for (int j = 0; j < 4; ++j) { s1 = (j == i1) ? sc[4 * g + j] : s1; s2 = (j == i2) ? sc[4 * g + j] : s2; }
                const float gsum = m1 + m2;
                if (gsum > best) { best = gsum; gsel = g; i1s = i1; i2s = i2; w1s = s1; w2s = s2; }
            }
            const float inv = 1.f / (w1s + w2s); w1s *= inv; w2s *= inv;
            const int lo = i1s < i2s ? i1s : i2s, hi = i1s < i2s ? i2s : i1s;
            wA = i1s < i2s ? w1s : w2s; wB = i1s < i2s ? w2s : w1s;
            const int pidx = lo == 0 ? hi - 1 : (lo == 1 ? hi + 1 : 5);
            cls = 6 * gsel + pidx;
        }
        int locw = 0, mycnt = 0;
#pragma unroll 1
        for (int c = 0; c < NCLS; ++c) { const unsigned long long mk = __ballot(cls == c); const int n = __popcll(mk);
            if (cls == c) locw = __popcll(mk & ((1ull << lane) - 1ull)); if (lane == c) mycnt = n; }
        { int lq = lane; asm volatile("" : "+v"(lq)); if (lane < 32) whist[wave * 32 + lq] = mycnt; }
        __syncthreads();
        if (tid < 32) { int t = 0;
            for (int w = 0; w < 8; ++w) t += whist[w * 32 + tid];
            int tq = tid; asm volatile("" : "+v"(tq));
            whist[256 + tid] = (tid < NCLS && t > 0) ? (int)atomicAdd(&gcnt[tq], (unsigned)t) : 0; }
        __syncthreads();
        if (lane < 32) { int pre = whist[256 + cls];
            for (int w = 0; w < wave; ++w) pre += whist[w * 32 + cls];
            const int slot = pre + locw; list[(size_t)cls * M + slot] = r0 + lane; wl[(size_t)cls * M + slot] = (f32x2){wA, wB}; }
        __syncthreads();
    }
}
DI void phase_final(const Params& p, int W) {
    const int tid = ltid(W), wave = __builtin_amdgcn_readfirstlane(tid >> 6), lane = tid & 63, gw = lbid() * 8 + wave, ngw = lgrid() * 8;
    const bf16_t* X = (const bf16_t*)(p.ws + WS_X16);
    f32x4 g[4];
#pragma unroll
    for (int j = 0; j < 4; ++j) g[j] = *(const f32x4*)(p.g_final + 4 * lane + 256 * j);
    for (int r0 = gw * 2; r0 < M; r0 += ngw * 2) {
        f32x4 v[2][4];
        load_xrow(nullptr, X, (size_t)r0, lane, v[0]); load_xrow(nullptr, X, (size_t)r0 + 1, lane, v[1]);
#pragma unroll
        for (int q = 0; q < 2; ++q) { float ss = 0.f;
#pragma unroll
            for (int j = 0; j < 4; ++j) ss += (v[q][j].x * v[q][j].x + v[q][j].y * v[q][j].y) + (v[q][j].z * v[q][j].z + v[q][j].w * v[q][j].w);
            const float rs = rsqrtf(wave_sum(ss) * (1.f / D) + EPS);
#pragma unroll
            for (int j = 0; j < 4; ++j) *(f32x4*)(p.out + (size_t)(r0 + q) * D + 4 * lane + 256 * j) = v[q][j] * rs * g[j]; }
    }
}

DI void hgrn_v0_item(const Params& p, int item, int W) {
    const int tid = ltid(W), dg = tid & 15, vv = tid >> 4;
    const int bh = item >> 2, vs = item & 3, b = bh >> 2, h = bh & 3;
    const bf16_t* Z = (const bf16_t*)(p.ws + WS_Z) + (size_t)b * SEQ * NZA; bf16_t* AB = (bf16_t*)(p.ws + WS_AB) + (size_t)b * SEQ * KAB;
    const int dcol = h * 128 + dg * 8, vcol = h * 128 + vs * 32 + vv;
    float s[8];
#pragma unroll
    for (int i = 0; i < 8; ++i) s[i] = 0.f;
    u32x4 qn = *(const u32x4*)(Z + ZQ + dcol), gn = *(const u32x4*)(Z + ZG2 + dcol); bf16_t vn = Z[ZI + vcol];
    for (int t = 0; t < SEQ; ++t) {
        const u32x4 qc = qn, gc = gn; const float val = bf2f(vn);
        if (t + 1 < SEQ) { const bf16_t* zr = Z + (size_t)(t + 1) * NZA; qn = *(const u32x4*)(zr + ZQ + dcol); gn = *(const u32x4*)(zr + ZG2 + dcol); vn = zr[ZI + vcol]; }
        const unsigned qw[4] = {qc.x, qc.y, qc.z, qc.w}, gw[4] = {gc.x, gc.y, gc.z, gc.w};
        float o = 0.f;
#pragma unroll
        for (int i = 0; i < 4; ++i) {
            const float f0 = exp2f(h2f((unsigned short)(gw[i] & 0xffff))), f1 = exp2f(h2f((unsigned short)(gw[i] >> 16)));
            s[2 * i] = f0 * s[2 * i] + (1.f - f0) * val; s[2 * i + 1] = f1 * s[2 * i + 1] + (1.f - f1) * val;
            o += bf_lo(qw[i]) * s[2 * i] + bf_hi(qw[i]) * s[2 * i + 1];
        }
        o = sum16(o);
        if (dg == 0) AB[(size_t)t * KAB + vcol] = (bf16_t)(cvt_pk_bf16(o, 0.f) & 0xffff);
    }
}
DI void ret_v0_item(const Params& p, int item, LAS unsigned char* lds, int W) {
    const int tid = ltid(W);
    const int bh = item >> 3, vs = item & 7, b = bh >> 2, h = bh & 3;
    const bf16_t* Z = (const bf16_t*)(p.ws + WS_Z) + (size_t)b * SEQ * NZA; bf16_t* AB = (bf16_t*)(p.ws + WS_AB) + (size_t)b * SEQ * KAB;
    LAS float* qs = (LAS float*)lds;
    LAS float* ks = qs + 64 * 129;
    LAS float* vsm = ks + 64 * 129;
    LAS float* sc = vsm + 64 * 33;
    LAS float* S = sc + 64 * 65;
    const float lg = log2f(1.f - exp2f(-5.f - (float)h));
    for (int i = tid; i < 128 * 33; i += 512) S[i] = 0.f;
    __syncthreads();
    for (int n = 0; n < SEQ / 64; ++n) {
        const bf16_t* zc = Z + (size_t)n * 64 * NZA;
        for (int i = tid; i < 64 * 128; i += 512) { const int j = i >> 7, d = i & 127; qs[j * 129 + d] = bf2f(zc[(size_t)j * NZA + ZQR + h * 128 + d]); ks[j * 129 + d] = bf2f(zc[(size_t)j * NZA + ZKR + h * 128 + d]); }
        for (int i = tid; i < 64 * 32; i += 512) { const int j = i >> 5, v = i & 31; vsm[j * 33 + v] = bf2f(zc[(size_t)j * NZA + ZV + h * 256 + vs * 32 + v]); }
        __syncthreads();
        for (int i = tid; i < 64 * 64; i += 512) { const int j = i >> 6, l2 = i & 63; float a = 0.f;
            for (int d = 0; d < 128; ++d) a += qs[j * 129 + d] * ks[l2 * 129 + d];
            const int dd = j > l2 ? j - l2 : l2 - j; sc[j * 65 + l2] = a * exp2f(lg * (float)dd); }
        __syncthreads();
        for (int i = tid; i < 64 * 32; i += 512) { const int j = i >> 5, v = i & 31; float a = 0.f, c2 = 0.f;
            for (int l2 = 0; l2 < 64; ++l2) a += sc[j * 65 + l2] * vsm[l2 * 33 + v];
            for (int d = 0; d < 128; ++d) c2 += qs[j * 129 + d] * S[d * 33 + v];
            a += c2 * exp2f(lg * (float)(j + 1));
            AB[(size_t)(n * 64 + j) * KAB + 512 + h * 256 + vs * 32 + v] = (bf16_t)(cvt_pk_bf16(a, 0.f) & 0xffff); }
        __syncthreads();
        for (int i = tid; i < 128 * 32; i += 512) { const int d = i >> 5, v = i & 31; float a = S[d * 33 + v] * exp2f(lg * 64.f);
            for (int l2 = 0; l2 < 64; ++l2) a += ks[l2 * 129 + d] * exp2f(lg * (float)(63 - l2)) * vsm[l2 * 33 + v];
            S[d * 33 + v] = a; }
        __syncthreads();
    }
}
DI void phase_scan_v0(const Params& p, LAS unsigned char* lds, int W) {
    for (int it = lbid(); it < 256 + 512; it += lgrid()) {
        if (it < 256) hgrn_v0_item(p, it, W); else ret_v0_item(p, it - 256, lds, W);
        __syncthreads();
    }
}
DI void phase_headnorm(const Params& p, int l, int W) {
    const int tid = ltid(W), wave = __builtin_amdgcn_readfirstlane(tid >> 6), lane = tid & 63, gw = lbid() * 8 + wave, ngw = lgrid() * 8;
    bf16_t* AB = (bf16_t*)(p.ws + WS_AB);
    float ga[8], gb[16];
#pragma unroll
    for (int i = 0; i < 8; ++i) ga[i] = p.g_hgrn[(size_t)l * 512 + 8 * lane + i];
#pragma unroll
    for (int i = 0; i < 16; ++i) gb[i] = p.g_ret[(size_t)l * 1024 + 16 * lane + i];
    for (int r = gw; r < M; r += ngw) {
        bf16_t* row = AB + (size_t)r * KAB;
        { const u32x4 w = *(const u32x4*)(row + 8 * lane); float v[8] = {bf_lo(w.x), bf_hi(w.x), bf_lo(w.y), bf_hi(w.y), bf_lo(w.z), bf_hi(w.z), bf_lo(w.w), bf_hi(w.w)};
          float ss = 0.f;
#pragma unroll
          for (int i = 0; i < 8; ++i) ss += v[i] * v[i];
          ss = sum16(ss);
          const float rs = rsqrtf(ss * (1.f / 128.f) + EPS);
          u32x4 o; o.x = cvt_pk_bf16(v[0] * rs * ga[0], v[1] * rs * ga[1]); o.y = cvt_pk_bf16(v[2] * rs * ga[2], v[3] * rs * ga[3]); o.z = cvt_pk_bf16(v[4] * rs * ga[4], v[5] * rs * ga[5]); o.w = cvt_pk_bf16(v[6] * rs * ga[6], v[7] * rs * ga[7]);
          *(u32x4*)(row + 8 * lane) = o; }
        { const u32x4 w0 = *(const u32x4*)(row + 512 + 16 * lane), w1 = *(const u32x4*)(row + 512 + 16 * lane + 8);
          float v[16] = {bf_lo(w0.x), bf_hi(w0.x), bf_lo(w0.y), bf_hi(w0.y), bf_lo(w0.z), bf_hi(w0.z), bf_lo(w0.w), bf_hi(w0.w), bf_lo(w1.x), bf_hi(w1.x), bf_lo(w1.y), bf_hi(w1.y), bf_lo(w1.z), bf_hi(w1.z), bf_lo(w1.w), bf_hi(w1.w)};
          float sm = 0.f;
#pragma unroll
          for (int i = 0; i < 16; ++i) sm += v[i];
          sm = sum16(sm);
          const float mu = sm * (1.f / 256.f); float ss = 0.f;
#pragma unroll
          for (int i = 0; i < 16; ++i) { v[i] -= mu; ss += v[i] * v[i]; }
          ss = sum16(ss);
          const float rs = rsqrtf(ss * (1.f / 256.f) + EPS);
          u32x4 o0, o1;
          o0.x = cvt_pk_bf16(v[0] * rs * gb[0], v[1] * rs * gb[1]); o0.y = cvt_pk_bf16(v[2] * rs * gb[2], v[3] * rs * gb[3]); o0.z = cvt_pk_bf16(v[4] * rs * gb[4], v[5] * rs * gb[5]); o0.w = cvt_pk_bf16(v[6] * rs * gb[6], v[7] * rs * gb[7]);
          o1.x = cvt_pk_bf16(v[8] * rs * gb[8], v[9] * rs * gb[9]); o1.y = cvt_pk_bf16(v[10] * rs * gb[10], v[11] * rs * gb[11]); o1.z = cvt_pk_bf16(v[12] * rs * gb[12], v[13] * rs * gb[13]); o1.w = cvt_pk_bf16(v[14] * rs * gb[14], v[15] * rs * gb[15]);
          *(u32x4*)(row + 512 + 16 * lane) = o0; *(u32x4*)(row + 512 + 16 * lane + 8) = o1; }
    }
}

typedef short s16x4 __attribute__((ext_vector_type(4)));
typedef float f32x16 __attribute__((ext_vector_type(16)));
DI unsigned xrow(unsigned row) { return ((row & 3) << 2) | ((row >> 2) & 3); }
DI unsigned off_b(unsigned row, unsigned ch) { return 256u * row + 16u * (ch ^ xrow(row)); }
DI unsigned off_p(unsigned row, unsigned ch) { return 128u * row + 16u * (ch ^ ((row >> 1) & 7)); }
DI unsigned row_addr16(unsigned lane, unsigned rb, unsigned s) { return off_b(16 * rb + (lane & 15), 4 * s + (lane >> 4)); }
DI unsigned tr_addr32(unsigned lane, unsigned c, unsigned ks, unsigned t) {
    const unsigned h = lane >> 5, blk = (lane >> 4) & 1, q = (lane & 15) >> 2, pp = lane & 3;
    return off_b(16 * ks + 8 * h + 4 * t + q, 4 * c + 2 * blk + (pp >> 1)) + 8 * (pp & 1);
}
struct LaneAddr { unsigned trt[2], trq, r16[4], qb, qx2, qx0, pp[4]; };
DI void lane_addr(int lane, LaneAddr& A) {
    const unsigned h = lane >> 5, blk = (lane >> 4) & 1, q = (lane & 15) >> 2, p4 = lane & 3, u = 2 * blk + (p4 >> 1);
#pragma unroll
    for (unsigned t = 0; t < 2; ++t) A.trt[t] = 2048 * h + 1024 * t + 256 * q + 16 * (u ^ ((2 * h + t) & 3)) + 8 * (p4 & 1);
    A.trq = q;
    const unsigned l15 = lane & 15, q4 = lane >> 4, x15 = xrow(l15);
#pragma unroll
    for (unsigned s2 = 0; s2 < 4; ++s2) A.r16[s2] = 256 * l15 + 64 * (s2 ^ (x15 >> 2)) + 16 * (q4 ^ (x15 & 3));
    const unsigned r = lane & 31, xr = xrow(r);
    A.qb = 256 * r + 8 * h; A.qx2 = xr >> 2; A.qx0 = xr & 3;
    const unsigned xp = (r >> 1) & 7;
#pragma unroll
    for (unsigned ks = 0; ks < 4; ++ks) A.pp[ks] = 128 * r + 16 * ((2 * ks + h) ^ xp);
}
#define TRA(A, c, ks, t) ((A).trt[t] + 64u * ((unsigned)(c) ^ (A).trq) + 4096u * (ks))
#define QBA(A, jb, db, k) ((A).qb + 64u * ((unsigned)(db) ^ (A).qx2) + 16u * ((unsigned)(k) ^ (A).qx0) + 8192u * (jb))
DI bf16x8 tr_frag(const LAS unsigned char* img, unsigned a0, unsigned a1) {
    const s16x4 lo = __builtin_amdgcn_ds_read_tr16_b64_v4i16((LAS s16x4*)(img + a0));
    const s16x4 hi = __builtin_amdgcn_ds_read_tr16_b64_v4i16((LAS s16x4*)(img + a1));
    return __builtin_shufflevector(lo, hi, 0, 1, 2, 3, 4, 5, 6, 7);
}
DI bf16x8 pack8(const f32x16& x, int s) {
    u32x4 w; w.x = cvt_pk_bf16(x[8 * s + 0], x[8 * s + 1]); w.y = cvt_pk_bf16(x[8 * s + 2], x[8 * s + 3]); w.z = cvt_pk_bf16(x[8 * s + 4], x[8 * s + 5]); w.w = cvt_pk_bf16(x[8 * s + 6], x[8 * s + 7]);
    return __builtin_bit_cast(bf16x8, w);
}
DI bf16x8 cat8(u32x2 a, u32x2 b) { u32x4 w; w.x = a.x; w.y = a.y; w.z = b.x; w.w = b.y; return __builtin_bit_cast(bf16x8, w); }
#define MFMA32(a, b, c) __builtin_amdgcn_mfma_f32_32x32x16_bf16((a), (b), (c), 0, 0, 0)
#define MFMA16(a, b, c) __builtin_amdgcn_mfma_f32_16x16x32_bf16((a), (b), (c), 0, 0, 0)
#define GLDS16(src, dst) __builtin_amdgcn_global_load_lds((const unsigned*)(src), (LAS unsigned*)(dst), 16, 0, 0)
#define LBAR() asm volatile("s_waitcnt lgkmcnt(0)\n\ts_barrier" ::: "memory")
DI int crow(int reg, int h) { return (reg & 3) + 8 * (reg >> 2) + 4 * h; }
DI float ex2(float x) { return __builtin_amdgcn_exp2f(x); }

DI void ret_chain(const Params& p, int l, int chain, LAS unsigned char* lds, int n_lo, int n_hi, int n_full, int W) {
    const int tid = ltid(W), wave = __builtin_amdgcn_readfirstlane(tid >> 6), lane0 = tid & 63;
    const int b = chain >> 2, hd = chain & 3;
    const float lg = log2f(1.f - exp2f(-5.f - (float)hd));
    const char* wsb = (const char*)p.ws; const unsigned zoff = (unsigned)WS_Z + (unsigned)chain * (unsigned)(SEQ * 1024);
    bf16_t* ABb = (bf16_t*)(p.ws + WS_AB) + (size_t)b * SEQ * KAB + 512 + hd * 256;
    LAS unsigned char* Qimg = lds; LAS unsigned char* Kimg = lds + 16384; LAS unsigned char* Pimg = lds + 65536; LAS unsigned char* stg = lds + 73728;
    LAS float* gl = (LAS float*)(lds + 107520);
    if (tid < 256) gl[tid] = p.g_ret[(size_t)l * 1024 + hd * 256 + tid];
    unsigned goff[2]; float kf[2];
#pragma unroll
    for (int i = 0; i < 2; ++i) { const unsigned idx = tid + 512 * i, row = idx >> 4, ch = (idx & 15) ^ xrow(row); goff[i] = row * 1024 + ch * 16; kf[i] = ex2(lg * (float)(63 - (int)row)); }
    f32x16 S[4];
#pragma unroll
    for (int d = 0; d < 4; ++d)
#pragma unroll
        for (int e = 0; e < 16; ++e) S[d][e] = 0.f;
    u32x4 R[4][2];
#define RET_LOAD(n_) do { const unsigned zc_ = zoff + (unsigned)(n_) * (unsigned)(64 * 1024); \
        _Pragma("unroll") for (int i_ = 0; i_ < 2; ++i_) { \
            R[0][i_] = *(const u32x4*)(wsb + (size_t)(unsigned)(zc_ + goff[i_])); R[1][i_] = *(const u32x4*)(wsb + (size_t)(unsigned)(zc_ + 256 + goff[i_])); \
            R[2][i_] = *(const u32x4*)(wsb + (size_t)(unsigned)(zc_ + 512 + goff[i_])); R[3][i_] = *(const u32x4*)(wsb + (size_t)(unsigned)(zc_ + 768 + goff[i_])); } } while (0)
#define RET_WRITE() do { _Pragma("unroll") for (int i_ = 0; i_ < 2; ++i_) { const unsigned o_ = (tid + 512 * i_) * 16; const float f_ = kf[i_]; const u32x4 v_ = R[1][i_]; u32x4 k_; \
            k_.x = cvt_pk_bf16(bf_lo(v_.x) * f_, bf_hi(v_.x) * f_); k_.y = cvt_pk_bf16(bf_lo(v_.y) * f_, bf_hi(v_.y) * f_); k_.z = cvt_pk_bf16(bf_lo(v_.z) * f_, bf_hi(v_.z) * f_); k_.w = cvt_pk_bf16(bf_lo(v_.w) * f_, bf_hi(v_.w) * f_); \
            *(LAS u32x4*)(lds + o_) = R[0][i_]; *(LAS u32x4*)(lds + 16384 + o_) = k_; *(LAS u32x4*)(lds + 32768 + o_) = R[2][i_]; *(LAS u32x4*)(lds + 49152 + o_) = R[3][i_]; } } while (0)
#define RET_LN(n_) do { const int row_ = tid >> 3, seg_ = tid & 7; const LAS u32x4* sp_ = (const LAS u32x4*)(stg + row_ * 528 + seg_ * 64); \
          float v_[32]; float sm_ = 0.f; \
          _Pragma("unroll") for (int k = 0; k < 4; ++k) { const u32x4 w = sp_[k]; v_[8 * k] = bf_lo(w.x); v_[8 * k + 1] = bf_hi(w.x); v_[8 * k + 2] = bf_lo(w.y); v_[8 * k + 3] = bf_hi(w.y); v_[8 * k + 4] = bf_lo(w.z); v_[8 * k + 5] = bf_hi(w.z); v_[8 * k + 6] = bf_lo(w.w); v_[8 * k + 7] = bf_hi(w.w); } \
          _Pragma("unroll") for (int k = 0; k < 32; ++k) sm_ += v_[k]; \
          sm_ += swz_xor<1>(sm_); sm_ += swz_xor<2>(sm_); sm_ += swz_xor<4>(sm_); \
          const float mu_ = sm_ * (1.f / 256.f); float ss_ = 0.f; \
          _Pragma("unroll") for (int k = 0; k < 32; ++k) { v_[k] -= mu_; ss_ += v_[k] * v_[k]; } \
          ss_ += swz_xor<1>(ss_); ss_ += swz_xor<2>(ss_); ss_ += swz_xor<4>(ss_); \
          const float rs_ = rsqrtf(ss_ * (1.f / 256.f) + EPS); \
          bf16_t* op_ = ABb + (size_t)((n_) * 64 + row_) * KAB + seg_ * 32; const LAS float* gp_ = gl + seg_ * 32; \
          _Pragma("unroll") for (int k = 0; k < 4; ++k) { const f32x4 g0 = *(const LAS f32x4*)(gp_ + 8 * k), g1 = *(const LAS f32x4*)(gp_ + 8 * k + 4); u32x4 o; \
              o.x = cvt_pk_bf16(v_[8 * k] * rs_ * g0[0], v_[8 * k + 1] * rs_ * g0[1]); o.y = cvt_pk_bf16(v_[8 * k + 2] * rs_ * g0[2], v_[8 * k + 3] * rs_ * g0[3]); \
              o.z = cvt_pk_bf16(v_[8 * k + 4] * rs_ * g1[0], v_[8 * k + 5] * rs_ * g1[1]); o.w = cvt_pk_bf16(v_[8 * k + 6] * rs_ * g1[2], v_[8 * k + 7] * rs_ * g1[3]); \
              *(u32x4*)(op_ + 8 * k) = o; } } while (0)
    if (n_full > n_lo) {
        u32x4 KV[3][3][2];
#pragma unroll
        for (int b3 = 0; b3 < 3; ++b3) if (n_lo + b3 < n_full) { const unsigned zc = zoff + (unsigned)(n_lo + b3) * (unsigned)(64 * 1024);
#pragma unroll
            for (int i = 0; i < 2; ++i) { KV[b3][0][i] = *(const u32x4*)(wsb + (size_t)(unsigned)(zc + 256 + goff[i])); KV[b3][1][i] = *(const u32x4*)(wsb + (size_t)(unsigned)(zc + 512 + goff[i])); KV[b3][2][i] = *(const u32x4*)(wsb + (size_t)(unsigned)(zc + 768 + goff[i])); } }
        const float g64 = ex2(lg * 64.f);
#pragma unroll 1
        for (int n = n_lo; n < n_full; n += 3) {
#pragma unroll
            for (int b3 = 0; b3 < 3; ++b3) { const int nn = n + b3;
                if (nn < n_full) {
#pragma unroll
                    for (int i = 0; i < 2; ++i) { const unsigned o = (tid + 512 * i) * 16; const float f = kf[i]; const u32x4 v = KV[b3][0][i]; u32x4 k;
                        k.x = cvt_pk_bf16(bf_lo(v.x) * f, bf_hi(v.x) * f); k.y = cvt_pk_bf16(bf_lo(v.y) * f, bf_hi(v.y) * f); k.z = cvt_pk_bf16(bf_lo(v.z) * f, bf_hi(v.z) * f); k.w = cvt_pk_bf16(bf_lo(v.w) * f, bf_hi(v.w) * f);
                        *(LAS u32x4*)(lds + 16384 + o) = k; *(LAS u32x4*)(lds + 32768 + o) = KV[b3][1][i]; *(LAS u32x4*)(lds + 49152 + o) = KV[b3][2][i]; }
                    if (nn + 3 < n_full) { const unsigned zc = zoff + (unsigned)(nn + 3) * (unsigned)(64 * 1024);
#pragma unroll
                        for (int i = 0; i < 2; ++i) { KV[b3][0][i] = *(const u32x4*)(wsb + (size_t)(unsigned)(zc + 256 + goff[i])); KV[b3][1][i] = *(const u32x4*)(wsb + (size_t)(unsigned)(zc + 512 + goff[i])); KV[b3][2][i] = *(const u32x4*)(wsb + (size_t)(unsigned)(zc + 768 + goff[i])); } }
                    LBAR();
                    { int lane = lane0; asm volatile("" : "+v"(lane)); LaneAddr LA; lane_addr(lane, LA);
                      const LAS unsigned char* Vimg = lds + 32768 + (wave >> 2) * 16384; const int vc = wave & 3;
                      bf16x8 Vf[4], Ka[2][4];
#pragma unroll
                      for (int ks = 0; ks < 4; ++ks) Vf[ks] = tr_frag(Vimg, TRA(LA, vc, ks, 0), TRA(LA, vc, ks, 1));
#pragma unroll
                      for (int ks = 0; ks < 4; ++ks) Ka[0][ks] = tr_frag(Kimg, TRA(LA, 0, ks, 0), TRA(LA, 0, ks, 1));
#pragma unroll
                      for (int db = 0; db < 4; ++db) {
                          if (db < 3) {
#pragma unroll
                              for (int ks = 0; ks < 4; ++ks) Ka[(db + 1) & 1][ks] = tr_frag(Kimg, TRA(LA, db + 1, ks, 0), TRA(LA, db + 1, ks, 1)); }
                          __builtin_amdgcn_sched_barrier(0);
#pragma unroll
                          for (int e = 0; e < 16; ++e) S[db][e] *= g64;
#pragma unroll
                          for (int ks = 0; ks < 4; ++ks) S[db] = MFMA32(Ka[db & 1][ks], Vf[ks], S[db]);
                          __builtin_amdgcn_sched_barrier(0); } }
                    LBAR();
                } }
        }
        n_lo = n_full;
    }
    RET_LOAD(n_lo); RET_WRITE(); if (n_lo + 1 < n_hi) RET_LOAD(n_lo + 1);
    __syncthreads();
#pragma unroll 1
    for (int n = n_lo; n < n_hi; ++n) {
        int lane = lane0; asm volatile("" : "+v"(lane));
        const int r = lane & 31, h5 = lane >> 5;
        const bool full = n >= n_full;
        LaneAddr LA; lane_addr(lane, LA);
        if (n > n_lo && n - 1 >= n_full) RET_LN(n - 1);
        if (full) { const int lt = wave >> 1, q4 = lane >> 4;
#pragma unroll
          for (int jj = 0; jj < 2; ++jj) { const int jt = 2 * (wave & 1) + jj; f32x4 acc = {0.f, 0.f, 0.f, 0.f};
#pragma unroll
              for (int s2 = 0; s2 < 4; ++s2) { const bf16x8 a = *(const LAS bf16x8*)(Kimg + LA.r16[s2] + 4096 * lt); const bf16x8 bq = *(const LAS bf16x8*)(Qimg + LA.r16[s2] + 4096 * jt); acc = MFMA16(a, bq, acc); }
              const int j = 16 * jt + (lane & 15); float pv[4];
#pragma unroll
              for (int e = 0; e < 4; ++e) { const int lq = 16 * lt + 4 * q4 + e; const int ex = j >= lq ? j - 63 : 2 * lq - j - 63; pv[e] = acc[e] * ex2(lg * (float)ex); }
              u32x2 w; w.x = cvt_pk_bf16(pv[0], pv[1]); w.y = cvt_pk_bf16(pv[2], pv[3]);
              *(LAS u32x2*)(Pimg + off_p(j, 2 * lt + (q4 >> 1)) + 8 * (q4 & 1)) = w; } }
        LBAR();
        const LAS unsigned char* Vimg = lds + 32768 + (wave >> 2) * 16384; const int vc = wave & 3;
#define SB0 __builtin_amdgcn_sched_barrier(0)
        bf16x8 Vf[4];
#pragma unroll
        for (int ks = 0; ks < 4; ++ks) Vf[ks] = tr_frag(Vimg, TRA(LA, vc, ks, 0), TRA(LA, vc, ks, 1));
        f32x16 O[2];
#pragma unroll
        for (int jb = 0; jb < 2; ++jb)
#pragma unroll
            for (int e = 0; e < 16; ++e) O[jb][e] = 0.f;
        bf16x8 Ka[2][4];
        if (full) {
        u32x2 qa[2][2][2];
#define RET_QLOAD(buf, st) do { _Pragma("unroll") for (int jb_ = 0; jb_ < 2; ++jb_) { qa[buf][jb_][0] = *(const LAS u32x2*)(Qimg + QBA(LA, jb_, (st) >> 1, 2 * ((st) & 1))); qa[buf][jb_][1] = *(const LAS u32x2*)(Qimg + QBA(LA, jb_, (st) >> 1, 2 * ((st) & 1) + 1)); } } while (0)
        RET_QLOAD(0, 0);
#pragma unroll
        for (int st = 0; st < 8; ++st) {
            if (st < 7) { if (st & 1) RET_QLOAD(0, st + 1); else RET_QLOAD(1, st + 1); }
            SB0;
            const bf16x8 sb = pack8(S[st >> 1], st & 1);
#pragma unroll
            for (int jb = 0; jb < 2; ++jb) O[jb] = MFMA32(cat8(qa[st & 1][jb][0], qa[st & 1][jb][1]), sb, O[jb]);
            SB0;
        }
        bf16x8 Pf[2][4];
#pragma unroll
        for (int jb = 0; jb < 2; ++jb)
#pragma unroll
            for (int ks = 0; ks < 4; ++ks) Pf[jb][ks] = *(const LAS bf16x8*)(Pimg + LA.pp[ks] + 4096 * jb);
#pragma unroll
        for (int ks = 0; ks < 4; ++ks) Ka[0][ks] = tr_frag(Kimg, TRA(LA, 0, ks, 0), TRA(LA, 0, ks, 1));
        SB0;
#pragma unroll
        for (int jb = 0; jb < 2; ++jb)
#pragma unroll
            for (int e = 0; e < 16; ++e) O[jb][e] *= ex2(lg * (float)(32 * jb + crow(e, h5) + 1));
#pragma unroll
        for (int jb = 0; jb < 2; ++jb)
#pragma unroll
            for (int ks = 0; ks < 4; ++ks) O[jb] = MFMA32(Pf[jb][ks], Vf[ks], O[jb]);
        } else {
#pragma unroll
            for (int ks = 0; ks < 4; ++ks) Ka[0][ks] = tr_frag(Kimg, TRA(LA, 0, ks, 0), TRA(LA, 0, ks, 1));
        }
        { const float g64 = ex2(lg * 64.f);
#pragma unroll
          for (int db = 0; db < 4; ++db) {
              if (db < 3) {
#pragma unroll
                  for (int ks = 0; ks < 4; ++ks) Ka[(db + 1) & 1][ks] = tr_frag(Kimg, TRA(LA, db + 1, ks, 0), TRA(LA, db + 1, ks, 1)); }
              SB0;
#pragma unroll
              for (int e = 0; e < 16; ++e) S[db][e] *= g64;
#pragma unroll
              for (int ks = 0; ks < 4; ++ks) S[db] = MFMA32(Ka[db & 1][ks], Vf[ks], S[db]);
              SB0; } }
#undef RET_QLOAD
        LBAR();
        if (full)
#pragma unroll
        for (int jb = 0; jb < 2; ++jb)
#pragma unroll
            for (int e = 0; e < 16; ++e) *(LAS bf16_t*)(stg + (32 * jb + crow(e, h5)) * 528 + (32 * wave + r) * 2) = (bf16_t)(cvt_pk_bf16(O[jb][e], 0.f) & 0xffff);
        if (n + 1 < n_hi) { RET_WRITE(); if (n + 2 < n_hi) RET_LOAD(n + 2); }
        LBAR();
    }
    RET_LN(n_hi - 1);
    __syncthreads();
#undef RET_LOAD
#undef RET_WRITE
#undef RET_LN
}

DI void hgrn_chain(const Params& p, int l, int chain, LAS unsigned char* lds, int n_lo, int n_hi, int n_full, int W) {
    const int tid = ltid(W), wave = __builtin_amdgcn_readfirstlane(tid >> 6), lane0 = tid & 63;
    const int b = chain >> 2, hd = chain & 3;
    const char* wsb = (const char*)p.ws; const unsigned zoff = (unsigned)(WS_Z + HZ_OFF) + (unsigned)chain * (unsigned)(SEQ * 768);
    bf16_t* ABb = (bf16_t*)(p.ws + WS_AB) + (size_t)b * SEQ * KAB + hd * 128;
    LAS unsigned char* Vimg = lds; LAS unsigned char* Qimg = lds + 16384; LAS unsigned char* Kimg = lds + 32768; LAS unsigned char* Pimg = lds + 49152; LAS unsigned char* stg = Qimg;
    LAS float* tot = (LAS float*)(lds + 57344);
    LAS float* eref = (LAS float*)(lds + 61440); LAS float* e2t = (LAS float*)(lds + 61952); LAS float* gl = (LAS float*)(lds + 62464);
    if (tid < 128) gl[tid] = p.g_hgrn[(size_t)l * 512 + hd * 128 + tid];
    const int vb = wave & 3, jb = wave >> 2;
    unsigned gq, gv[2];
    gq = (unsigned)(8 * wave) * 768u + (unsigned)(4 * lane0);
#pragma unroll
    for (int i = 0; i < 2; ++i) { const unsigned idx = tid + 512 * i, row = idx >> 4, sl = idx & 15; gv[i] = row * 768u + 512u + (sl ^ xrow(row)) * 16; }
    f32x16 S[4];
#pragma unroll
    for (int d = 0; d < 4; ++d)
#pragma unroll
        for (int e = 0; e < 16; ++e) S[d][e] = 0.f;
    unsigned Qr[8], Gr[8]; u32x4 Vr[2];
#define HG_LOADQG(n_) do { const unsigned zc_ = zoff + (unsigned)(n_) * (unsigned)(64 * 768) + gq; \
        _Pragma("unroll") for (int i_ = 0; i_ < 8; ++i_) { Qr[i_] = *(const unsigned*)(wsb + (size_t)(unsigned)(zc_ + i_ * 768)); Gr[i_] = *(const unsigned*)(wsb + (size_t)(unsigned)(zc_ + i_ * 768 + 256)); } } while (0)
#define HG_LOADV(n_) do { const unsigned zc_ = zoff + (unsigned)(n_) * (unsigned)(64 * 768); \
        _Pragma("unroll") for (int i_ = 0; i_ < 2; ++i_) Vr[i_] = *(const u32x4*)(wsb + (size_t)(unsigned)(zc_ + gv[i_])); } while (0)
#define HG_WRITEV() do { _Pragma("unroll") for (int i_ = 0; i_ < 2; ++i_) *(LAS u32x4*)(Vimg + (tid + 512 * i_) * 16) = Vr[i_]; } while (0)
#define HG_LN(n_) do { const int row_ = tid >> 3, seg_ = tid & 7; const LAS u32x4* sp_ = (const LAS u32x4*)(stg + row_ * 272 + seg_ * 32); \
          float v_[16]; float ss_ = 0.f; \
          _Pragma("unroll") for (int k = 0; k < 2; ++k) { const u32x4 w = sp_[k]; v_[8 * k] = bf_lo(w.x); v_[8 * k + 1] = bf_hi(w.x); v_[8 * k + 2] = bf_lo(w.y); v_[8 * k + 3] = bf_hi(w.y); v_[8 * k + 4] = bf_lo(w.z); v_[8 * k + 5] = bf_hi(w.z); v_[8 * k + 6] = bf_lo(w.w); v_[8 * k + 7] = bf_hi(w.w); } \
          _Pragma("unroll") for (int k = 0; k < 16; ++k) ss_ += v_[k] * v_[k]; \
          ss_ += swz_xor<1>(ss_); ss_ += swz_xor<2>(ss_); ss_ += swz_xor<4>(ss_); \
          const float rs_ = rsqrtf(ss_ * (1.f / 128.f) + EPS); \
          bf16_t* op_ = ABb + (size_t)((n_) * 64 + row_) * KAB + seg_ * 16; const LAS float* gp_ = gl + seg_ * 16; \
          _Pragma("unroll") for (int k = 0; k < 2; ++k) { const f32x4 g0 = *(const LAS f32x4*)(gp_ + 8 * k), g1 = *(const LAS f32x4*)(gp_ + 8 * k + 4); u32x4 o; \
              o.x = cvt_pk_bf16(v_[8 * k] * rs_ * g0[0], v_[8 * k + 1] * rs_ * g0[1]); o.y = cvt_pk_bf16(v_[8 * k + 2] * rs_ * g0[2], v_[8 * k + 3] * rs_ * g0[3]); \
              o.z = cvt_pk_bf16(v_[8 * k + 4] * rs_ * g1[0], v_[8 * k + 5] * rs_ * g1[1]); o.w = cvt_pk_bf16(v_[8 * k + 6] * rs_ * g1[2], v_[8 * k + 7] * rs_ * g1[3]); \
              *(u32x4*)(op_ + 8 * k) = o; } } while (0)
    if (n_full > n_lo) {
        unsigned G3[2][8]; u32x4 V3[2][2];
#pragma unroll
        for (int b3 = 0; b3 < 2; ++b3) if (n_lo + b3 < n_full) { const unsigned zc = zoff + (unsigned)(n_lo + b3) * (unsigned)(64 * 768);
#pragma unroll
            for (int i = 0; i < 8; ++i) G3[b3][i] = *(const unsigned*)(wsb + (size_t)(unsigned)(zc + gq + i * 768 + 256));
#pragma unroll
            for (int i = 0; i < 2; ++i) V3[b3][i] = *(const u32x4*)(wsb + (size_t)(unsigned)(zc + gv[i])); }
#pragma unroll 1
        for (int n = n_lo; n < n_full; n += 2) {
#pragma unroll
            for (int b3 = 0; b3 < 2; ++b3) { const int nn = n + b3;
                if (nn < n_full) {
                    int lane = lane0; asm volatile("" : "+v"(lane)); const int h5 = lane >> 5, cp = lane;
                    LaneAddr LA; lane_addr(lane, LA);
                    float c0[8], c1[8];
                    { float a0 = 0.f, a1 = 0.f;
#pragma unroll
                      for (int i = 0; i < 8; ++i) { a0 += h2f((unsigned short)(G3[b3][i] & 0xffff)); a1 += h2f((unsigned short)(G3[b3][i] >> 16)); c0[i] = a0; c1[i] = a1; }
                      *(LAS f32x2*)(tot + wave * 128 + 2 * cp) = (f32x2){a0, a1}; }
#pragma unroll
                    for (int i = 0; i < 2; ++i) *(LAS u32x4*)(Vimg + (tid + 512 * i) * 16) = V3[b3][i];
                    LBAR();
                    { float o0 = 0.f, o1 = 0.f, rf0 = 0.f, rf1 = 0.f, t0 = 0.f, t1 = 0.f;
#pragma unroll
                      for (int t = 0; t < 8; ++t) { const f32x2 v = *(const LAS f32x2*)(tot + t * 128 + 2 * cp); if (t < wave) { o0 += v.x; o1 += v.y; } if (t < 4) { rf0 += v.x; rf1 += v.y; } t0 += v.x; t1 += v.y; }
                      if (wave == 0) { *(LAS f32x2*)(eref + 2 * cp) = (f32x2){ex2(rf0), ex2(rf1)}; *(LAS f32x2*)(e2t + 2 * cp) = (f32x2){ex2(t0 - rf0), ex2(t1 - rf1)}; }
#pragma unroll
                      for (int i = 0; i < 8; ++i) { const int tok = 8 * wave + i;
                          const float g0 = h2f((unsigned short)(G3[b3][i] & 0xffff)), g1 = h2f((unsigned short)(G3[b3][i] >> 16));
                          const float cu0 = o0 + c0[i], cu1 = o1 + c1[i];
                          const float k0 = (1.f - ex2(g0)) * ex2(fminf(rf0 - cu0, 120.f)), k1 = (1.f - ex2(g1)) * ex2(fminf(rf1 - cu1, 120.f));
                          *(LAS unsigned*)(Kimg + off_b(tok, cp >> 2) + (cp & 3) * 4) = cvt_pk_bf16(k0, k1); } }
                    if (nn + 2 < n_full) { const unsigned zc = zoff + (unsigned)(nn + 2) * (unsigned)(64 * 768);
#pragma unroll
                        for (int i = 0; i < 8; ++i) G3[b3][i] = *(const unsigned*)(wsb + (size_t)(unsigned)(zc + gq + i * 768 + 256));
#pragma unroll
                        for (int i = 0; i < 2; ++i) V3[b3][i] = *(const u32x4*)(wsb + (size_t)(unsigned)(zc + gv[i])); }
                    LBAR();
                    { bf16x8 Vf[4], Ka[2][4];
#pragma unroll
                      for (int ks = 0; ks < 4; ++ks) Vf[ks] = tr_frag(Vimg, TRA(LA, vb, ks, 0), TRA(LA, vb, ks, 1));
#pragma unroll
                      for (int ks = 0; ks < 4; ++ks) Ka[0][ks] = tr_frag(Kimg, TRA(LA, 0, ks, 0), TRA(LA, 0, ks, 1));
#pragma unroll
                      for (int db = 0; db < 4; ++db) {
                          f32x4 fe[4];
#pragma unroll
                          for (int g = 0; g < 4; ++g) fe[g] = *(const LAS f32x4*)(eref + 32 * db + 8 * g + 4 * h5);
                          if (db < 3) {
#pragma unroll
                              for (int ks = 0; ks < 4; ++ks) Ka[(db + 1) & 1][ks] = tr_frag(Kimg, TRA(LA, db + 1, ks, 0), TRA(LA, db + 1, ks, 1)); }
                          __builtin_amdgcn_sched_barrier(0);
#pragma unroll
                          for (int g = 0; g < 4; ++g)
#pragma unroll
                              for (int e = 0; e < 4; ++e) S[db][4 * g + e] *= fe[g][e];
#pragma unroll
                          for (int g = 0; g < 4; ++g) fe[g] = *(const LAS f32x4*)(e2t + 32 * db + 8 * g + 4 * h5);
#pragma unroll
                          for (int ks = 0; ks < 4; ++ks) S[db] = MFMA32(Ka[db & 1][ks], Vf[ks], S[db]);
#pragma unroll
                          for (int g = 0; g < 4; ++g)
#pragma unroll
                              for (int e = 0; e < 4; ++e) S[db][4 * g + e] *= fe[g][e];
                          __builtin_amdgcn_sched_barrier(0); } }
                    LBAR();
                } }
        }
        n_lo = n_full;
    }
    HG_LOADQG(n_lo); HG_LOADV(n_lo); HG_WRITEV(); if (n_lo + 1 < n_hi) HG_LOADV(n_lo + 1);
    __syncthreads();
#pragma unroll 1
    for (int n = n_lo; n < n_hi; ++n) {
        const bool full = n >= n_full;
        int lane = lane0; asm volatile("" : "+v"(lane));
        const int r = lane & 31, h5 = lane >> 5, cp = lane;
        LaneAddr LA; lane_addr(lane, LA);
        float c0[8], c1[8];
        { float a0 = 0.f, a1 = 0.f;
#pragma unroll
          for (int i = 0; i < 8; ++i) { a0 += h2f((unsigned short)(Gr[i] & 0xffff)); a1 += h2f((unsigned short)(Gr[i] >> 16)); c0[i] = a0; c1[i] = a1; }
          *(LAS f32x2*)(tot + wave * 128 + 2 * cp) = (f32x2){a0, a1}; }
        if (n > n_lo && n - 1 >= n_full) HG_LN(n - 1);
        LBAR();
        { float o0 = 0.f, o1 = 0.f, rf0 = 0.f, rf1 = 0.f, t0 = 0.f, t1 = 0.f;
#pragma unroll
          for (int t = 0; t < 8; ++t) { const f32x2 v = *(const LAS f32x2*)(tot + t * 128 + 2 * cp); if (t < wave) { o0 += v.x; o1 += v.y; } if (t < 4) { rf0 += v.x; rf1 += v.y; } t0 += v.x; t1 += v.y; }
          if (wave == 0) { *(LAS f32x2*)(eref + 2 * cp) = (f32x2){ex2(rf0), ex2(rf1)}; *(LAS f32x2*)(e2t + 2 * cp) = (f32x2){ex2(t0 - rf0), ex2(t1 - rf1)}; }
#pragma unroll
          for (int i = 0; i < 8; ++i) { const int tok = 8 * wave + i;
              const float g0 = h2f((unsigned short)(Gr[i] & 0xffff)), g1 = h2f((unsigned short)(Gr[i] >> 16));
              const float cu0 = o0 + c0[i], cu1 = o1 + c1[i];
              const float q0 = bf_lo(Qr[i]) * ex2(cu0 - rf0), q1 = bf_hi(Qr[i]) * ex2(cu1 - rf1);
              const float k0 = (1.f - ex2(g0)) * ex2(fminf(rf0 - cu0, 120.f)), k1 = (1.f - ex2(g1)) * ex2(fminf(rf1 - cu1, 120.f));
              const unsigned a = off_b(tok, cp >> 2) + (cp & 3) * 4;
              *(LAS unsigned*)(Qimg + a) = cvt_pk_bf16(q0, q1); *(LAS unsigned*)(Kimg + a) = cvt_pk_bf16(k0, k1); } }
        if (n + 1 < n_hi) HG_LOADQG(n + 1);
        LBAR();
        if (full) { const int lt = wave >> 1, q4 = lane >> 4;
#pragma unroll
          for (int jj = 0; jj < 2; ++jj) { const int jt = 2 * (wave & 1) + jj; f32x4 acc = {0.f, 0.f, 0.f, 0.f};
#pragma unroll
              for (int s2 = 0; s2 < 4; ++s2) { const bf16x8 a = *(const LAS bf16x8*)(Kimg + LA.r16[s2] + 4096 * lt); const bf16x8 bq = *(const LAS bf16x8*)(Qimg + LA.r16[s2] + 4096 * jt); acc = MFMA16(a, bq, acc); }
              const int j = 16 * jt + (lane & 15); float pv[4];
#pragma unroll
              for (int e = 0; e < 4; ++e) { const int lq = 16 * lt + 4 * q4 + e; pv[e] = (lq <= j) ? acc[e] : 0.f; }
              u32x2 w; w.x = cvt_pk_bf16(pv[0], pv[1]); w.y = cvt_pk_bf16(pv[2], pv[3]);
              *(LAS u32x2*)(Pimg + off_p(j, 2 * lt + (q4 >> 1)) + 8 * (q4 & 1)) = w; } }
        LBAR();
        bf16x8 Vf[4];
#pragma unroll
        for (int ks = 0; ks < 4; ++ks) Vf[ks] = tr_frag(Vimg, TRA(LA, vb, ks, 0), TRA(LA, vb, ks, 1));
        f32x16 O;
#pragma unroll
        for (int e = 0; e < 16; ++e) O[e] = 0.f;
        bf16x8 Pf[4];
#pragma unroll
        for (int ks = 0; ks < 4; ++ks) Pf[ks] = *(const LAS bf16x8*)(Pimg + LA.pp[ks] + 4096 * jb);
        u32x2 qa[2][2][2]; bf16x8 Ka[2][4];
#define HG_DLOAD(buf, db_) do { _Pragma("unroll") for (int s_ = 0; s_ < 2; ++s_) { qa[buf][s_][0] = *(const LAS u32x2*)(Qimg + QBA(LA, jb, db_, 2 * s_)); qa[buf][s_][1] = *(const LAS u32x2*)(Qimg + QBA(LA, jb, db_, 2 * s_ + 1)); } \
            _Pragma("unroll") for (int ks_ = 0; ks_ < 4; ++ks_) Ka[buf][ks_] = tr_frag(Kimg, TRA(LA, db_, ks_, 0), TRA(LA, db_, ks_, 1)); } while (0)
        HG_DLOAD(0, 0);
        __builtin_amdgcn_sched_barrier(0);
        if (full) {
#pragma unroll
            for (int ks = 0; ks < 4; ++ks) O = MFMA32(Pf[ks], Vf[ks], O); }
#pragma unroll
        for (int db = 0; db < 4; ++db) {
            f32x4 fe[4];
#pragma unroll
            for (int g = 0; g < 4; ++g) fe[g] = *(const LAS f32x4*)(eref + 32 * db + 8 * g + 4 * h5);
            if (db < 3) { if (db & 1) HG_DLOAD(0, db + 1); else HG_DLOAD(1, db + 1); }
            __builtin_amdgcn_sched_barrier(0);
#pragma unroll
            for (int g = 0; g < 4; ++g)
#pragma unroll
                for (int e = 0; e < 4; ++e) S[db][4 * g + e] *= fe[g][e];
#pragma unroll
            for (int g = 0; g < 4; ++g) fe[g] = *(const LAS f32x4*)(e2t + 32 * db + 8 * g + 4 * h5);
            if (full) {
#pragma unroll
                for (int s2 = 0; s2 < 2; ++s2) O = MFMA32(cat8(qa[db & 1][s2][0], qa[db & 1][s2][1]), pack8(S[db], s2), O); }
#pragma unroll
            for (int ks = 0; ks < 4; ++ks) S[db] = MFMA32(Ka[db & 1][ks], Vf[ks], S[db]);
#pragma unroll
            for (int g = 0; g < 4; ++g)
#pragma unroll
                for (int e = 0; e < 4; ++e) S[db][4 * g + e] *= fe[g][e];
            __builtin_amdgcn_sched_barrier(0);
        }
#undef HG_DLOAD
        LBAR();
        if (full)
#pragma unroll
        for (int e = 0; e < 16; ++e) *(LAS bf16_t*)(stg + (32 * jb + crow(e, h5)) * 272 + (32 * vb + r) * 2) = (bf16_t)(cvt_pk_bf16(O[e], 0.f) & 0xffff);
        if (n + 1 < n_hi) { HG_WRITEV(); if (n + 2 < n_hi) HG_LOADV(n + 2); }
        LBAR();
    }
    HG_LN(n_hi - 1);
    __syncthreads();
#undef HG_LOADQG
#undef HG_LOADV
#undef HG_WRITEV
#undef HG_LN
}
#ifndef SPLIT_RET
#define SPLIT_RET 36
#endif
#ifndef SPLIT_HG
#define SPLIT_HG 41
#endif
DI void phase_scan(const Params& p, int l, LAS unsigned char* lds, int W) {
    for (int it = lbid(); it < 256; it += lgrid()) {
        const int j = it >> 3, bsel = 2 * (it & 7) + (j >> 4), jj = j & 15, chain = (jj >> 3) * 64 + bsel * 4 + ((jj >> 1) & 3), part = jj & 1;
        if (chain < 64) { if (part == 0) ret_chain(p, l, chain, lds, 0, SPLIT_RET, 0, W); else ret_chain(p, l, chain, lds, 0, SEQ / 64, SPLIT_RET, W); }
        else { if (part == 0) hgrn_chain(p, l, chain - 64, lds, 0, SPLIT_HG, 0, W); else hgrn_chain(p, l, chain - 64, lds, 0, SEQ / 64, SPLIT_HG, W); }
    }
}

#define XB_TMO      128
#define XB_XCNT(j)  (256  + 64 * (j))
#define XB_XSUB(j)  (1280 + 64 * (j))
#define XB_XGEN(j)  (2304 + 64 * (j))
#define XB_TOP      3328
#define XB_TOPGEN   3392
#define XB_LSUB(j)  (3456 + 64 * (j))
#define XB_LGEN(j)  (4480 + 64 * (j))
#define XCD_BAR_WORDS 5504
#define XB_SPIN_CAP (1u << 18)
DI unsigned xb_ld(unsigned* p)              { return __hip_atomic_load(p, __ATOMIC_RELAXED, __HIP_MEMORY_SCOPE_AGENT); }
DI unsigned xb_add(unsigned* p, unsigned v) { return __hip_atomic_fetch_add(p, v, __ATOMIC_RELAXED, __HIP_MEMORY_SCOPE_AGENT); }
DI unsigned xb_xcc_id() { return (unsigned)__builtin_amdgcn_s_getreg((3 << 11) | 20) & 0xFu; }
#define XB_SPIN(cond, bar) do { unsigned _sp = 0; while (cond) { __builtin_amdgcn_s_sleep(1); \
    if ((++_sp & 255u) == 0u) { if (xb_ld(&(bar)[XB_TMO])) break; if (_sp > XB_SPIN_CAP) { atomicAdd(&(bar)[XB_TMO], 1u); break; } } } } while (0)
DI void xcd_barrier_post(unsigned* bar, int W) { if (ltid(W) == 0) (void)xb_add(&bar[XB_XCNT(xb_xcc_id())], 1u); }
DI void xcd_barrier_complete(unsigned* bar, unsigned x, unsigned& nloc, unsigned& nx) {
    const unsigned G = (unsigned)lgrid();
    unsigned sum, cnt, mine, sp = 0u;
    for (;;) {
        sum = 0u; cnt = 0u; mine = 0u;
#pragma unroll
        for (unsigned j = 0; j < 16; ++j) { const unsigned c = xb_ld(&bar[XB_XCNT(j)]); sum += c; cnt += (c > 0u) ? 1u : 0u; mine = (j == x) ? c : mine; }
        if (sum == G) break;
        __builtin_amdgcn_s_sleep(1);
        if ((++sp & 255u) == 0u) { if (xb_ld(&bar[XB_TMO])) break; if (sp > XB_SPIN_CAP) { atomicAdd(&bar[XB_TMO], 1u); break; } }
    }
    nloc = mine > 0u ? mine : 1u; nx = cnt > 0u ? cnt : 1u;
}
DI void xcd_barrier(unsigned* bar, volatile LAS unsigned* st, int W) {
    asm volatile("s_waitcnt vmcnt(0)" ::: "memory");
    __syncthreads();
    if (ltid(W) == 0) {
        const unsigned x = xb_xcc_id();
        __builtin_amdgcn_s_waitcnt(0);
        unsigned nloc = st[0], nx = st[1];
        if (nloc == 0u) { xcd_barrier_complete(bar, x, nloc, nx); st[0] = nloc; st[1] = nx; }
        const unsigned old = xb_add(&bar[XB_XSUB(x)], 1u);
        const unsigned gen = old / nloc;
        if (old + 1u == (gen + 1u) * nloc) {
            __builtin_amdgcn_fence(__ATOMIC_RELEASE, "agent");
            asm volatile("s_waitcnt vmcnt(0)" ::: "memory");
            const unsigned og = xb_add(&bar[XB_TOP], 1u);
            const unsigned tg = og / nx;
            if (og + 1u == (tg + 1u) * nx) xb_add(&bar[XB_TOPGEN], 1u);
            else XB_SPIN(xb_ld(&bar[XB_TOPGEN]) == tg, bar);
            __builtin_amdgcn_fence(__ATOMIC_ACQUIRE, "agent");
            xb_add(&bar[XB_XGEN(x)], 1u);
            asm volatile("s_waitcnt vmcnt(0)" ::: "memory");
        } else {
            XB_SPIN(xb_ld(&bar[XB_XGEN(x)]) == gen, bar);
            __builtin_amdgcn_fence(__ATOMIC_ACQUIRE, "agent");
            asm volatile("s_waitcnt vmcnt(0)" ::: "memory");
        }
    }
    __syncthreads();
}

DI void local_barrier(unsigned* bar, int W) {
    asm volatile("s_waitcnt vmcnt(0)" ::: "memory");
    __syncthreads();
    if (ltid(W) == 0) {
        const unsigned x = (unsigned)lbid() & 7u;
        const unsigned old = xb_add(&bar[XB_LSUB(x)], 1u), gen = old >> 5;
        if ((old & 31u) == 31u) xb_add(&bar[XB_LGEN(x)], 1u);
        else XB_SPIN(xb_ld(&bar[XB_LGEN(x)]) == gen, bar);
        asm volatile("buffer_inv sc0\n\ts_waitcnt vmcnt(0)" ::: "memory");
    }
    __syncthreads();
}

#ifndef PROBE_REP_A
#define PROBE_REP_A 0
#endif
#ifndef PROBE_WHICH
#define PROBE_WHICH 0
#endif
#ifndef PROBE_REP_S
#define PROBE_REP_S 0
#endif
#ifndef PROBE_N1
#define PROBE_N1 0
#endif
#ifndef PROBE_PRO
#define PROBE_PRO 0
#endif
#ifndef PROBE_SYNC
#define PROBE_SYNC 0
#endif
#ifndef PROBE_RET2
#define PROBE_RET2 0
#endif
#ifndef PROBE_HG2
#define PROBE_HG2 0
#endif
#ifndef DBG_STOP
#define DBG_STOP 0
#endif
DI void dbg_dump(const Params& p, size_t ws_off, int W) {
    const bf16_t* b = (const bf16_t*)(p.ws + ws_off); const size_t n = (size_t)M * D; const size_t g = (size_t)lbid() * 512 + ltid(W), ng = (size_t)lgrid() * 512;
    for (size_t base = 0; base < n; base += ng) { const size_t i = base + g; if (i < n) p.out[i] = bf2f(b[i]); }
}
#define DBG_AT(k, off) do { if (DBG_STOP == (k)) { if ((off) != ~(size_t)0) dbg_dump(PP, (off), W); return; } } while (0)
typedef const __attribute__((address_space(4))) Params* KP;
DI KP launder(KP k) { asm volatile("" : "+s"(k)); return k; }
#define PP (*(const Params*)launder(kp))
#define CGSYNC() do { asm volatile("s_waitcnt vmcnt(0) lgkmcnt(0)" ::: "memory"); grid.sync(); __builtin_amdgcn_fence(__ATOMIC_ACQUIRE, "agent"); asm volatile("s_waitcnt vmcnt(0)" ::: "memory"); __syncthreads(); } while (0)
#define GSYNC() xcd_barrier((unsigned*)WSP(WS_CTL) + CW_BAR, (volatile LAS unsigned*)(lds + 147392), W)
#define WSP(off) (PP.ws + (off))
#ifndef LS_MASK
#define LS_MASK 127
#endif
#define LSYNC(k) do { if (((LS_MASK >> (k)) & 1) && ((volatile LAS unsigned*)(lds + 147392))[2] != 0u) local_barrier((unsigned*)WSP(WS_CTL) + CW_BAR, W); else GSYNC(); } while (0)
template <int l> DI void run_layer(KP kp, LAS unsigned char* lds, int W) {
#if PROBE_N1
        for (int rep = 0; rep < PROBE_N1; ++rep) { if (l == 0) { const Params& p = PP; phase_norm1(p, p.x, l, W); GSYNC(); } }
#endif
        { const Params& p = PP; phase_norm1(p, l == 0 ? p.x : (const float*)nullptr, l, W);
          if (l == 1) { const int tid = ltid(W), wave = __builtin_amdgcn_readfirstlane(tid >> 6), lane = tid & 63; LAS float* scr = (LAS float*)(lds + wave * 16384);
              for (int it = IT_LAYER + IT_NE + lbid() * 8 + wave; it < IT_ALL; it += lgrid() * 8) t_dispatch(p, it, scr, lane); } }
        LSYNC(0);
#if PROBE_REP_A
        for (int rep = 0; rep < PROBE_REP_A; ++rep) { if (l == 0) { PInA_bare P; P.wsb = (const char*)WSP(0); P.aoff0 = (unsigned)WS_H; P.boff0 = (unsigned)(WS_WIN + (size_t)l * NIN * D); P.l = l;
          P.so.init(lgrid(), lbid()); pg::gemm_phase(lds, P, W); GSYNC(); } }
#endif
        { PInA P; P.wsb = (const char*)WSP(0); P.aoff0 = (unsigned)WS_H; P.boff0 = (unsigned)(WS_WIN + (size_t)l * NIN * D); P.l = l;
          P.so.init(lgrid(), lbid()); pg::gemm_phase(lds, P, W); }
        LSYNC(1);
        DBG_AT(1, WS_Z);
#if SCAN_V0
        phase_scan_v0(PP, lds, W);
        GSYNC();
        phase_headnorm(PP, l, W);
        GSYNC();
#else
#if PROBE_REP_S
        for (int rep = 0; rep < PROBE_REP_S; ++rep) { if (l == 0) { phase_scan(PP, l, lds, W); GSYNC(); } }
#endif
        phase_scan(PP, l, lds, W);
        LSYNC(2);
#endif
        DBG_AT(2, WS_AB);
        { PInC P; P.wsb = (const char*)WSP(0); P.aoff0 = (unsigned)WS_H; P.boff0 = (unsigned)(WS_WIN + ((size_t)l * NIN + NZA) * D);
          P.so.init(lgrid(), lbid()); pg::gemm_phase(lds, P, W); }
        LSYNC(3);
        DBG_AT(3, WS_Z);
        { PMerge P; P.wsb = (const char*)WSP(0); P.aoff0 = (unsigned)(FP8_DE ? WS_Z + AB8_OFF : WS_AB); P.boff0 = (unsigned)(WS_WAB + (size_t)l * D * KAB * (FP8_DE ? 1 : 2));
          P.so.init(lgrid(), lbid()); pg::gemm_phase(lds, P, W); }
        LSYNC(4);
        DBG_AT(4, WS_H);
        { const Params& p = PP; PWout P; P.wsb = (const char*)p.ws; P.aoff0 = (unsigned)WS_H; P.boff0 = (unsigned)(WS_WOUT + (size_t)l * D * D * (FP8_DE ? 1 : 2)); P.xin32 = p.x; P.l = l;
          P.so.init(lgrid(), lbid()); pg::gemm_phase(lds, P, W); }
        LSYNC(5);
        DBG_AT(5, ~(size_t)0);
        phase_norm2(PP, l, lds, W);
        GSYNC();
        LAS int* lcnt = (LAS int*)(lds + LDS_AUX); LAS int* ltoff = lcnt + 32;
        { const int t = ltid(W);
          if (t < 32) { const unsigned* gcnt = (const unsigned*)WSP(WS_CTL) + CW_CNT + l * 32; lcnt[t] = t < NCLS ? (int)__hip_atomic_load(gcnt + t, __ATOMIC_RELAXED, __HIP_MEMORY_SCOPE_AGENT) : 0; }
          if (t == 0) { int off = 0;
            for (int c = 0; c < NCLS; ++c) { ltoff[c] = off; off += (lcnt[c] + 255) >> 8; }
            ltoff[NCLS] = off; } }
        __syncthreads();
        const int mx = lbid() & 7, mj = lbid() >> 3, mtot = __builtin_amdgcn_readfirstlane(ltoff[NCLS]);
        const int Tl = mtot > mx ? (mtot - mx + 7) >> 3 : 0;
        unsigned* mctr = (unsigned*)WSP(WS_CTL) + CW_MOE + (l * 8 + mx) * 64;
        int hstart = 0, nH = 0; const int nL = 4 * (Tl > 32 ? Tl - 32 : 0);
        { const int tot12 = 12 * Tl, q = tot12 >> 5, rem = tot12 & 31;
          for (int jj = 0; jj <= mj; ++jj) { const int g8 = 8 * Tl - jj, nG = g8 > 0 ? (g8 + 31) >> 5 : 0; int h = q + (jj < rem ? 1 : 0) - nG; h = h < 0 ? 0 : h; if (jj < mj) hstart += h; else nH = h; } }
        { PMoe1 P; P.wsb = (const char*)WSP(0); P.l = l; P.T.lcnt = lcnt; P.T.ltoff = ltoff; P.G = lgrid(); P.c = lbid(); P.W = W; P.lds = lds; P.ctr = mctr; P.Tl = Tl;
          pg::gemm_phase(lds, P, W); }
        if (((LS_MASK >> 6) & 1) && ((volatile LAS unsigned*)(lds + 147392))[2] != 0u) {
            if (ltid(W) == 0) { unsigned* bar = (unsigned*)WSP(WS_CTL) + CW_BAR;
                const unsigned nA = (unsigned)(64 * (Tl < 32 ? Tl : 32)), nB = (unsigned)(64 * (Tl > 32 ? Tl - 32 : 0));
                XB_SPIN(xb_ld(mctr) < nA, bar);
                if (hstart < nL) XB_SPIN(xb_ld(mctr + 1) < nB, bar);
                asm volatile("buffer_inv sc0\n\ts_waitcnt vmcnt(0)" ::: "memory"); }
            __syncthreads();
        } else GSYNC();
        DBG_AT(6, WS_Z);
        { PMoe2 P; P.wsb = (const char*)WSP(0); P.l = l; P.T.lcnt = lcnt; P.T.ltoff = ltoff; P.G = lgrid(); P.c = lbid(); P.hstart = hstart; P.nH = nH; P.nL = nL;
          pg::gemm_phase(lds, P, W); }
        GSYNC();
        DBG_AT(7, ~(size_t)0);
    }
__global__ void __launch_bounds__(512, 2) fwd_mega(Params p_unused) {
    extern __shared__ __attribute__((aligned(16))) unsigned char lds_raw[];
    LAS unsigned char* lds = (LAS unsigned char*)lds_raw;
    int W = __builtin_amdgcn_readfirstlane((int)threadIdx.x >> 6); asm volatile("" : "+s"(W));
    cg::grid_group grid = cg::this_grid();
    KP kp = (KP)__builtin_amdgcn_kernarg_segment_ptr();

    { const int t0 = ltid(W); if (t0 < 4) ((volatile LAS unsigned*)(lds + 147392))[t0] = 0u;
      if (t0 == 0) { unsigned* lab = (unsigned*)WSP(WS_CTL) + CW_LAB + 2 * (lbid() & 7); const unsigned xcc = xb_xcc_id();
          atomicMax(lab, xcc + 1u); atomicMax(lab + 1, 16u - xcc); } }
    __syncthreads();
    xcd_barrier_post((unsigned*)WSP(WS_CTL) + CW_BAR, W);
#if PROBE_PRO
    for (int rep = 0; rep < PROBE_PRO; ++rep) { phase_prologue(PP, lds, W); GSYNC(); }
#endif
    phase_prologue(PP, lds, W);
    CGSYNC();
    if (ltid(W) == 0) {
        const unsigned* lab = (const unsigned*)WSP(WS_CTL) + CW_LAB; unsigned ok = (lgrid() == 256) ? 1u : 0u;
        for (int x = 0; x < 8; ++x) { const unsigned a = xb_ld((unsigned*)lab + 2 * x), b = xb_ld((unsigned*)lab + 2 * x + 1); ok &= (a + b == 17u) ? 1u : 0u; }
        ((volatile LAS unsigned*)(lds + 147392))[2] = ok; }
    __syncthreads();
#if PROBE_SYNC
    for (int rep = 0; rep < PROBE_SYNC; ++rep) GSYNC();
#endif
    run_layer<0>(kp, lds, W);
    run_layer<1>(kp, lds, W);
    phase_final(PP, W);
#undef PP
#undef GSYNC
#undef CGSYNC
#undef WSP
}

extern "C" void kernel_launch(void* const* d_in, const int* in_sizes, int n_in, void* d_out, int out_size, void* d_ws, size_t ws_size, hipStream_t stream) {
    static int grid_blocks = 0;
    if (grid_blocks == 0) {
        if (n_in != 19 || out_size != M * D || ws_size < WS_END) { fprintf(stderr, "kernel_launch: unexpected shapes (n_in %d, out %d, ws %zu; need ws >= %zu)\n", n_in, out_size, ws_size, (size_t)WS_END); grid_blocks = -1; return; }
        int dev = 0, cus = 0, per_cu = 0;
        (void)hipGetDevice(&dev);
        (void)hipDeviceGetAttribute(&cus, hipDeviceAttributeMultiprocessorCount, dev);
        (void)hipFuncSetAttribute((const void*)fwd_mega, hipFuncAttributeMaxDynamicSharedMemorySize, LDS_BYTES);
        (void)hipOccupancyMaxActiveBlocksPerMultiprocessor(&per_cu, (const void*)fwd_mega, 512, LDS_BYTES);
        if (per_cu < 1) { fprintf(stderr, "kernel_launch: occupancy query says %d blocks per CU\n", per_cu); per_cu = 1; }
        grid_blocks = cus * 1;
        fprintf(stderr, "kernel_launch: cus %d per_cu %d grid %d ws %zu\n", cus, per_cu, grid_blocks, ws_size);
    }
    if (grid_blocks < 0) return;
    (void)hipMemsetAsync((char*)d_ws + WS_CTL, 0, CTL_BYTES, stream);
    Params p{};
    const float** pp = (const float**)&p;
    for (int i = 0; i < 19; ++i) pp[i] = (const float*)d_in[i];
    p.out = (float*)d_out; p.ws = (unsigned char*)d_ws;
    void* args[] = {&p};
    hipError_t e = hipLaunchCooperativeKernel((const void*)fwd_mega, dim3(grid_blocks), dim3(512), args, LDS_BYTES, stream);
    if (e != hipSuccess) fprintf(stderr, "cooperative launch failed: %s (grid %d)\n", hipGetErrorString(e), grid_blocks);
}
```
